# Optimizing an MI355X kernel written in HIP

```python
import math
import jax
import jax.numpy as jnp
from jax import lax
import numpy as np

D_MODEL = 2048
BATCH = 2
SEQ = 4096
DEPTH = 1

CHUNK = 64
Q_BLOCK = 128
PLE_DIM = 256
RMS_EPS = 1e-6

DA_HEADS = 8
DA_HEAD_DIM = 128
DA_V_DIM = 2 * DA_HEAD_DIM
DA_QK_WIDTH = DA_HEADS * 2 * DA_HEAD_DIM
DA_V_WIDTH = DA_HEADS * DA_V_DIM

GLA_HEADS = 4
GLA_KEY_WIDTH = D_MODEL // 2
GLA_VAL_WIDTH = D_MODEL
GLA_DK = GLA_KEY_WIDTH // GLA_HEADS
GLA_DV = GLA_VAL_WIDTH // GLA_HEADS
GLA_GATE_RANK = 16
GLA_TAU = 16.0

N_EXPERTS = 32
TOP_K = 4
D_EXPERT = D_MODEL
SWIGLU_LIMIT = 7.0
SWIGLU_ALPHA = 1.702
MOE_BLOCK = 128

SPLIT_SIZES = (DA_QK_WIDTH, DA_QK_WIDTH, DA_V_WIDTH, GLA_KEY_WIDTH, GLA_KEY_WIDTH, GLA_VAL_WIDTH, GLA_VAL_WIDTH, GLA_GATE_RANK)
IN_WIDTH = DA_QK_WIDTH * 2 + DA_V_WIDTH + GLA_KEY_WIDTH * 2 + GLA_VAL_WIDTH * 2 + GLA_GATE_RANK

kernel_name = "hybrid_diffattn_gla_moe_block"


def _split_points(sizes):
    pts, acc = [], 0
    for s in sizes[:-1]:
        acc += s
        pts.append(acc)
    return pts


def rmsnorm(x, g, eps=RMS_EPS):
    xf = x.astype(jnp.float32)
    y = xf * lax.rsqrt(jnp.mean(xf * xf, axis=-1, keepdims=True) + eps)
    return (y * g.astype(jnp.float32)).astype(x.dtype)


def diff_attention(q, k, v, g_q, g_k, lam, subln_g, lambda_init):
    bsz, s_len = q.shape[0], q.shape[1]
    q = rmsnorm(q, g_q) * (DA_HEAD_DIM ** -0.5)
    k = rmsnorm(k, g_k)
    slopes = jnp.exp2(-8.0 * jnp.arange(1, DA_HEADS + 1, dtype=jnp.float32) / DA_HEADS)
    pos = jnp.arange(s_len)
    key_chunk = pos // CHUNK
    n_blocks = s_len // Q_BLOCK
    qb = q.reshape(bsz, n_blocks, Q_BLOCK, DA_HEADS, 2, DA_HEAD_DIM).transpose(1, 0, 2, 3, 4, 5)
    starts = jnp.arange(n_blocks) * Q_BLOCK

    def block(args):
        q_blk, start = args
        t = start + jnp.arange(Q_BLOCK)
        sc = jnp.einsum('bqhcd,bkhcd->bhcqk', q_blk, k, preferred_element_type=jnp.float32)
        dist = jnp.abs(t[:, None] - pos[None, :]).astype(jnp.float32)
        bias = -slopes[:, None, None] * dist
        allowed = key_chunk[None, :] <= (t // CHUNK)[:, None]
        sc = jnp.where(allowed, sc + bias[None, :, None], -jnp.inf)
        a = jax.nn.softmax(sc, axis=-1)
        a = a[:, :, 0] - lam * a[:, :, 1]
        return jnp.einsum('bhqk,bkhe->bqhe', a.astype(v.dtype), v, preferred_element_type=jnp.float32)

    o = lax.map(block, (qb, starts))
    o = o.transpose(1, 0, 2, 3, 4).reshape(bsz, s_len, DA_HEADS, DA_V_DIM)
    o = rmsnorm(o, subln_g) * (1.0 - lambda_init)
    return o.reshape(bsz, s_len, DA_V_WIDTH).astype(v.dtype)


def gla(q, k, v, g, log_a, out_g):
    bsz, s_len = q.shape[0], q.shape[1]
    nc = s_len // CHUNK

    def to_chunks(t):
        return t.reshape(bsz, nc, CHUNK, GLA_HEADS, t.shape[-1]).transpose(1, 0, 3, 2, 4)

    qc = to_chunks(q * (GLA_DK ** -0.5))
    kc = to_chunks(k)
    vc = to_chunks(v)
    bc = jnp.cumsum(to_chunks(log_a.astype(jnp.float32)), axis=3)

    def step(state, inp):
        q_, k_, v_, b_ = inp
        decay = jnp.exp(-jnp.abs(b_[:, :, :, None, :] - b_[:, :, None, :, :]))
        attn = jnp.einsum('bhtk,bhsk,bhtsk->bhts', q_, k_, decay)
        o_intra = jnp.einsum('bhts,bhsv->bhtv', attn, v_)
        o_inter = jnp.einsum('bhtk,bhkv->bhtv', q_ * jnp.exp(b_), state)
        b_last = b_[:, :, -1:, :]
        state = state * jnp.exp(b_last)[:, :, 0, :, None] + jnp.einsum(
            'bhsk,bhsv->bhkv', k_ * jnp.exp(b_last - b_), v_)
        return state, (o_intra + o_inter).astype(jnp.float32)

    state0 = jnp.zeros((bsz, GLA_HEADS, GLA_DK, GLA_DV), jnp.float32)
    _, o = lax.scan(step, state0, (qc, kc, vc, bc))
    o = o.transpose(1, 0, 3, 2, 4).reshape(bsz, s_len, GLA_HEADS, GLA_DV)
    o = rmsnorm(o, out_g) * jax.nn.silu(g.astype(jnp.float32))
    return o.reshape(bsz, s_len, GLA_VAL_WIDTH).astype(v.dtype)


def moe(h, router_w, router_b, w_gu, b_gu, w_dn, b_dn):
    n_tok, dim = h.shape
    logits = jnp.matmul(h, router_w, preferred_element_type=jnp.float32) + router_b.astype(jnp.float32)
    top_val, top_idx = lax.top_k(logits, TOP_K)
    gates = jax.nn.softmax(top_val, axis=-1)
    n_pairs = n_tok * TOP_K
    flat_e = top_idx.reshape(-1)
    flat_tok = jnp.arange(n_pairs, dtype=jnp.int32) // TOP_K
    order = jnp.argsort(flat_e)
    sorted_e = flat_e[order]
    counts = jnp.bincount(flat_e, length=N_EXPERTS)
    padded = (counts + MOE_BLOCK - 1) // MOE_BLOCK * MOE_BLOCK
    start = jnp.cumsum(counts) - counts
    pad_end = jnp.cumsum(padded)
    pad_start = pad_end - padded
    rank = jnp.arange(n_pairs) - start[sorted_e]
    dest_sorted = (pad_start[sorted_e] + rank).astype(jnp.int32)
    n_blocks = -(-n_pairs // MOE_BLOCK) + N_EXPERTS
    n_rows = n_blocks * MOE_BLOCK
    row_tok = jnp.full((n_rows,), n_tok, jnp.int32).at[dest_sorted].set(flat_tok[order])
    block_start = jnp.arange(n_blocks) * MOE_BLOCK
    block_expert = jnp.minimum(jnp.searchsorted(pad_end, block_start, side='right'), N_EXPERTS - 1)
    h_pad = jnp.concatenate([h, jnp.zeros((1, dim), h.dtype)], axis=0)
    xs = h_pad[row_tok].reshape(n_blocks, MOE_BLOCK, dim)

    def expert_block(args):
        xb, e = args
        gu = xb @ w_gu[e] + b_gu[e]
        gate = jnp.minimum(gu[..., 0::2], SWIGLU_LIMIT)
        up = jnp.clip(gu[..., 1::2], -SWIGLU_LIMIT, SWIGLU_LIMIT)
        act = (up + 1.0) * gate * jax.nn.sigmoid(SWIGLU_ALPHA * gate)
        return act @ w_dn[e] + b_dn[e]

    ys = lax.map(expert_block, (xs, block_expert)).reshape(n_rows, dim)
    pair_row = jnp.zeros((n_pairs,), jnp.int32).at[order].set(dest_sorted)
    y_pairs = ys[pair_row].reshape(n_tok, TOP_K, dim)
    return jnp.einsum('tk,tkd->td', gates.astype(h.dtype), y_pairs)


def setup_inputs(seed: int = 0) -> dict:
    key = jax.random.key(seed)
    ks = iter(jax.random.split(key, 40))

    def nrm(shape, scale):
        return jax.random.normal(next(ks), shape, jnp.float32) * scale

    def gain(shape):
        return 1.0 + nrm(shape, 0.02)

    L, D = DEPTH, D_MODEL
    return {
        "x": nrm((BATCH, SEQ, D), 1.0),
        "p": nrm((DEPTH, BATCH, SEQ, PLE_DIM), 1.0),
        "w_in": nrm((L, D, IN_WIDTH), D ** -0.5),
        "da_q_norm": gain((L, DA_HEAD_DIM)),
        "da_k_norm": gain((L, DA_HEAD_DIM)),
        "da_lambda_q1": nrm((L, DA_HEAD_DIM), 0.1),
        "da_lambda_k1": nrm((L, DA_HEAD_DIM), 0.1),
        "da_lambda_q2": nrm((L, DA_HEAD_DIM), 0.1),
        "da_lambda_k2": nrm((L, DA_HEAD_DIM), 0.1),
        "da_subln": gain((L, DA_V_DIM)),
        "gla_gate_w2": nrm((L, GLA_GATE_RANK, GLA_KEY_WIDTH), GLA_GATE_RANK ** -0.5),
        "gla_gate_b": nrm((L, GLA_KEY_WIDTH), 0.1),
        "gla_out_norm": gain((L, GLA_DV)),
        "w_branch_da": nrm((L, DA_V_WIDTH, D), DA_V_WIDTH ** -0.5),
        "w_branch_gla": nrm((L, GLA_VAL_WIDTH, D), GLA_VAL_WIDTH ** -0.5),
        "w_merge_gate": nrm((L, D, 2 * D), D ** -0.5),
        "b_merge_gate": nrm((L, 2 * D), 0.02),
        "w_out": nrm((L, D, D), D ** -0.5),
        "norm_mix": gain((L, D)),
        "norm_ffn": gain((L, D)),
        "router_w": nrm((L, D, N_EXPERTS), D ** -0.5),
        "router_b": nrm((L, N_EXPERTS), 0.01),
        "w_gate_up": nrm((L, N_EXPERTS, D, 2 * D_EXPERT), D ** -0.5),
        "b_gate_up": nrm((L, N_EXPERTS, 2 * D_EXPERT), 0.02),
        "w_down": nrm((L, N_EXPERTS, D_EXPERT, D), D_EXPERT ** -0.5),
        "b_down": nrm((L, N_EXPERTS, D), 0.02),
        "norm_ple": gain((L, D)),
        "w_ple_gate": nrm((L, D, D), D ** -0.5),
        "w_ple_up": nrm((L, PLE_DIM, D), PLE_DIM ** -0.5),
        "norm_ple_post": gain((L, D)),
    }


def reference(x, p, w_in, da_q_norm, da_k_norm, da_lambda_q1, da_lambda_k1, da_lambda_q2, da_lambda_k2,
              da_subln, gla_gate_w2, gla_gate_b, gla_out_norm, w_branch_da, w_branch_gla, w_merge_gate,
              b_merge_gate, w_out, norm_mix, norm_ffn, router_w, router_b, w_gate_up, b_gate_up, w_down,
              b_down, norm_ple, w_ple_gate, w_ple_up, norm_ple_post):
    bsz, s_len, dim = x.shape
    split_pts = _split_points(SPLIT_SIZES)
    for i in range(DEPTH):
        h = rmsnorm(x, norm_mix[i])
        proj = h @ w_in[i]
        dq, dk, dv, gq, gk, gv, gg, glr = jnp.split(proj, split_pts, axis=-1)

        lambda_init = 0.8 - 0.6 * math.exp(-0.3 * i)
        lam = (jnp.exp(jnp.sum(da_lambda_q1[i].astype(jnp.float32) * da_lambda_k1[i].astype(jnp.float32)))
               - jnp.exp(jnp.sum(da_lambda_q2[i].astype(jnp.float32) * da_lambda_k2[i].astype(jnp.float32)))
               + lambda_init)
        y_da = diff_attention(
            dq.reshape(bsz, s_len, DA_HEADS, 2, DA_HEAD_DIM),
            dk.reshape(bsz, s_len, DA_HEADS, 2, DA_HEAD_DIM),
            dv.reshape(bsz, s_len, DA_HEADS, DA_V_DIM),
            da_q_norm[i], da_k_norm[i], lam, da_subln[i], lambda_init)

        log_a = jax.nn.log_sigmoid(jnp.matmul(glr, gla_gate_w2[i], preferred_element_type=jnp.float32)
                                   + gla_gate_b[i].astype(jnp.float32)) / GLA_TAU
        y_gla = gla(
            gq.reshape(bsz, s_len, GLA_HEADS, GLA_DK),
            gk.reshape(bsz, s_len, GLA_HEADS, GLA_DK),
            gv.reshape(bsz, s_len, GLA_HEADS, GLA_DV),
            gg.reshape(bsz, s_len, GLA_HEADS, GLA_DV),
            log_a.reshape(bsz, s_len, GLA_HEADS, GLA_DK),
            gla_out_norm[i])

        gates = jax.nn.sigmoid(h @ w_merge_gate[i] + b_merge_gate[i])
        g_da, g_gla = jnp.split(gates, 2, axis=-1)
        mixed = g_da * (y_da @ w_branch_da[i]) + g_gla * (y_gla @ w_branch_gla[i])
        x = x + mixed @ w_out[i]

        h = rmsnorm(x, norm_ffn[i])
        x = x + moe(h.reshape(bsz * s_len, dim), router_w[i], router_b[i], w_gate_up[i], b_gate_up[i],
                    w_down[i], b_down[i]).reshape(bsz, s_len, dim)

        h = rmsnorm(x, norm_ple[i])
        ple = rmsnorm(p[i] @ w_ple_up[i], norm_ple_post[i]) * jax.nn.sigmoid(h @ w_ple_gate[i])
        x = x + ple
    return x
```

```cpp
#include <hip/hip_runtime.h>
#define MK_LAUNCHES 1
#include <cstdio>
#include <cstdint>
namespace pg8 {
#define PG8_LAS __attribute__((address_space(3)))
typedef unsigned short bf16_t;
typedef short bf16x8 __attribute__((ext_vector_type(8)));
typedef float f32x4 __attribute__((ext_vector_type(4)));
typedef unsigned u32x4 __attribute__((ext_vector_type(4)));
typedef long i64x2_t __attribute__((ext_vector_type(2)));
typedef short bf16x16_t __attribute__((ext_vector_type(16)));
typedef int i32x8_t __attribute__((ext_vector_type(8)));
constexpr int BM = 256, BK = 64, HALF = 128, HTB = HALF * BK * 2  , STAGE_BYTES = 8 * HTB, NXCD = 8, WGM = 8;

__host__ __device__ __forceinline__ int lds_byte(int r, int c) { const int st = (r >> 4) * 2 + (c >> 5), rr = r & 15, cc = c & 31, ob = rr * 64 + cc * 2; return st * 1024 + (ob ^ (((ob >> 9) & 1) << 5)); }
__host__ __device__ __forceinline__ void stage_rc(int b, int& R, int& C) { const int st = b / 1024, sb = b % 1024, swz = sb ^ (((sb >> 9) & 1) << 5); R = (st >> 1) * 16 + swz / 64; C = (st & 1) * 32 + (swz % 64) / 2; }
__host__ __device__ __forceinline__ int perm32(int rho) { const int n = rho >> 4, i = rho & 15; return 8 * (i >> 2) + 4 * n + (i & 3); }

struct Unit { int pm, pn, flags; };
struct Gemm { const bf16_t* A; const bf16_t* Bt; int M, N, K, tid; };

struct StaticOrder {
    int nM, nN, nwg, G, c;
    __host__ __device__ void init(int M, int N, int G_, int c_) { nM = M / BM; nN = N / BM; nwg = nM * nN; G = G_; c = c_; }
    __host__ __device__ bool next(int i, Unit& u) const {
        const long L = (long)i * G + c; if (L >= nwg) return false;
        int wgid = (int)L; { const int q = nwg / NXCD, r = nwg % NXCD, xcd = wgid % NXCD, off = wgid / NXCD; wgid = (xcd < r ? xcd * (q + 1) : r * (q + 1) + (xcd - r) * q) + off; }
        const int nig = WGM * nN, gid = wgid / nig, fm = gid * WGM, gsz = (nM - fm) < WGM ? (nM - fm) : WGM;
        u.pm = fm + ((wgid % nig) % gsz); u.pn = (wgid % nig) / gsz; u.flags = 0; return true;
    }
    __device__ __forceinline__ void a_ready(const Unit&) const {}
    __device__ __forceinline__ void done(const Unit&) const {}
};

__device__ __forceinline__ unsigned cvt_pk_bf16(float lo, float hi) { unsigned r; asm volatile("v_cvt_pk_bf16_f32 %0, %1, %2" : "=v"(r) : "v"(lo), "v"(hi)); return r; }
template <class Epi, class Sched, bool ALIGN_EPI = false, bool SP2 = false, int FP8 = 0  >
__device__ __forceinline__ void gemm_phase(PG8_LAS unsigned char* lds, const Gemm g, const Sched& S, const Epi& E) {
    const int tid = g.tid, wid = __builtin_amdgcn_readfirstlane(tid >> 6), lane = tid & 63, wr = wid >> 2, wc = wid & 3, fr = lane & 15, fq = lane >> 4;
    const int K = g.K, nt = K / BK;
    unsigned voffA[2], voffB[2];
#pragma unroll
    for (int i = 0; i < 2; ++i) { int R, C; stage_rc(tid * 16 + i * 8192, R, C); const int Rb = Epi::PERM ? ((R & ~31) + perm32(R & 31)) : R;
        voffA[i] = (unsigned)(R * K + C) * 2u; voffB[i] = (unsigned)(Rb * K + C) * 2u; }
    const size_t kstep = (size_t)(BK * 2);
    const size_t hstep = (size_t)HALF * K * 2;
    const size_t tstep = 2 * hstep;
    const unsigned ldsw = (unsigned)wid * 1024u;
    const int aoff = lds_byte(wr * 64 + fr, fq * 8), boff = lds_byte(wc * 32 + fr, fq * 8);
#define PG8_SA(b, h) (((b) * 2 + (h)) * HTB)
#define PG8_SB(b, h) ((4 + (b) * 2 + (h)) * HTB)
#define PG8_STAGE(bufoff, gbase, voff) do { _Pragma("unroll") for (int _i = 0; _i < 2; ++_i) { unsigned vo_ = (voff)[_i]; asm volatile("" : "+v"(vo_));   \
        __builtin_amdgcn_global_load_lds((const unsigned*)((const char*)(gbase) + vo_), (PG8_LAS unsigned*)(lds + (bufoff) + ldsw + _i * 8192), 16, 0, 0); } } while (0)
#define PG8_LDA(dst, b, h) do { _Pragma("unroll") for (int m = 0; m < 4; ++m) _Pragma("unroll") for (int k = 0; k < 2; ++k) dst[m][k] = *(const PG8_LAS bf16x8*)(lds + PG8_SA(b, h) + aoff + m * 2048 + k * 1024); } while (0)
#define PG8_LDB(dst, b, h) do { _Pragma("unroll") for (int n = 0; n < 2; ++n) _Pragma("unroll") for (int k = 0; k < 2; ++k) dst[n][k] = *(const PG8_LAS bf16x8*)(lds + PG8_SB(b, h) + boff + n * 2048 + k * 1024); } while (0)
#define PG8_MMA(ai, bj, At, Bt) do { __builtin_amdgcn_s_setprio(1); \
        if constexpr (FP8 == 2) { _Pragma("unroll") for (int m = 0; m < 4; ++m) _Pragma("unroll") for (int n = 0; n < 2; ++n) { \
            const bf16x16_t b16_ = __builtin_shufflevector(Bt[n][0], Bt[n][1], 0, 1, 2, 3, 4, 5, 6, 7, 8, 9, 10, 11, 12, 13, 14, 15), a16_ = __builtin_shufflevector(At[m][0], At[m][1], 0, 1, 2, 3, 4, 5, 6, 7, 8, 9, 10, 11, 12, 13, 14, 15); \
            acc[ai][bj][m][n] = __builtin_amdgcn_mfma_scale_f32_16x16x128_f8f6f4(__builtin_bit_cast(i32x8_t, b16_), __builtin_bit_cast(i32x8_t, a16_), acc[ai][bj][m][n], 0, 0, 0, 0, 0, 0); } } \
        else { _Pragma("unroll") for (int m = 0; m < 4; ++m) _Pragma("unroll") for (int n = 0; n < 2; ++n) _Pragma("unroll") for (int k = 0; k < 2; ++k) { \
        if constexpr (FP8 == 1) { const i64x2_t b2_ = __builtin_bit_cast(i64x2_t, Bt[n][k]), a2_ = __builtin_bit_cast(i64x2_t, At[m][k]); \
            acc[ai][bj][m][n] = __builtin_amdgcn_mfma_f32_16x16x32_fp8_fp8(b2_[0], a2_[0], acc[ai][bj][m][n], 0, 0, 0); \
            acc[ai][bj][m][n] = __builtin_amdgcn_mfma_f32_16x16x32_fp8_fp8(b2_[1], a2_[1], acc[ai][bj][m][n], 0, 0, 0); } \
        else acc[ai][bj][m][n] = __builtin_amdgcn_mfma_f32_16x16x32_bf16(Bt[n][k], At[m][k], acc[ai][bj][m][n], 0, 0, 0); } } __builtin_amdgcn_s_setprio(0); } while (0)
#define PG8_WAIT_V(n) asm volatile("s_waitcnt vmcnt(" #n ")" ::: "memory")
#define PG8_WAIT_L(n) asm volatile("s_waitcnt lgkmcnt(" #n ")" ::: "memory")
#define PG8_BAR __builtin_amdgcn_s_barrier()
#define PG8_SCHED __builtin_amdgcn_sched_barrier(0)
    Unit cur, nxt; int ui = 0;
    if (!S.next(0, cur)) return;
    f32x4 acc[2][2][4][2];
#pragma unroll
    for (int a = 0; a < 2; ++a)
#pragma unroll
        for (int b = 0; b < 2; ++b)
#pragma unroll
            for (int m = 0; m < 4; ++m)
#pragma unroll
                for (int n = 0; n < 2; ++n) acc[a][b][m][n] = (f32x4){0.f, 0.f, 0.f, 0.f};
    bf16x8 At[4][2], B0[2][2], B1[2][2];
    const char* cA = (const char*)g.A + (size_t)cur.pm * tstep; const char* cB = (const char*)g.Bt + (size_t)cur.pn * tstep;
    S.a_ready(cur);
    if constexpr (SP2) {
        PG8_STAGE(PG8_SB(0, 0), cB, voffB); PG8_STAGE(PG8_SB(0, 1), cB + hstep, voffB); PG8_STAGE(PG8_SA(0, 0), cA, voffA); PG8_STAGE(PG8_SA(0, 1), cA + hstep, voffA);
        if (wr == 1) PG8_BAR;
        PG8_WAIT_V(2); PG8_BAR;
        PG8_STAGE(PG8_SB(1, 0), cB + kstep, voffB); PG8_STAGE(PG8_SA(1, 0), cA + kstep, voffA); PG8_STAGE(PG8_SB(1, 1), cB + hstep + kstep, voffB);
        PG8_WAIT_V(6); PG8_BAR;
    } else {
        PG8_STAGE(PG8_SB(0, 0), cB, voffB); PG8_STAGE(PG8_SA(0, 0), cA, voffA); PG8_STAGE(PG8_SB(0, 1), cB + hstep, voffB); PG8_STAGE(PG8_SA(0, 1), cA + hstep, voffA);
        if (wr == 1) PG8_BAR;
        PG8_WAIT_V(4); PG8_BAR;
        PG8_STAGE(PG8_SB(1, 0), cB + kstep, voffB); PG8_STAGE(PG8_SA(1, 0), cA + kstep, voffA); PG8_STAGE(PG8_SB(1, 1), cB + hstep + kstep, voffB);
        PG8_WAIT_V(6); PG8_BAR;
    }
    for (;;) {
        const bool has_next = S.next(ui + 1, nxt);
        const char* nA = has_next ? (const char*)g.A + (size_t)nxt.pm * tstep : cA; const char* nB = has_next ? (const char*)g.Bt + (size_t)nxt.pn * tstep : cB;
        for (int t = 0; t < nt; t += 2) {
            const bool last = (t == nt - 2);
            const char* a1 = cA + (size_t)(t + 1) * kstep;
            const char* a2 = last ? nA : cA + (size_t)(t + 2) * kstep; const char* b2 = last ? nB : cB + (size_t)(t + 2) * kstep;
            const char* a3 = a2 + kstep; const char* b3 = b2 + kstep;
            if (last && has_next) S.a_ready(nxt);
            if constexpr (Epi::HAS_MID) { if (t == nt / 2) E.mid(acc, cur, wr, wc, fr, fq); }
            if constexpr (SP2) {
            PG8_LDB(B0, 0, 0); PG8_LDB(B1, 0, 1); PG8_SCHED; PG8_LDA(At, 0, 0); PG8_STAGE(PG8_SA(1, 1), a1 + hstep, voffA);
            PG8_WAIT_V(8); PG8_WAIT_L(0); PG8_BAR; PG8_MMA(0, 0, At, B0); PG8_MMA(0, 1, At, B1); PG8_BAR; PG8_SCHED;
            PG8_LDA(At, 0, 1); PG8_STAGE(PG8_SB(0, 0), b2, voffB); PG8_STAGE(PG8_SB(0, 1), b2 + hstep, voffB); PG8_STAGE(PG8_SA(0, 0), a2, voffA);
            PG8_WAIT_V(8); PG8_WAIT_L(0); PG8_BAR; if (!(cur.flags & 1)) { PG8_MMA(1, 0, At, B0); PG8_MMA(1, 1, At, B1); } PG8_BAR; PG8_SCHED;
            PG8_LDB(B0, 1, 0); PG8_LDB(B1, 1, 1); PG8_SCHED; PG8_LDA(At, 1, 0); PG8_STAGE(PG8_SA(0, 1), a2 + hstep, voffA);
            PG8_WAIT_V(8); PG8_WAIT_L(0); PG8_BAR; PG8_MMA(0, 0, At, B0); PG8_MMA(0, 1, At, B1); PG8_BAR; PG8_SCHED;
            PG8_LDA(At, 1, 1); PG8_STAGE(PG8_SB(1, 0), b3, voffB); PG8_STAGE(PG8_SB(1, 1), b3 + hstep, voffB); PG8_STAGE(PG8_SA(1, 0), a3, voffA);
            PG8_WAIT_V(8); PG8_WAIT_L(0); PG8_BAR; if (!(cur.flags & 1)) { PG8_MMA(1, 0, At, B0); PG8_MMA(1, 1, At, B1); } PG8_BAR; PG8_SCHED;
            } else {
            PG8_LDB(B0, 0, 0); PG8_SCHED; PG8_LDA(At, 0, 0); PG8_STAGE(PG8_SA(1, 1), a1 + hstep, voffA);
            PG8_WAIT_L(8); PG8_BAR; PG8_WAIT_L(0); PG8_MMA(0, 0, At, B0); PG8_BAR; PG8_SCHED;
            PG8_LDB(B1, 0, 1); PG8_STAGE(PG8_SB(0, 0), b2, voffB);
            PG8_BAR; PG8_WAIT_L(0); PG8_MMA(0, 1, At, B1); PG8_BAR;
            PG8_LDA(At, 0, 1); PG8_STAGE(PG8_SA(0, 0), a2, voffA);
            PG8_BAR; PG8_WAIT_L(0); PG8_MMA(1, 0, At, B0); PG8_BAR; PG8_SCHED;
            PG8_STAGE(PG8_SB(0, 1), b2 + hstep, voffB);
            PG8_WAIT_V(6); PG8_BAR; PG8_MMA(1, 1, At, B1); PG8_BAR;
            PG8_LDB(B0, 1, 0); PG8_SCHED; PG8_LDA(At, 1, 0); PG8_STAGE(PG8_SA(0, 1), a2 + hstep, voffA);
            PG8_WAIT_L(8); PG8_BAR; PG8_WAIT_L(0); PG8_MMA(0, 0, At, B0); PG8_BAR; PG8_SCHED;
            PG8_LDB(B1, 1, 1); PG8_STAGE(PG8_SB(1, 0), b3, voffB);
            PG8_BAR; PG8_WAIT_L(0); PG8_MMA(0, 1, At, B1); PG8_BAR;
            PG8_LDA(At, 1, 1); PG8_STAGE(PG8_SA(1, 0), a3, voffA);
            PG8_BAR; PG8_WAIT_L(0); PG8_MMA(1, 0, At, B0); PG8_BAR; PG8_SCHED;
            PG8_STAGE(PG8_SB(1, 1), b3 + hstep, voffB);
            PG8_WAIT_V(6); PG8_BAR; PG8_MMA(1, 1, At, B1); PG8_BAR;
            }
        }
        if constexpr (ALIGN_EPI) { if (wr == 0) PG8_BAR; }
        if constexpr (!Epi::AFTER_DRAIN) { E(acc, cur, wr, wc, fr, fq); S.done(cur); }
        if (!has_next) break;
#pragma unroll
        for (int a = 0; a < 2; ++a)
#pragma unroll
            for (int b = 0; b < 2; ++b)
#pragma unroll
                for (int m = 0; m < 4; ++m)
#pragma unroll
                    for (int n = 0; n < 2; ++n) acc[a][b][m][n] = (f32x4){0.f, 0.f, 0.f, 0.f};
        cur = nxt; cA = nA; cB = nB; ++ui;
        if constexpr (ALIGN_EPI) { if (wr == 1) PG8_BAR; }
    }
    PG8_WAIT_V(0);
    if constexpr (!ALIGN_EPI) { if (wr == 0) PG8_BAR; }
    PG8_BAR;
    if constexpr (Epi::AFTER_DRAIN) { E.fused(acc, cur, wr, wc, fr, fq, lds, wid, lane); S.done(cur); }
#undef PG8_SA
#undef PG8_SB
#undef PG8_STAGE
#undef PG8_LDA
#undef PG8_LDB
#undef PG8_MMA
#undef PG8_WAIT_V
#undef PG8_WAIT_L
#undef PG8_BAR
#undef PG8_SCHED
}
}
#define XB_TMO      128
#define XB_XCNT(j)  (256  + 64 * (j))
#define XB_XSUB(j)  (1280 + 64 * (j))
#define XB_XGEN(j)  (2304 + 64 * (j))
#define XB_TOP      3328
#define XB_TOPGEN   3392
#define XCD_BAR_WORDS 3456
#define XB_SPIN_CAP (1u << 18)
#define LAS __attribute__((address_space(3)))

__device__ __forceinline__ unsigned xb_ld(unsigned* p)              { return __hip_atomic_load(p, __ATOMIC_RELAXED, __HIP_MEMORY_SCOPE_AGENT); }
__device__ __forceinline__ unsigned xb_add(unsigned* p, unsigned v) { return __hip_atomic_fetch_add(p, v, __ATOMIC_RELAXED, __HIP_MEMORY_SCOPE_AGENT); }
__device__ __forceinline__ unsigned xb_xcc_id() { return (unsigned)__builtin_amdgcn_s_getreg((3 << 11) | 20) & 0xFu; }
#define XB_SPIN(cond, bar) do { unsigned _sp = 0; while (cond) { __builtin_amdgcn_s_sleep(1); \
    if ((++_sp & 255u) == 0u) { if (xb_ld(&(bar)[XB_TMO])) break; if (_sp > XB_SPIN_CAP) { atomicAdd(&(bar)[XB_TMO], 1u); break; } } } } while (0)

struct XcdBarrier {
    unsigned* bar; unsigned x; int wave;
    volatile LAS unsigned* st;
};

__device__ __forceinline__ XcdBarrier xcd_barrier_post(unsigned* bar, volatile LAS unsigned* st) {
    XcdBarrier b; b.bar = bar; b.x = xb_xcc_id(); b.st = st;
    if (threadIdx.x == 0) (void)xb_add(&bar[XB_XCNT(b.x)], 1u);
    return b;
}
__device__ __forceinline__ void xcd_barrier_complete(unsigned* bar, unsigned x, unsigned& nloc, unsigned& nx) {
    const unsigned G = gridDim.x * gridDim.y * gridDim.z;
    unsigned sum, cnt, mine, sp = 0u;
    for (;;) {
        sum = 0u; cnt = 0u; mine = 0u;
#pragma unroll
        for (unsigned j = 0; j < 16; ++j) { const unsigned c = xb_ld(&bar[XB_XCNT(j)]); sum += c; cnt += (c > 0u) ? 1u : 0u; mine = (j == x) ? c : mine; }
        if (sum == G) break;
        __builtin_amdgcn_s_sleep(1);
        if ((++sp & 255u) == 0u) { if (xb_ld(&bar[XB_TMO])) break; if (sp > XB_SPIN_CAP) { atomicAdd(&bar[XB_TMO], 1u); break; } }
    }
    nloc = mine > 0u ? mine : 1u; nx = cnt > 0u ? cnt : 1u;
}

__device__ __forceinline__ void xcd_barrier(const XcdBarrier& b) {
    asm volatile("s_waitcnt vmcnt(0)" ::: "memory");
    __syncthreads();
    if (b.wave == 0 && __builtin_amdgcn_mbcnt_hi(~0u, __builtin_amdgcn_mbcnt_lo(~0u, 0u)) == 0u) {
        unsigned* bar = b.bar;
        __builtin_amdgcn_s_waitcnt(0);
        unsigned nloc = b.st[0], nx = b.st[1];
        if (nloc == 0u) { xcd_barrier_complete(bar, b.x, nloc, nx); b.st[0] = nloc; b.st[1] = nx; }
        const unsigned old = xb_add(&bar[XB_XSUB(b.x)], 1u);
        const unsigned gen = old / nloc;
        if (old + 1u == (gen + 1u) * nloc) {
            __builtin_amdgcn_fence(__ATOMIC_RELEASE, "agent");
            asm volatile("s_waitcnt vmcnt(0)" ::: "memory");
            const unsigned og = xb_add(&bar[XB_TOP], 1u);
            const unsigned tg = og / nx;
            if (og + 1u == (tg + 1u) * nx) xb_add(&bar[XB_TOPGEN], 1u);
            else XB_SPIN(xb_ld(&bar[XB_TOPGEN]) == tg, bar);
            __builtin_amdgcn_fence(__ATOMIC_ACQUIRE, "agent");
            xb_add(&bar[XB_XGEN(b.x)], 1u);
            asm volatile("s_waitcnt vmcnt(0)" ::: "memory");
        } else {
            XB_SPIN(xb_ld(&bar[XB_XGEN(b.x)]) == gen, bar);
            __builtin_amdgcn_fence(__ATOMIC_ACQUIRE, "agent");
            asm volatile("s_waitcnt vmcnt(0)" ::: "memory");
        }
    }
    __syncthreads();
}


#define GAS __attribute__((address_space(1)))
using pg8::bf16_t; using pg8::bf16x8; using pg8::f32x4; using pg8::u32x4; using pg8::cvt_pk_bf16;
typedef short s16x4 __attribute__((ext_vector_type(4)));
typedef float f32x16 __attribute__((ext_vector_type(16)));
typedef float f32x2 __attribute__((ext_vector_type(2)));
typedef unsigned u32x2 __attribute__((ext_vector_type(2)));
#define RLX_AGENT __ATOMIC_RELAXED, __HIP_MEMORY_SCOPE_AGENT
#define LDS_WAIT() asm volatile("s_waitcnt lgkmcnt(0)" ::: "memory")
#define VM_WAIT() asm volatile("s_waitcnt vmcnt(0)" ::: "memory")

constexpr int NB = 2, SEQ = 4096, DM = 2048, TOK = NB * SEQ;
constexpr int PLE = 256;
constexpr int DA_H = 8, DA_D = 128, DA_V = 256;
constexpr int GL_H = 4, GL_DK = 256, GL_DV = 512, GL_KW = 1024, GL_VW = 2048, GL_R = 16;
constexpr int NEXP = 32, TOPK = 4, DEXP = 2048;
constexpr int IN_W = 12304, IN_MAIN = 12288;
constexpr int N_INP = IN_MAIN + 2 * DM;
constexpr int CHUNK = 64, NCH = SEQ / CHUNK;
constexpr float RMS_EPS = 1e-6f;
constexpr float LOG2E = 1.4426950408889634f;
constexpr int MAXROWS = 40960;

constexpr size_t MiB = 1u << 20;
constexpr size_t WS_CTL = 0, CTL_ZERO_BYTES = 1 * MiB;
constexpr size_t WS_WTIN = 1 * MiB;
constexpr size_t WS_WTBR = 65 * MiB;
constexpr size_t WS_WTOUT = 81 * MiB, WS_WTPLEG = 89 * MiB;
constexpr size_t WS_WTPLEUP = 97 * MiB;
constexpr size_t WS_WTGU = 98 * MiB;
constexpr size_t WS_WTDN = 610 * MiB;
constexpr size_t WS_H1 = 866 * MiB;
constexpr size_t WS_Q = 898 * MiB, WS_K = 930 * MiB, WS_V = 962 * MiB;
constexpr size_t WS_GQP = 994 * MiB, WS_GQM = 1010 * MiB, WS_GKP = 1026 * MiB, WS_GKM = 1042 * MiB;
constexpr size_t WS_GV = 1058 * MiB, WS_SG = 1090 * MiB;
constexpr size_t WS_GATES = 1122 * MiB;
constexpr size_t WS_BCUM = 1186 * MiB;
constexpr size_t WS_ATTC = 1218 * MiB;
constexpr size_t WS_YDA = 1222 * MiB;
constexpr size_t WS_OGLA = 1254 * MiB;
constexpr size_t WS_YGLA = 1318 * MiB;
constexpr size_t WS_YCAT = 1350 * MiB;
constexpr size_t WS_MIXED = 1414 * MiB;
constexpr size_t WS_X1 = 1446 * MiB;
constexpr size_t WS_H2 = 1510 * MiB;
constexpr size_t WS_ROUTE = 1542 * MiB;
constexpr size_t WS_XS = 1543 * MiB;
constexpr size_t WS_ACT = 1703 * MiB;
constexpr size_t WS_YB = 1863 * MiB;
constexpr size_t WS_X2 = 2023 * MiB;
constexpr size_t WS_H3 = 2087 * MiB;
constexpr size_t WS_PN = 2119 * MiB;
constexpr size_t WS_PB = 2151 * MiB;
constexpr size_t WS_UB = 2155 * MiB;
constexpr size_t WS_H1F8 = 2103 * MiB;
constexpr size_t WS_WTMG8 = 49 * MiB;
constexpr size_t WS_END = 2187 * MiB;
constexpr int CW_BAR = 4096;
constexpr int CW_CNT = 8192;
constexpr int CW_QUEUE = 12288;
constexpr int CW_LAM = 16384;

constexpr int RING_BYTES = 131072;
constexpr int EX_OFF = 131072;
constexpr int MISC_OFF = 139264 + 1024;
constexpr int LDS_BYTES = 160 * 1024;

struct Frame {
    LAS unsigned char* lds;
    int tid, lane, wave, G, vcu;
    unsigned char* ws;
    const float* in[30];
    float* out;
};

__device__ __forceinline__ void refresh(Frame& F) { int l; asm volatile("v_mbcnt_lo_u32_b32 %0, -1, 0\n\tv_mbcnt_hi_u32_b32 %0, -1, %0" : "=v"(l)); F.lane = l; F.tid = F.wave * 64 + l; }
__device__ __forceinline__ float wave_sum(float v) {
#pragma unroll
    for (int o = 1; o < 64; o <<= 1) v += __shfl_xor(v, o);
    return v;
}
__device__ __forceinline__ float bf2f(unsigned short b) { return __uint_as_float(((unsigned)b) << 16); }
__device__ __forceinline__ float bflo(unsigned w) { return __uint_as_float(w << 16); }
__device__ __forceinline__ float bfhi(unsigned w) { return __uint_as_float(w & 0xffff0000u); }
__device__ __forceinline__ float fast_sigmoid(float x) { return 1.0f / (1.0f + __expf(-x)); }
typedef short v4i16_t __attribute__((ext_vector_type(4)));
__device__ __forceinline__ s16x4 lds_tr16(const LAS unsigned char* p) { return __builtin_bit_cast(s16x4, __builtin_amdgcn_ds_read_tr16_b64_v4i16((LAS v4i16_t*)p)); }
__device__ __forceinline__ bf16x8 cat8(const s16x4 a, const s16x4 b) { bf16x8 r; r[0] = a[0]; r[1] = a[1]; r[2] = a[2]; r[3] = a[3]; r[4] = b[0]; r[5] = b[1]; r[6] = b[2]; r[7] = b[3]; return r; }

__device__ __forceinline__ void p0_tr_load(f32x4 (&v)[16], const float* W, int ldw, int kb, int nb, int lane) {
    const int k0 = 64 * kb, n0 = 64 * nb, lk = lane >> 4, ln = (lane & 15) * 4;
#pragma unroll
    for (int i = 0; i < 16; ++i) v[i] = __builtin_nontemporal_load((const f32x4*)(W + (size_t)(k0 + 4 * i + lk) * ldw + n0 + ln));
}
__device__ __forceinline__ void p0_tr_finish(const f32x4 (&v)[16], int Kdst, bf16_t* WT, size_t row_off, LAS float* scr, int kb, int nb, int lane, bool nostore = false) {
    const int k0 = 64 * kb, n0 = 64 * nb, lk = lane >> 4, ln = (lane & 15) * 4;
#pragma unroll
    for (int i = 0; i < 16; ++i) { LAS float* s = scr + (4 * i + lk) * 65 + ln; s[0] = v[i][0]; s[1] = v[i][1]; s[2] = v[i][2]; s[3] = v[i][3]; }
    LDS_WAIT(); asm volatile("" ::: "memory");
    const int c = lane & 7;
#pragma unroll
    for (int j = 0; j < 8; ++j) { const int n = (lane >> 3) + 8 * j; const LAS float* s = scr + (8 * c) * 65 + n;
        u32x4 o; o.x = cvt_pk_bf16(s[0 * 65], s[1 * 65]); o.y = cvt_pk_bf16(s[2 * 65], s[3 * 65]); o.z = cvt_pk_bf16(s[4 * 65], s[5 * 65]); o.w = cvt_pk_bf16(s[6 * 65], s[7 * 65]);
        if (!nostore || o.x == 0x12345678u) __builtin_nontemporal_store(o, (u32x4*)(WT + (row_off + n0 + n) * (size_t)Kdst + k0 + 8 * c)); }
    LDS_WAIT(); asm volatile("" ::: "memory");
}
constexpr float W8_SCALE = 32.0f, W8_INV = 1.0f / 32.0f;
__device__ __forceinline__ unsigned pack_fp8x4(float a, float b, float c, float d) {
    a = fminf(fmaxf(a, -448.f), 448.f); b = fminf(fmaxf(b, -448.f), 448.f); c = fminf(fmaxf(c, -448.f), 448.f); d = fminf(fmaxf(d, -448.f), 448.f);
    int w = 0; w = __builtin_amdgcn_cvt_pk_fp8_f32(a, b, w, false); w = __builtin_amdgcn_cvt_pk_fp8_f32(c, d, w, true); return (unsigned)w;
}
__device__ __forceinline__ void p0_tr_finish8(const f32x4 (&v)[16], int Kdst, unsigned char* WT, size_t row_off, LAS float* scr, int kb, int nb, int lane, bool nostore = false) {
    const int k0 = 64 * kb, n0 = 64 * nb, lk = lane >> 4, ln = (lane & 15) * 4;
#pragma unroll
    for (int i = 0; i < 16; ++i) { LAS float* s = scr + (4 * i + lk) * 65 + ln; s[0] = v[i][0]; s[1] = v[i][1]; s[2] = v[i][2]; s[3] = v[i][3]; }
    LDS_WAIT(); asm volatile("" ::: "memory");
    const int c = lane & 7;
#pragma unroll
    for (int j = 0; j < 8; ++j) { const int n = (lane >> 3) + 8 * j; const LAS float* s = scr + (8 * c) * 65 + n;
        u32x2 o; o.x = pack_fp8x4(s[0 * 65] * W8_SCALE, s[1 * 65] * W8_SCALE, s[2 * 65] * W8_SCALE, s[3 * 65] * W8_SCALE); o.y = pack_fp8x4(s[4 * 65] * W8_SCALE, s[5 * 65] * W8_SCALE, s[6 * 65] * W8_SCALE, s[7 * 65] * W8_SCALE);
        if (!nostore || o.x == 0x12345678u) __builtin_nontemporal_store(o, (u32x2*)(WT + (row_off + n0 + n) * (size_t)Kdst + k0 + 8 * c)); }
    LDS_WAIT(); asm volatile("" ::: "memory");
}
__device__ __forceinline__ void p0_transpose_item8(const float* W, int ldw, int Kdst, unsigned char* WT, size_t row_off, LAS float* scr, int kb, int nb, int lane) {
    f32x4 v[16]; p0_tr_load(v, W, ldw, kb, nb, lane); p0_tr_finish8(v, Kdst, WT, row_off, scr, kb, nb, lane);
}
__device__ __forceinline__ void p0_transpose_item(const float* W, int ldw, int Kdst, bf16_t* WT, size_t row_off, LAS float* scr, int kb, int nb, int lane, bool nostore = false) {
    f32x4 v[16]; p0_tr_load(v, W, ldw, kb, nb, lane); p0_tr_finish(v, Kdst, WT, row_off, scr, kb, nb, lane, nostore);
}

__device__ __forceinline__ float log_sigmoid_f(float z) { return fminf(z, 0.f) - __logf(1.0f + __expf(-fabsf(z))); }

__device__ __forceinline__ void p0_chunk_job(Frame& F, int ci) {
    const float* x = F.in[0]; const float* gmix = F.in[18]; const float* w_in = F.in[2];
    const float* w2 = F.in[10]; const float* gb = F.in[11];
    bf16_t* h1 = (bf16_t*)(F.ws + WS_H1); float* bcum = (float*)(F.ws + WS_BCUM);
    LAS float* glr_s = (LAS float*)(F.lds);
    int lane_ = F.lane; asm volatile("" : "+v"(lane_));
    const int t0 = ci * 64, lane = lane_, w = F.wave;
    {
        const float* pin = F.in[1]; bf16_t* pb = (bf16_t*)(F.ws + WS_PB);
#pragma unroll
        for (int r = 0; r < 8; ++r) { const size_t t = (size_t)(t0 + 8 * w + r); const f32x4 pv = *(const f32x4*)(pin + t * PLE + 4 * lane);
            u32x2 o; o.x = cvt_pk_bf16(pv[0], pv[1]); o.y = cvt_pk_bf16(pv[2], pv[3]); *(u32x2*)(pb + t * PLE + 4 * lane) = o; }
    }
    LAS float* wl = (LAS float*)(F.lds + 4096);
    for (int k = F.tid; k < DM; k += 512) { const float gk = gmix[k]; const int slot = (k & 3) * 512 + (k >> 2);
#pragma unroll
        for (int q = 0; q < 4; ++q) { const f32x4 wq = *(const f32x4*)(w_in + (size_t)k * IN_W + IN_MAIN + 4 * q) * gk; *(LAS f32x4*)(wl + slot * 16 + 4 * (q ^ ((slot >> 2) & 3))) = wq; } }
    LDS_WAIT(); __syncthreads();
    {
        f32x4 g[8];
#pragma unroll
        for (int j = 0; j < 8; ++j) g[j] = *(const f32x4*)(gmix + 4 * (lane + 64 * j));
        const int sw = (lane >> 2) & 3;
#pragma unroll 1
        for (int p = 0; p < 4; ++p) {
            f32x4 xv[2][8]; float rs2[2];
#pragma unroll
            for (int r = 0; r < 2; ++r) { const size_t t = (size_t)(t0 + 8 * w + 2 * p + r);
                const float* xrow = x + t * DM + 4 * lane; asm volatile("" : "+v"(xrow));
#pragma unroll
                for (int j = 0; j < 8; ++j) xv[r][j] = *(const f32x4*)(xrow + 256 * j); }
#pragma unroll
            for (int r = 0; r < 2; ++r) { const size_t t = (size_t)(t0 + 8 * w + 2 * p + r); float ss = 0.f;
#pragma unroll
                for (int j = 0; j < 8; ++j) ss += (xv[r][j][0] * xv[r][j][0] + xv[r][j][1] * xv[r][j][1]) + (xv[r][j][2] * xv[r][j][2] + xv[r][j][3] * xv[r][j][3]);
                ss = wave_sum(ss);
                const float rs = rsqrtf(ss * (1.0f / DM) + RMS_EPS); rs2[r] = rs;
                bf16_t* hrow = h1 + t * DM + 4 * lane; unsigned char* frow = F.ws + WS_H1F8 + t * DM + 4 * lane; asm volatile("" : "+v"(hrow), "+v"(frow));
#pragma unroll
                for (int j = 0; j < 8; ++j) { u32x2 o; o.x = cvt_pk_bf16(xv[r][j][0] * rs * g[j][0], xv[r][j][1] * rs * g[j][1]); o.y = cvt_pk_bf16(xv[r][j][2] * rs * g[j][2], xv[r][j][3] * rs * g[j][3]);
                    *(u32x2*)(hrow + 256 * j) = o;
                    *(unsigned*)(frow + 256 * j) = pack_fp8x4(xv[r][j][0] * rs * g[j][0], xv[r][j][1] * rs * g[j][1], xv[r][j][2] * rs * g[j][2], xv[r][j][3] * rs * g[j][3]); }
            }
            float acc[32];
#pragma unroll
            for (int i = 0; i < 32; ++i) acc[i] = 0.f;
            unsigned wb[8];
#pragma unroll
            for (int q = 0; q < 4; ++q) { unsigned b0 = 4096u + (unsigned)lane * 64u + 16u * (unsigned)(q ^ sw); asm volatile("" : "+v"(b0)); wb[q] = b0; unsigned b1 = b0 + 65536u; asm volatile("" : "+v"(b1)); wb[4 + q] = b1; }
#pragma unroll
            for (int j = 0; j < 8; ++j)
#pragma unroll
                for (int c = 0; c < 4; ++c) {
                    f32x4 wv[4];
#pragma unroll
                    for (int q = 0; q < 4; ++q) wv[q] = *(const LAS f32x4*)((const LAS unsigned char*)F.lds + wb[(c >> 1) * 4 + q] + ((c & 1) * 512 + 64 * j) * 64);
#pragma unroll
                    for (int r = 0; r < 2; ++r) { const float xg = xv[r][j][c];
#pragma unroll
                        for (int q = 0; q < 4; ++q) { acc[r * 16 + 4 * q + 0] += xg * wv[q][0]; acc[r * 16 + 4 * q + 1] += xg * wv[q][1]; acc[r * 16 + 4 * q + 2] += xg * wv[q][2]; acc[r * 16 + 4 * q + 3] += xg * wv[q][3]; } }
                    if (c & 1) asm volatile("" ::: "memory");
                }
#pragma unroll
            for (int n = 16, m = 32; n >= 1; n >>= 1, m >>= 1) {
                const bool up = (lane & m) != 0;
#pragma unroll
                for (int i = 0; i < n; ++i) { const float a = acc[i], b = acc[i + n]; const float send = up ? a : b, keep = up ? b : a; acc[i] = keep + __shfl_xor(send, m); }
            }
            acc[0] += __shfl_xor(acc[0], 1);
            const int idx = lane >> 1;
            if ((lane & 1) == 0) glr_s[(8 * w + 2 * p + (idx >> 4)) * 16 + (idx & 15)] = acc[0] * ((idx >> 4) ? rs2[1] : rs2[0]);
        }
    }
    LDS_WAIT(); __syncthreads();
    {
        const int c0 = F.tid, c1 = F.tid + 512;
        float wa[16], wb[16];
#pragma unroll
        for (int j = 0; j < 16; ++j) { wa[j] = w2[j * GL_KW + c0]; wb[j] = w2[j * GL_KW + c1]; }
        const float ba = gb[c0], bb = gb[c1]; float ra = 0.f, rb = 0.f;
        for (int r = 0; r < 64; ++r) {
            float za = ba, zb = bb;
#pragma unroll
            for (int q = 0; q < 4; ++q) { const f32x4 gv = *(const LAS f32x4*)(glr_s + r * 16 + 4 * q);
                za += gv[0] * wa[4 * q] + gv[1] * wa[4 * q + 1] + gv[2] * wa[4 * q + 2] + gv[3] * wa[4 * q + 3];
                zb += gv[0] * wb[4 * q] + gv[1] * wb[4 * q + 1] + gv[2] * wb[4 * q + 2] + gv[3] * wb[4 * q + 3]; }
            ra += log_sigmoid_f(za) * (1.0f / 16.0f); rb += log_sigmoid_f(zb) * (1.0f / 16.0f);
            bcum[(size_t)(t0 + r) * GL_KW + c0] = ra; bcum[(size_t)(t0 + r) * GL_KW + c1] = rb;
        }
    }
    LDS_WAIT(); __syncthreads();
}

__device__ __forceinline__ void p0_prologue(Frame& F, int rep = 0) {
    if (rep != 1) for (int ci = F.vcu; ci < TOK / CHUNK; ci += F.G) p0_chunk_job(F, ci);
    if (F.vcu == F.G - 1 && F.wave == 0) {
        const float* q1 = F.in[5]; const float* k1 = F.in[6]; const float* q2 = F.in[7]; const float* k2 = F.in[8];
        float s1 = q1[F.lane] * k1[F.lane] + q1[F.lane + 64] * k1[F.lane + 64], s2 = q2[F.lane] * k2[F.lane] + q2[F.lane + 64] * k2[F.lane + 64];
        s1 = wave_sum(s1); s2 = wave_sum(s2);
        if (F.lane == 0) { const float lam = expf(s1) - expf(s2) + 0.2f; ((unsigned*)(F.ws + WS_CTL))[CW_LAM] = __float_as_uint(lam); }
    }
    LAS float* scr = (LAS float*)(F.lds + F.wave * 16640);
    const int nch = TOK / CHUNK, ncv = (F.G > nch) ? F.G - nch : F.G;
    const int gw = ((F.G > nch) ? F.vcu - nch : F.vcu) * 8 + F.wave, NGW = ncv * 8;
    constexpr int I0 = 32 * 192, I1 = 32 * 64, I2 = 32 * 32, I6 = 4 * 32;
    constexpr int NITEMS = I0 + I1 + 4 * I2 + I6;
    struct It { const float* W; unsigned char* WT; int ldw, Kdst, kb, nb, f8; };
    auto decode = [&](int r) -> It {
        if (r < I0) return It{F.in[2], F.ws + WS_WTIN, IN_W, DM, r / 192, r % 192, 0}; r -= I0;
        if (r < I1) return It{F.in[15], F.ws + WS_WTMG8, 2 * DM, DM, r / 64, r % 64, 1}; r -= I1;
        if (r < I2) return It{F.in[13], F.ws + WS_WTBR, DM, 2 * DM, r / 32, r % 32, 0}; r -= I2;
        if (r < I2) return It{F.in[14], F.ws + WS_WTBR + 2 * DM, DM, 2 * DM, r / 32, r % 32, 0}; r -= I2;
        if (r < I2) return It{F.in[17], F.ws + WS_WTOUT, DM, DM, r / 32, r % 32, 0}; r -= I2;
        if (r < I2) return It{F.in[27], F.ws + WS_WTPLEG, DM, DM, r / 32, r % 32, 1}; r -= I2;
        return It{F.in[28], F.ws + WS_WTPLEUP, DM, PLE, r / 32, r % 32, 0};
    };
    for (int it = ((gw >= 0 && rep != 2) ? gw : NITEMS); it < NITEMS; it += 2 * NGW) {
        const int it2 = it + NGW; const bool two = it2 < NITEMS;
        const It a = decode(it), b = decode(two ? it2 : it);
        f32x4 va[16], vb[16];
        p0_tr_load(va, a.W, a.ldw, a.kb, a.nb, F.lane); p0_tr_load(vb, b.W, b.ldw, b.kb, b.nb, F.lane);
        if (a.f8) p0_tr_finish8(va, a.Kdst, a.WT, 0, scr, a.kb, a.nb, F.lane); else p0_tr_finish(va, a.Kdst, (bf16_t*)a.WT, 0, scr, a.kb, a.nb, F.lane);
        if (two) { if (b.f8) p0_tr_finish8(vb, b.Kdst, b.WT, 0, scr, b.kb, b.nb, F.lane); else p0_tr_finish(vb, b.Kdst, (bf16_t*)b.WT, 0, scr, b.kb, b.nb, F.lane); }
    }
    LDS_WAIT(); __syncthreads();
}

constexpr int CV_GU = 32 * 32 * 64, CV_DN = 32 * 32 * 32, CV_NIT = CV_GU + CV_DN;
__device__ __forceinline__ void moe_item(int it, const Frame& F, const float*& W, int& ldw, int& Kdst, bf16_t*& WT, size_t& ro, int& kb, int& nb) {
    if (it < CV_GU) { const int e = it / 2048, q = it % 2048; W = F.in[22] + (size_t)e * DM * 2 * DEXP; ldw = 2 * DEXP; Kdst = DM; WT = (bf16_t*)(F.ws + WS_WTGU); ro = (size_t)e * 2 * DEXP; kb = q / 64; nb = q % 64; }
    else { const int r = it - CV_GU, e = r / 1024, q = r % 1024; W = F.in[24] + (size_t)e * DEXP * DM; ldw = DM; Kdst = DEXP; WT = (bf16_t*)(F.ws + WS_WTDN); ro = (size_t)e * DM; kb = q / 32; nb = q % 32; }
}
__device__ __forceinline__ void small_convert(Frame& F, int rank, int nconv) {
    LAS float* scr = (LAS float*)(F.lds + F.wave * 16640);
    const int gw = rank * 8 + F.wave, NGW = nconv * 8;
    for (int it = gw; it < 4 * 1024 + 128; it += NGW) {
        if (it < 1024) p0_transpose_item(F.in[13], DM, 2 * DM, (bf16_t*)(F.ws + WS_WTBR), 0, scr, it / 32, it % 32, F.lane);
        else if (it < 2048) p0_transpose_item(F.in[14], DM, 2 * DM, (bf16_t*)(F.ws + WS_WTBR) + DM, 0, scr, (it - 1024) / 32, it % 32, F.lane);
        else if (it < 3072) p0_transpose_item(F.in[17], DM, DM, (bf16_t*)(F.ws + WS_WTOUT), 0, scr, (it - 2048) / 32, it % 32, F.lane);
        else if (it < 4096) p0_transpose_item(F.in[27], DM, DM, (bf16_t*)(F.ws + WS_WTPLEG), 0, scr, (it - 3072) / 32, it % 32, F.lane);
        else p0_transpose_item(F.in[28], DM, PLE, (bf16_t*)(F.ws + WS_WTPLEUP), 0, scr, (it - 4096) / 32, it % 32, F.lane);
    }
}
__device__ __forceinline__ void moe_convert(Frame& F, int rank, int nconv, int it_lo, int it_hi, bool nostore = false) {
    LAS float* scr = (LAS float*)(F.lds + F.wave * 16640);
    const int gw = rank * 8 + F.wave, NGW = nconv * 8;
    const int NIT = it_hi;
    f32x4 va[16], vb[16];
    const float* W; int ldw, Kdst, kb, nb; bf16_t* WT; size_t ro;
    int it = it_lo + gw;
    if (it < NIT) { moe_item(it, F, W, ldw, Kdst, WT, ro, kb, nb); p0_tr_load(va, W, ldw, kb, nb, F.lane); }
    for (; it < NIT; it += 2 * NGW) {
        const float* W2; int ldw2, Kdst2, kb2, nb2; bf16_t* WT2; size_t ro2;
        const int it2 = it + NGW;
        if (it2 < NIT) { moe_item(it2, F, W2, ldw2, Kdst2, WT2, ro2, kb2, nb2); p0_tr_load(vb, W2, ldw2, kb2, nb2, F.lane); }
        p0_tr_finish8(va, Kdst, (unsigned char*)WT, ro, scr, kb, nb, F.lane, nostore);
        const int it3 = it2 + NGW;
        if (it3 < NIT) { moe_item(it3, F, W, ldw, Kdst, WT, ro, kb, nb); p0_tr_load(va, W, ldw, kb, nb, F.lane); }
        if (it2 < NIT) p0_tr_finish8(vb, Kdst2, (unsigned char*)WT2, ro2, scr, kb2, nb2, F.lane, nostore);
    }
    LDS_WAIT(); __syncthreads();
}

using pg8::Unit;
__device__ __forceinline__ u32x4 pack8(const f32x4 a, const f32x4 b) { u32x4 w; w.x = cvt_pk_bf16(a[0], a[1]); w.y = cvt_pk_bf16(a[2], a[3]); w.z = cvt_pk_bf16(b[0], b[1]); w.w = cvt_pk_bf16(b[2], b[3]); return w; }
__device__ __forceinline__ void unpack8(const u32x4 w, f32x4& a, f32x4& b) { a[0] = bflo(w.x); a[1] = bfhi(w.x); a[2] = bflo(w.y); a[3] = bfhi(w.y); b[0] = bflo(w.z); b[1] = bfhi(w.z); b[2] = bflo(w.w); b[3] = bfhi(w.w); }
__device__ __forceinline__ f32x4 exp4(const f32x4 v) { f32x4 r; r[0] = __expf(v[0]); r[1] = __expf(v[1]); r[2] = __expf(v[2]); r[3] = __expf(v[3]); return r; }
__device__ __forceinline__ f32x4 sig4(const f32x4 v) { f32x4 r; r[0] = fast_sigmoid(v[0]); r[1] = fast_sigmoid(v[1]); r[2] = fast_sigmoid(v[2]); r[3] = fast_sigmoid(v[3]); return r; }

constexpr float QSCALE = 0.08838834764831845f * LOG2E;

struct EpiInProj {
    static constexpr bool PERM = true, AFTER_DRAIN = false, HAS_MID = false;
    bf16_t *q, *k, *v, *gqp, *gqm, *gkp, *gkm, *gv, *sg, *gates;
    const float *gqn, *gkn, *bcum, *bmerge;
    LAS float* ex;
    __device__ __forceinline__ void operator()(const f32x4 (&acc)[2][2][4][2], const Unit& u, int wr, int wc, int fr, int fq) const {
        const int pn = u.pn, cl = wc * 32 + 8 * fq;
        const size_t row0 = (size_t)u.pm * 256 + wr * 64 + fr;
        if (pn < 16) {
#pragma unroll
            for (int ai = 0; ai < 2; ++ai)
#pragma unroll
                for (int m = 0; m < 4; ++m)
#pragma unroll
                    for (int bj = 0; bj < 2; ++bj) {
                        const f32x4 a = acc[ai][bj][m][0], b = acc[ai][bj][m][1];
                        float s = (a[0] * a[0] + a[1] * a[1]) + (a[2] * a[2] + a[3] * a[3]) + (b[0] * b[0] + b[1] * b[1]) + (b[2] * b[2] + b[3] * b[3]);
                        s += __shfl_xor(s, 16); s += __shfl_xor(s, 32);
                        if (fq == 0) ex[((ai * 128 + wr * 64 + m * 16 + fr) * 2 + bj) * 4 + wc] = s;
                    }
            LDS_WAIT(); __builtin_amdgcn_s_barrier(); asm volatile("" ::: "memory");
            const float* gn = (pn < 8) ? gqn : gkn; const float sc = (pn < 8) ? QSCALE : 1.0f;
            const f32x4 g0 = *(const f32x4*)(gn + cl), g1 = *(const f32x4*)(gn + cl + 4);
            bf16_t* base = ((pn < 8) ? q : k) + (pn & 7) * 256 + cl;
#pragma unroll
            for (int ai = 0; ai < 2; ++ai)
#pragma unroll
                for (int m = 0; m < 4; ++m) {
                    const int rl = ai * 128 + wr * 64 + m * 16 + fr;
#pragma unroll
                    for (int bj = 0; bj < 2; ++bj) {
                        const f32x4 p4 = *(const LAS f32x4*)(ex + (rl * 2 + bj) * 4);
                        const float rs = rsqrtf(((p4[0] + p4[1]) + (p4[2] + p4[3])) * (1.0f / 128.0f) + RMS_EPS) * sc;
                        *(u32x4*)(base + (row0 + ai * 128 + m * 16) * DM + bj * 128) = pack8(acc[ai][bj][m][0] * rs * g0, acc[ai][bj][m][1] * rs * g1);
                    }
                }
            return;
        }
        if (pn < 24 || (pn >= 32 && pn < 48)) {
            bf16_t* base = (pn < 24) ? v + (pn - 16) * 256 : (pn < 40 ? gv + (pn - 32) * 256 : sg + (pn - 40) * 256);
            const bool silu = pn >= 40;
            base += cl;
#pragma unroll
            for (int ai = 0; ai < 2; ++ai)
#pragma unroll
                for (int m = 0; m < 4; ++m)
#pragma unroll
                    for (int bj = 0; bj < 2; ++bj) {
                        f32x4 a = acc[ai][bj][m][0], b = acc[ai][bj][m][1];
                        if (silu) { a = a * sig4(a); b = b * sig4(b); }
                        *(u32x4*)(base + (row0 + ai * 128 + m * 16) * DM + bj * 128) = pack8(a, b);
                    }
            return;
        }
        if (pn < 32) {
            const bool isq = pn < 28; const int cg = ((pn - 24) & 3) * 256 + cl;
            bf16_t* bp = (isq ? gqp : gkp) + cg; bf16_t* bm = (isq ? gqm : gkm) + cg; const float sc = isq ? 0.0625f : 1.0f;
#pragma unroll
            for (int ai = 0; ai < 2; ++ai)
#pragma unroll
                for (int m = 0; m < 4; ++m)
#pragma unroll
                    for (int bj = 0; bj < 2; ++bj) {
                        const size_t r = row0 + ai * 128 + m * 16;
                        const f32x4 b0 = *(const f32x4*)(bcum + r * GL_KW + cg + bj * 128), b1 = *(const f32x4*)(bcum + r * GL_KW + cg + bj * 128 + 4);
                        const f32x4 a = acc[ai][bj][m][0] * sc, b = acc[ai][bj][m][1] * sc;
                        *(u32x4*)(bp + r * GL_KW + bj * 128) = pack8(a * exp4(b0), b * exp4(b1));
                        *(u32x4*)(bm + r * GL_KW + bj * 128) = pack8(a * exp4(-b0), b * exp4(-b1));
                    }
            return;
        }
    }
};
struct EpiGates {
    static constexpr bool PERM = true, AFTER_DRAIN = false, HAS_MID = false;
    bf16_t* gates; const float* bmerge;
    __device__ __forceinline__ void operator()(const f32x4 (&acc)[2][2][4][2], const Unit& u, int wr_, int wc_, int fr_, int fq_) const {
        int fr = fr_, fq = fq_, wr = wr_, wc = wc_; asm volatile("" : "+v"(fr), "+v"(fq), "+v"(wr), "+v"(wc));
        const int cg = u.pn * 256 + wc * 32 + 8 * fq;
        const size_t row0 = (size_t)u.pm * 256 + wr * 64 + fr;
#pragma unroll
        for (int bj = 0; bj < 2; ++bj) {
            const f32x4 bb0 = *(const f32x4*)(bmerge + cg + bj * 128), bb1 = *(const f32x4*)(bmerge + cg + bj * 128 + 4);
#pragma unroll
            for (int ai = 0; ai < 2; ++ai)
#pragma unroll
                for (int m = 0; m < 4; ++m)
                    *(u32x4*)(gates + (row0 + ai * 128 + m * 16) * (2 * DM) + cg + bj * 128) = pack8(sig4(acc[ai][bj][m][0] * W8_INV + bb0), sig4(acc[ai][bj][m][1] * W8_INV + bb1));
        }
    }
};

struct EpiMixed2 {
    static constexpr bool PERM = true, AFTER_DRAIN = false, HAS_MID = true;
    const bf16_t* gates; bf16_t* mixed;
    __device__ __forceinline__ void mid(f32x4 (&acc)[2][2][4][2], const Unit& u, int wr, int wc, int fr_, int fq_) const {
        int fr = fr_, fq = fq_; asm volatile("" : "+v"(fr), "+v"(fq));
        const size_t row0 = (size_t)u.pm * 256 + wr * 64 + fr; const int c0 = u.pn * 256 + wc * 32 + 8 * fq;
#pragma unroll
        for (int ai = 0; ai < 2; ++ai)
#pragma unroll
            for (int m = 0; m < 4; ++m)
#pragma unroll
                for (int bj = 0; bj < 2; ++bj) {
                    const size_t r = row0 + ai * 128 + m * 16; const int c = c0 + bj * 128;
                    f32x4 da, db, ga, gb; unpack8(*(const u32x4*)(gates + r * (2 * DM) + c), da, db); unpack8(*(const u32x4*)(gates + r * (2 * DM) + DM + c), ga, gb);
#pragma unroll
                    for (int j = 0; j < 4; ++j) { acc[ai][bj][m][0][j] *= da[j] * __builtin_amdgcn_rcpf(fmaxf(ga[j], 1e-30f)); acc[ai][bj][m][1][j] *= db[j] * __builtin_amdgcn_rcpf(fmaxf(gb[j], 1e-30f)); }
                    asm volatile("" ::: "memory");
                }
    }
    __device__ __forceinline__ void operator()(const f32x4 (&acc)[2][2][4][2], const Unit& u, int wr, int wc, int fr, int fq) const {
        const size_t row0 = (size_t)u.pm * 256 + wr * 64 + fr; const int c0 = u.pn * 256 + wc * 32 + 8 * fq;
#pragma unroll
        for (int ai = 0; ai < 2; ++ai)
#pragma unroll
            for (int m = 0; m < 4; ++m)
#pragma unroll
                for (int bj = 0; bj < 2; ++bj) {
                    const size_t r = row0 + ai * 128 + m * 16; const int c = c0 + bj * 128;
                    f32x4 ga, gb; unpack8(*(const u32x4*)(gates + r * (2 * DM) + DM + c), ga, gb);
#pragma unroll
                    for (int j = 0; j < 4; ++j) { ga[j] = fmaxf(ga[j], 1e-30f); gb[j] = fmaxf(gb[j], 1e-30f); }
                    *(u32x4*)(mixed + r * DM + c) = pack8(acc[ai][bj][m][0] * ga, acc[ai][bj][m][1] * gb);
                }
    }
};
struct EpiX1 {
    static constexpr bool PERM = false, AFTER_DRAIN = false, HAS_MID = false;
    const float* x; float* x1;
    __device__ __forceinline__ void operator()(const f32x4 (&acc)[2][2][4][2], const Unit& u, int wr, int wc, int fr, int fq) const {
        const size_t row0 = (size_t)u.pm * 256 + wr * 64 + fr; const int c0 = u.pn * 256 + wc * 32 + 4 * fq;
#pragma unroll
        for (int ai = 0; ai < 2; ++ai)
#pragma unroll
            for (int m = 0; m < 4; ++m)
#pragma unroll
                for (int bj = 0; bj < 2; ++bj)
#pragma unroll
                    for (int n = 0; n < 2; ++n) { const size_t o = (row0 + ai * 128 + m * 16) * DM + c0 + bj * 128 + n * 16;
                        *(f32x4*)(x1 + o) = *(const f32x4*)(x + o) + acc[ai][bj][m][n]; if (n) asm volatile("" ::: "memory"); }
    }
};
struct EpiOut {
    static constexpr bool PERM = false, AFTER_DRAIN = false, HAS_MID = false;
    const float* x2; const bf16_t* pnorm; float* out; float sc;
    __device__ __forceinline__ void operator()(const f32x4 (&acc)[2][2][4][2], const Unit& u, int wr, int wc, int fr_, int fq_) const {
        int fr = fr_, fq = fq_; asm volatile("" : "+v"(fr), "+v"(fq));
        const size_t row0 = (size_t)u.pm * 256 + wr * 64 + fr; const int c0 = u.pn * 256 + wc * 32 + 4 * fq;
#pragma unroll
        for (int ai = 0; ai < 2; ++ai)
#pragma unroll
            for (int m = 0; m < 4; ++m)
#pragma unroll
                for (int bj = 0; bj < 2; ++bj)
#pragma unroll
                    for (int n = 0; n < 2; ++n) { const size_t o = (row0 + ai * 128 + m * 16) * DM + c0 + bj * 128 + n * 16;
                        const u32x2 pw = *(const u32x2*)(pnorm + o); f32x4 pv; pv[0] = bflo(pw.x); pv[1] = bfhi(pw.x); pv[2] = bflo(pw.y); pv[3] = bfhi(pw.y);
                        *(f32x4*)(out + o) = *(const f32x4*)(x2 + o) + pv * sig4(acc[ai][bj][m][n] * sc); asm volatile("" ::: "memory"); }
    }
};
struct EpiGU {
    static constexpr bool PERM = true, AFTER_DRAIN = false, HAS_MID = false;
    const float* bgu; bf16_t* act;
    __device__ __forceinline__ void operator()(const f32x4 (&acc)[2][2][4][2], const Unit& u, int wr, int wc, int fr, int fq) const {
        const size_t row0 = (size_t)u.pm * 256 + wr * 64 + fr; const int e = u.pn >> 4, n16 = u.pn & 15, cl = wc * 32 + 8 * fq;
#pragma unroll
        for (int bj = 0; bj < 2; ++bj) {
            const float* bp = bgu + (size_t)e * (2 * DEXP) + n16 * 256 + bj * 128 + cl;
            const f32x4 b0 = *(const f32x4*)bp, b1 = *(const f32x4*)(bp + 4);
#pragma unroll
            for (int ai = 0; ai < 2; ++ai)
#pragma unroll
                for (int m = 0; m < 4; ++m) {
                    const f32x4 a = acc[ai][bj][m][0] + b0, b = acc[ai][bj][m][1] + b1;
                    float o[4];
#pragma unroll
                    for (int p = 0; p < 4; ++p) { const float gt = fminf(p < 2 ? a[2 * p] : b[2 * p - 4], 7.0f); const float up = fminf(fmaxf(p < 2 ? a[2 * p + 1] : b[2 * p - 3], -7.0f), 7.0f);
                        o[p] = (up + 1.0f) * gt * fast_sigmoid(1.702f * gt); }
                    u32x2 w; w.x = cvt_pk_bf16(o[0], o[1]); w.y = cvt_pk_bf16(o[2], o[3]);
                    *(u32x2*)(act + (row0 + ai * 128 + m * 16) * DEXP + n16 * 128 + bj * 64 + (cl >> 1)) = w;
                }
        }
    }
};
struct EpiGU8 {
    static constexpr bool PERM = true, AFTER_DRAIN = false, HAS_MID = false;
    const float* bgu; unsigned char* act;
    __device__ __forceinline__ void operator()(const f32x4 (&acc)[2][2][4][2], const Unit& u, int wr, int wc, int fr, int fq) const {
        const size_t row0 = (size_t)u.pm * 256 + wr * 64 + fr; const int e = u.pn >> 4, n16 = u.pn & 15, cl = wc * 32 + 8 * fq;
#pragma unroll
        for (int bj = 0; bj < 2; ++bj) {
            const float* bp = bgu + (size_t)e * (2 * DEXP) + n16 * 256 + bj * 128 + cl;
            const f32x4 b0 = *(const f32x4*)bp, b1 = *(const f32x4*)(bp + 4);
#pragma unroll
            for (int ai = 0; ai < 2; ++ai)
#pragma unroll
                for (int m = 0; m < 4; ++m) {
                    const f32x4 a = acc[ai][bj][m][0] * W8_INV + b0, b = acc[ai][bj][m][1] * W8_INV + b1;
                    float o[4];
#pragma unroll
                    for (int p = 0; p < 4; ++p) { const float gt = fminf(p < 2 ? a[2 * p] : b[2 * p - 4], 7.0f); const float up = fminf(fmaxf(p < 2 ? a[2 * p + 1] : b[2 * p - 3], -7.0f), 7.0f);
                        o[p] = (up + 1.0f) * gt * fast_sigmoid(1.702f * gt); }
                    *(unsigned*)(act + (row0 + ai * 128 + m * 16) * DEXP + n16 * 128 + bj * 64 + (cl >> 1)) = pack_fp8x4(o[0], o[1], o[2], o[3]);
                }
        }
    }
};
struct EpiDN8 {
    static constexpr bool PERM = true, AFTER_DRAIN = false, HAS_MID = false;
    const float* bdn; bf16_t* yb;
    __device__ __forceinline__ void operator()(const f32x4 (&acc)[2][2][4][2], const Unit& u, int wr, int wc, int fr, int fq) const {
        const size_t row0 = (size_t)u.pm * 256 + wr * 64 + fr; const int e = u.pn >> 3, n8 = u.pn & 7, cl = wc * 32 + 8 * fq;
#pragma unroll
        for (int bj = 0; bj < 2; ++bj) {
            const int c = n8 * 256 + bj * 128 + cl;
            const f32x4 b0 = *(const f32x4*)(bdn + (size_t)e * DM + c), b1 = *(const f32x4*)(bdn + (size_t)e * DM + c + 4);
#pragma unroll
            for (int ai = 0; ai < 2; ++ai)
#pragma unroll
                for (int m = 0; m < 4; ++m)
                    *(u32x4*)(yb + (row0 + ai * 128 + m * 16) * DM + c) = pack8(acc[ai][bj][m][0] * W8_INV + b0, acc[ai][bj][m][1] * W8_INV + b1);
        }
    }
};
struct EpiDN {
    static constexpr bool PERM = true, AFTER_DRAIN = false, HAS_MID = false;
    const float* bdn; bf16_t* yb;
    __device__ __forceinline__ void operator()(const f32x4 (&acc)[2][2][4][2], const Unit& u, int wr, int wc, int fr, int fq) const {
        const size_t row0 = (size_t)u.pm * 256 + wr * 64 + fr; const int e = u.pn >> 3, n8 = u.pn & 7, cl = wc * 32 + 8 * fq;
#pragma unroll
        for (int bj = 0; bj < 2; ++bj) {
            const int c = n8 * 256 + bj * 128 + cl;
            const f32x4 b0 = *(const f32x4*)(bdn + (size_t)e * DM + c), b1 = *(const f32x4*)(bdn + (size_t)e * DM + c + 4);
#pragma unroll
            for (int ai = 0; ai < 2; ++ai)
#pragma unroll
                for (int m = 0; m < 4; ++m)
                    *(u32x4*)(yb + (row0 + ai * 128 + m * 16) * DM + c) = pack8(acc[ai][bj][m][0] + b0, acc[ai][bj][m][1] + b1);
        }
    }
};

struct GroupedOrder {
    const LAS int* mtoff;
    int nN, lo, hi, r, step;
    __device__ __forceinline__ void init(const LAS int* mt, int nN_, int G, int c) {
        mtoff = mt; nN = nN_; const int U = mt[32] * nN_;
        if ((G & 7) == 0) { const int per = (U + 7) >> 3, xcd = c & 7; lo = xcd * per; hi = (lo + per < U) ? lo + per : U; r = c >> 3; step = G >> 3; }
        else { lo = 0; hi = U; r = c; step = G; }
    }
    __device__ __forceinline__ bool next(int i, Unit& u) const {
        const int L = lo + i * step + r; if (L >= hi) return false;
        int e = 0;
#pragma unroll 1
        for (int j = 1; j < 32; ++j) if (L >= mtoff[j] * nN) e = j;
        const int mt = mtoff[e + 1] - mtoff[e], rem = L - mtoff[e] * nN, n = rem / mt, m = rem - n * mt;
        u.pm = __builtin_amdgcn_readfirstlane(mtoff[e] + m); u.pn = __builtin_amdgcn_readfirstlane(e * nN + n); u.flags = __builtin_amdgcn_readfirstlane((mtoff[34 + e] - 256 * m <= 128) ? 1 : 0); return true;
    }
    __device__ __forceinline__ void a_ready(const Unit&) const {}
    __device__ __forceinline__ void done(const Unit&) const {}
};

__device__ __forceinline__ bf16x8 pk8(const float a0, const float a1, const float a2, const float a3, const float a4, const float a5, const float a6, const float a7) {
    u32x4 w; w.x = cvt_pk_bf16(a0, a1); w.y = cvt_pk_bf16(a2, a3); w.z = cvt_pk_bf16(a4, a5); w.w = cvt_pk_bf16(a6, a7); return __builtin_bit_cast(bf16x8, w); }
constexpr int ATT_STAGE = 65536, ATT_K1 = 16384, ATT_V = 32768;
constexpr float ATT_THR = 8.0f;

struct AttnOffs { unsigned k, v; };
__device__ __forceinline__ AttnOffs attn_offs(int lane, int w) {
    AttnOffs o;
    { const int key = 4 * w + (lane >> 4), ch = (lane & 15) ^ (key & 7); o.k = (unsigned)(key * DM + ch * 8) * 2u; }
    { const int key = 2 * w + (lane >> 5), ch = (lane & 31) ^ ((key & 3) << 2); o.v = (unsigned)(key * DM + ch * 8) * 2u; }
    return o;
}
__device__ __forceinline__ void attn_issue_tile(const Frame& F, const AttnOffs& ao, const char* kg, const char* vg, int stage) {
    const int w = F.wave;
    unsigned ok = ao.k, ov = ao.v; asm volatile("" : "+v"(ok), "+v"(ov));
#pragma unroll
    for (int c = 0; c < 2; ++c)
#pragma unroll
        for (int i = 0; i < 2; ++i) {
            const char* kp = kg + c * 256 + i * (32 * DM * 2); asm volatile("" : "+s"(kp));
            __builtin_amdgcn_global_load_lds((const unsigned*)(kp + ok), (LAS unsigned*)(F.lds + stage * ATT_STAGE + c * ATT_K1 + (w + 8 * i) * 1024), 16, 0, 0); }
#pragma unroll
    for (int i = 0; i < 4; ++i) {
        const char* vp = vg + i * (16 * DM * 2); asm volatile("" : "+s"(vp));
        __builtin_amdgcn_global_load_lds((const unsigned*)(vp + ov), (LAS unsigned*)(F.lds + stage * ATT_STAGE + ATT_V + (w + 8 * i) * 1024), 16, 0, 0); }
}

__device__ __forceinline__ void attn_unit(const Frame& F, int b, int h, int qb, float lam) {
    const bf16_t* Qg = (const bf16_t*)(F.ws + WS_Q); const bf16_t* Kg = (const bf16_t*)(F.ws + WS_K); const bf16_t* Vg = (const bf16_t*)(F.ws + WS_V);
    bf16_t* Y = (bf16_t*)(F.ws + WS_YCAT);
    int lane; asm volatile("v_mbcnt_lo_u32_b32 %0, -1, 0\n\tv_mbcnt_hi_u32_b32 %0, -1, %0" : "=v"(lane));
    const int w = F.wave, c = w >> 2, r0 = (w & 3) * 32, hi = lane >> 5, ql = lane & 31;
    const int NT = 2 * qb + 2, jlast = 2 * qb + (r0 >> 6);
    const size_t tok0 = (size_t)b * SEQ;
    const char* kbase = (const char*)(Kg + tok0 * DM + h * 256); const char* vbase = (const char*)(Vg + tok0 * DM + h * 256);
    const AttnOffs ao = attn_offs(lane, w);
    bf16x8 qf[8];
    { const char* qbase = (const char*)(Qg + (tok0 + qb * 128 + r0) * DM + h * 256 + c * 128); const unsigned qo = (unsigned)(ql * DM + 8 * hi) * 2u;
#pragma unroll
      for (int st = 0; st < 8; ++st) qf[st] = *(const bf16x8*)(qbase + qo + 32 * st); }
    attn_issue_tile(F, ao, kbase, vbase, 0);
    f32x16 o[8];
#pragma unroll
    for (int d = 0; d < 8; ++d)
#pragma unroll
        for (int r = 0; r < 16; ++r) o[d][r] = 0.f;
    float m_run = -1e30f, l_run = 0.f;
    const float slope = exp2f(-(float)(h + 1)) * LOG2E;
    const float tpos = (float)(qb * 128 + r0 + ql);
    const int kx = (ql & 7) << 4;
    const int koff = ql * 256;
    const int g1 = (lane >> 4) & 1, qq = (lane & 15) >> 2, pp = lane & 3;
    const int voff = (4 * hi + qq) * 512 + 32 * g1 + 16 * (pp >> 1) + 8 * (pp & 1);
    VM_WAIT(); __builtin_amdgcn_s_barrier(); asm volatile("" ::: "memory");
#define ATT_TR(dst, addr, off) asm volatile("ds_read_b64_tr_b16 %0, %1 offset:%2" : "=v"(dst) : "v"(addr), "n"(off))
#define ATT_VLOAD4(buf, A, dd, kh_) do { ATT_TR(buf[0], A, ((dd) >> 2) * 256 + (2 * (kh_)) * 8192); ATT_TR(buf[1], A, ((dd) >> 2) * 256 + (2 * (kh_)) * 8192 + 4096); \
        ATT_TR(buf[2], A, ((dd) >> 2) * 256 + (2 * (kh_) + 1) * 8192); ATT_TR(buf[3], A, ((dd) >> 2) * 256 + (2 * (kh_) + 1) * 8192 + 4096); } while (0)
#define ATT_VLOAD(buf, dd, kh_) do { if (((dd) & 3) == 0) ATT_VLOAD4(buf, va0, dd, kh_); else if (((dd) & 3) == 1) ATT_VLOAD4(buf, va1, dd, kh_); else if (((dd) & 3) == 2) ATT_VLOAD4(buf, va2, dd, kh_); else ATT_VLOAD4(buf, va3, dd, kh_); } while (0)
#define ATT_TILE(j, st_) do { \
        const int jj_ = (j); \
        if (jj_ + 1 < NT) attn_issue_tile(F, ao, kbase + (size_t)(jj_ + 1) * 64 * DM * 2, vbase + (size_t)(jj_ + 1) * 64 * DM * 2, st_ ^ 1); \
        if (jj_ <= jlast) { \
            const LAS unsigned char* Ks = F.lds + st_ * ATT_STAGE + c * ATT_K1; \
            const unsigned vbase = (unsigned)(size_t)(F.lds + st_ * ATT_STAGE + ATT_V) + (unsigned)voff; \
            const unsigned va0 = vbase + ((0 ^ qq) << 6), va1 = vbase + ((1 ^ qq) << 6), va2 = vbase + ((2 ^ qq) << 6), va3 = vbase + ((3 ^ qq) << 6); \
_Pragma("unroll") \
            for (int kh = 0; kh < 2; ++kh) {                            \
                f32x16 p0; \
_Pragma("unroll") \
                for (int r = 0; r < 16; ++r) p0[r] = 0.f; \
bf16x8 kf[4], kg_[4]; \
_Pragma("unroll") \
                for (int st = 0; st < 4; ++st) { const int co = ((2 * st + hi) << 4) ^ kx; kf[st] = *(const LAS bf16x8*)(Ks + kh * 8192 + koff + co); } \
                __builtin_amdgcn_sched_barrier(0); \
_Pragma("unroll") \
                for (int st = 0; st < 4; ++st) { const int co = ((2 * (st + 4) + hi) << 4) ^ kx; kg_[st] = *(const LAS bf16x8*)(Ks + kh * 8192 + koff + co); } \
_Pragma("unroll") \
                for (int st = 0; st < 4; ++st) p0 = __builtin_amdgcn_mfma_f32_32x32x16_bf16(kf[st], qf[st], p0, 0, 0, 0); \
                __builtin_amdgcn_sched_barrier(0); \
_Pragma("unroll") \
                for (int st = 0; st < 4; ++st) p0 = __builtin_amdgcn_mfma_f32_32x32x16_bf16(kg_[st], qf[st + 4], p0, 0, 0, 0); \
                __builtin_amdgcn_sched_barrier(0); \
                 \
                const float dq = tpos - (float)(64 * jj_ + 32 * kh + 4 * hi); \
                float mx = -1e30f; \
_Pragma("unroll") \
                for (int r = 0; r < 16; ++r) { const float cr = (float)((r & 3) + 8 * (r >> 2)); \
                    p0[r] = fmaf(-slope, fabsf(dq - cr), p0[r]); mx = fmaxf(mx, p0[r]); } \
                { auto rr_ = __builtin_amdgcn_permlane32_swap(__float_as_uint(mx), __float_as_uint(mx), false, false); mx = fmaxf(__uint_as_float(rr_[0]), __uint_as_float(rr_[1])); } \
                if (!__all(mx - m_run <= ATT_THR)) { \
                    const float mn = fmaxf(m_run, mx), al = __builtin_amdgcn_exp2f(m_run - mn); m_run = mn; l_run *= al; \
_Pragma("unroll") \
                    for (int d = 0; d < 8; ++d) \
_Pragma("unroll") \
                        for (int r = 0; r < 16; ++r) o[d][r] *= al; \
                } \
                float ps = 0.f; \
_Pragma("unroll") \
                for (int r = 0; r < 16; ++r) { p0[r] = __builtin_amdgcn_exp2f(p0[r] - m_run); ps += p0[r]; } \
                l_run += ps; \
                bf16x8 pf[2]; \
                pf[0] = pk8(p0[0], p0[1], p0[2], p0[3], p0[4], p0[5], p0[6], p0[7]); pf[1] = pk8(p0[8], p0[9], p0[10], p0[11], p0[12], p0[13], p0[14], p0[15]); \
                __builtin_amdgcn_sched_barrier(0); \
{ u32x2 vb[4][4]; \
                  ATT_VLOAD(vb[0], 0, kh); ATT_VLOAD(vb[1], 1, kh); ATT_VLOAD(vb[2], 2, kh); \
_Pragma("unroll") \
                  for (int d = 0; d < 8; ++d) { \
                    if (d < 5) { ATT_VLOAD(vb[(d + 3) & 3], d + 3, kh); asm volatile("s_waitcnt lgkmcnt(12)" ::: "memory"); } \
                    else if (d == 5) asm volatile("s_waitcnt lgkmcnt(8)" ::: "memory"); \
                    else if (d == 6) asm volatile("s_waitcnt lgkmcnt(4)" ::: "memory"); \
                    else asm volatile("s_waitcnt lgkmcnt(0)" ::: "memory"); \
                    __builtin_amdgcn_sched_barrier(0); \
                    { u32x4 w0, w1; w0.x = vb[d & 3][0].x; w0.y = vb[d & 3][0].y; w0.z = vb[d & 3][1].x; w0.w = vb[d & 3][1].y; w1.x = vb[d & 3][2].x; w1.y = vb[d & 3][2].y; w1.z = vb[d & 3][3].x; w1.w = vb[d & 3][3].y; \
                      o[d] = __builtin_amdgcn_mfma_f32_32x32x16_bf16(__builtin_bit_cast(bf16x8, w0), pf[0], o[d], 0, 0, 0); \
                      o[d] = __builtin_amdgcn_mfma_f32_32x32x16_bf16(__builtin_bit_cast(bf16x8, w1), pf[1], o[d], 0, 0, 0); } \
                    __builtin_amdgcn_sched_barrier(0); \
                  } } \
            } \
        } \
        VM_WAIT(); LDS_WAIT(); __builtin_amdgcn_s_barrier(); asm volatile("" ::: "memory"); \
    } while (0)
    for (int j = 0; j < NT; j += 2) { ATT_TILE(j, 0); ATT_TILE(j + 1, 1); }
#undef ATT_TILE
#undef ATT_VLOAD
#undef ATT_VLOAD4
#undef ATT_TR
    const float linv = 1.0f / (l_run + __shfl_xor(l_run, 32));
    LAS float* X = (LAS float*)F.lds + (size_t)(w & 3) * 128 * 64 + lane;
    if (c == 1) {
#pragma unroll
        for (int d = 0; d < 8; ++d)
#pragma unroll
            for (int r = 0; r < 16; ++r) X[(d * 16 + r) * 64] = o[d][r] * linv;
    }
    LDS_WAIT(); __builtin_amdgcn_s_barrier(); asm volatile("" ::: "memory");
    if (c == 0) {
        float ss = 0.f;
#pragma unroll
        for (int d = 0; d < 8; ++d) {
#pragma unroll
            for (int r = 0; r < 16; ++r) { const float v = o[d][r] * linv - lam * X[(d * 16 + r) * 64]; o[d][r] = v; ss += v * v; }
            asm volatile("" ::: "memory"); }
        ss += __shfl_xor(ss, 32);
        const float rs = rsqrtf(ss * (1.0f / 256.0f) + RMS_EPS) * 0.8f;
        const float* sg = F.in[9];
        bf16_t* yp = (bf16_t*)((char*)(Y + (tok0 + qb * 128 + r0) * (2 * DM) + h * 256) + (unsigned)(ql * (2 * DM) + 4 * hi) * 2u);
#pragma unroll
        for (int d = 0; d < 8; ++d) {
            asm volatile("" ::: "memory");
#pragma unroll
            for (int r4 = 0; r4 < 4; ++r4) { const int dv = 32 * d + 8 * r4; const f32x4 g = *(const f32x4*)(sg + dv + 4 * hi);
                u32x2 wv; wv.x = cvt_pk_bf16(o[d][4 * r4] * rs * g[0], o[d][4 * r4 + 1] * rs * g[1]); wv.y = cvt_pk_bf16(o[d][4 * r4 + 2] * rs * g[2], o[d][4 * r4 + 3] * rs * g[3]);
                *(u32x2*)(yp + dv) = wv; }
        }
    }
    LDS_WAIT(); __builtin_amdgcn_s_barrier(); asm volatile("" ::: "memory");
}

__device__ __forceinline__ void gla_scores_phase(const Frame& F) {
    const bf16_t* qp = (const bf16_t*)(F.ws + WS_GQP); const bf16_t* qm = (const bf16_t*)(F.ws + WS_GQM);
    const bf16_t* kp = (const bf16_t*)(F.ws + WS_GKP); const bf16_t* km = (const bf16_t*)(F.ws + WS_GKM);
    bf16_t* attc = (bf16_t*)(F.ws + WS_ATTC);
    LAS float* tmp = (LAS float*)F.lds;
    const int lane = F.lane, w = F.wave, which = w >> 2, mi = (w >> 1) & 1, si = w & 1, hi = lane >> 5, l31 = lane & 31;
    for (int unit = blockIdx.x; unit < NB * GL_H * NCH; unit += F.G) {
        const int b = unit >> 8, h = (unit >> 6) & 3, ch = unit & 63;
        const size_t t0 = (size_t)b * SEQ + ch * 64;
        const bf16_t* A = (which ? qm : qp) + (t0 + 32 * mi + l31) * GL_KW + h * 256 + 8 * hi;
        const bf16_t* Bm = (which ? kp : km) + (t0 + 32 * si + l31) * GL_KW + h * 256 + 8 * hi;
        f32x16 acc;
#pragma unroll
        for (int r = 0; r < 16; ++r) acc[r] = 0.f;
#pragma unroll
        for (int st = 0; st < 16; ++st) acc = __builtin_amdgcn_mfma_f32_32x32x16_bf16(*(const bf16x8*)(A + 16 * st), *(const bf16x8*)(Bm + 16 * st), acc, 0, 0, 0);
        const int s = 32 * si + l31;
#pragma unroll
        for (int r = 0; r < 16; ++r) { const int t = 32 * mi + (r & 3) + 8 * (r >> 2) + 4 * hi; const bool keep = which ? (s > t) : (s <= t); acc[r] = keep ? acc[r] : 0.f; }
        if (which) {
#pragma unroll
            for (int r = 0; r < 16; ++r) { const int t = 32 * mi + (r & 3) + 8 * (r >> 2) + 4 * hi; tmp[t * 64 + s] = acc[r]; }
        }
        LDS_WAIT(); __syncthreads();
        if (!which) {
#pragma unroll
            for (int r = 0; r < 16; ++r) { const int t = 32 * mi + (r & 3) + 8 * (r >> 2) + 4 * hi; const float v = acc[r] + tmp[t * 64 + s];
                attc[((size_t)unit * 64 + t) * 64 + s] = (bf16_t)(cvt_pk_bf16(v, 0.f) & 0xffffu); }
        }
        LDS_WAIT(); __syncthreads();
    }
}

constexpr int GL_KST = 544, GL_AST = 144, GL_VST = 272;
constexpr int GL_KM = 0, GL_QP = 64 * GL_KST, GL_AT = 2 * 64 * GL_KST, GL_VV = GL_AT + 64 * GL_AST, GL_DEC = GL_VV + 64 * GL_VST;
__device__ __forceinline__ void gla_scan_unit(const Frame& F, int g) {
    const int b = g >> 4, h = (g >> 2) & 3, vg = g & 3;
    const bf16_t* qp = (const bf16_t*)(F.ws + WS_GQP); const bf16_t* km = (const bf16_t*)(F.ws + WS_GKM);
    const bf16_t* gv = (const bf16_t*)(F.ws + WS_GV); const bf16_t* attc = (const bf16_t*)(F.ws + WS_ATTC);
    const float* bcum = (const float*)(F.ws + WS_BCUM); float* og = (float*)(F.ws + WS_OGLA);
    const int tid = F.tid, lane = F.lane, w = F.wave, gq = lane >> 4, li = lane & 15, q4 = li >> 2, p4 = li & 3;
    f32x4 S[16];
#pragma unroll
    for (int i = 0; i < 16; ++i) S[i] = (f32x4){0.f, 0.f, 0.f, 0.f};
    u32x4 rk[4], rq[4], ra, rv[2]; float rdec = 0.f;
    const size_t tb0 = (size_t)b * SEQ;
#define GLA_LOAD(c) do { const size_t t0_ = tb0 + (size_t)(c) * 64; \
        _Pragma("unroll") for (int i = 0; i < 4; ++i) { const int idx = tid + 512 * i, row = idx >> 5, cc = idx & 31; \
            rk[i] = *(const u32x4*)(km + (t0_ + row) * GL_KW + h * 256 + cc * 8); rq[i] = *(const u32x4*)(qp + (t0_ + row) * GL_KW + h * 256 + cc * 8); } \
        ra = *(const u32x4*)(attc + ((size_t)((b * GL_H + h) * NCH + (c)) * 64 + (tid >> 3)) * 64 + (tid & 7) * 8); \
        _Pragma("unroll") for (int i = 0; i < 2; ++i) { const int idx = tid + 512 * i, row = idx >> 4, cc = idx & 15; \
            rv[i] = *(const u32x4*)(gv + (t0_ + row) * GL_VW + h * 512 + vg * 128 + cc * 8); } \
        if (tid < 256) rdec = bcum[(t0_ + 63) * GL_KW + h * 256 + tid]; } while (0)
    GLA_LOAD(0);
    for (int c = 0; c < NCH; ++c) {
        __syncthreads();
#pragma unroll
        for (int i = 0; i < 4; ++i) { const int idx = tid + 512 * i, row = idx >> 5, cc = idx & 31;
            *(LAS u32x4*)(F.lds + GL_KM + row * GL_KST + cc * 16) = rk[i]; *(LAS u32x4*)(F.lds + GL_QP + row * GL_KST + cc * 16) = rq[i]; }
        *(LAS u32x4*)(F.lds + GL_AT + (tid >> 3) * GL_AST + (tid & 7) * 16) = ra;
#pragma unroll
        for (int i = 0; i < 2; ++i) { const int idx = tid + 512 * i, row = idx >> 4, cc = idx & 15; *(LAS u32x4*)(F.lds + GL_VV + row * GL_VST + cc * 16) = rv[i]; }
        if (tid < 256) *(LAS float*)(F.lds + GL_DEC + tid * 4) = __expf(rdec);
        LDS_WAIT(); __syncthreads();
        if (c + 1 < NCH) GLA_LOAD(c + 1);
        const size_t t0 = tb0 + (size_t)c * 64;
        bf16x8 bv[2];
#pragma unroll
        for (int st = 0; st < 2; ++st) { const LAS unsigned char* p = F.lds + GL_VV + (32 * st + 8 * gq + q4) * GL_VST + (16 * w + 4 * p4) * 2;
            bv[st] = cat8(lds_tr16(p), lds_tr16(p + 4 * GL_VST)); }
        bf16x8 af[2][4];
#pragma unroll
        for (int st = 0; st < 2; ++st)
#pragma unroll
            for (int tb = 0; tb < 4; ++tb) af[st][tb] = *(const LAS bf16x8*)(F.lds + GL_AT + (16 * tb + li) * GL_AST + (32 * st + 8 * gq) * 2);
        f32x4 o[4];
#pragma unroll
        for (int tb = 0; tb < 4; ++tb) o[tb] = (f32x4){0.f, 0.f, 0.f, 0.f};
        u32x4 qa[2][4];
#define GLA_LOADQ(buf, ks_) do { _Pragma("unroll") for (int tb = 0; tb < 4; ++tb) { const LAS unsigned char* p = F.lds + GL_QP + (16 * tb + li) * GL_KST + (32 * (ks_) + 4 * gq) * 2; \
            const u32x2 a0 = *(const LAS u32x2*)p, a1 = *(const LAS u32x2*)(p + 32); buf[tb].x = a0.x; buf[tb].y = a0.y; buf[tb].z = a1.x; buf[tb].w = a1.y; } } while (0)
        GLA_LOADQ(qa[0], 0);
#pragma unroll
        for (int ks = 0; ks < 8; ++ks) {
            if (ks < 7) GLA_LOADQ(qa[(ks + 1) & 1], ks + 1);
            __builtin_amdgcn_sched_barrier(0);
            const bf16x8 sb = pk8(S[2 * ks][0], S[2 * ks][1], S[2 * ks][2], S[2 * ks][3], S[2 * ks + 1][0], S[2 * ks + 1][1], S[2 * ks + 1][2], S[2 * ks + 1][3]);
#pragma unroll
            for (int tb = 0; tb < 4; ++tb) o[tb] = __builtin_amdgcn_mfma_f32_16x16x32_bf16(__builtin_bit_cast(bf16x8, qa[ks & 1][tb]), sb, o[tb], 0, 0, 0);
            __builtin_amdgcn_sched_barrier(0);
        }
#undef GLA_LOADQ
#pragma unroll
        for (int st = 0; st < 2; ++st)
#pragma unroll
            for (int tb = 0; tb < 4; ++tb) o[tb] = __builtin_amdgcn_mfma_f32_16x16x32_bf16(af[st][tb], bv[st], o[tb], 0, 0, 0);
        bf16x8 ak[2][2];
#define GLA_LOADK(buf, kb_) do { _Pragma("unroll") for (int st = 0; st < 2; ++st) { const LAS unsigned char* p = F.lds + GL_KM + (32 * st + 8 * gq + q4) * GL_KST + (16 * (kb_) + 4 * p4) * 2; \
            buf[st] = cat8(lds_tr16(p), lds_tr16(p + 4 * GL_KST)); } } while (0)
        GLA_LOADK(ak[0], 0);
#pragma unroll
        for (int kb = 0; kb < 16; ++kb) {
            if (kb < 15) GLA_LOADK(ak[(kb + 1) & 1], kb + 1);
            const f32x4 d = *(const LAS f32x4*)(F.lds + GL_DEC + (16 * kb + 4 * gq) * 4);
            __builtin_amdgcn_sched_barrier(0);
            S[kb] = __builtin_amdgcn_mfma_f32_16x16x32_bf16(ak[kb & 1][0], bv[0], S[kb], 0, 0, 0);
            S[kb] = __builtin_amdgcn_mfma_f32_16x16x32_bf16(ak[kb & 1][1], bv[1], S[kb], 0, 0, 0);
            S[kb] = S[kb] * d;
            __builtin_amdgcn_sched_barrier(0);
        }
#undef GLA_LOADK
#pragma unroll
        for (int tb = 0; tb < 4; ++tb)
#pragma unroll
            for (int r = 0; r < 4; ++r) og[(t0 + 16 * tb + 4 * gq + r) * GL_VW + h * 512 + vg * 128 + 16 * w + li] = o[tb][r];
    }
#undef GLA_LOAD
    __syncthreads();
}

__device__ __forceinline__ void gla_out_phase(const Frame& F) {
    const float* og = (const float*)(F.ws + WS_OGLA); const bf16_t* sg = (const bf16_t*)(F.ws + WS_SG); bf16_t* yg = (bf16_t*)(F.ws + WS_YCAT) + DM;
    const float* gn = F.in[12];
    const int gw = blockIdx.x * 8 + F.wave, NGW = F.G * 8, lane = F.lane;
    const f32x4 g0 = *(const f32x4*)(gn + 8 * lane), g1 = *(const f32x4*)(gn + 8 * lane + 4);
    for (int rw = gw; rw < TOK * GL_H; rw += NGW) {
        const size_t off = (size_t)rw * 512 + 8 * lane;
        const f32x4 a = *(const f32x4*)(og + off), b = *(const f32x4*)(og + off + 4);
        float ss = (a[0] * a[0] + a[1] * a[1]) + (a[2] * a[2] + a[3] * a[3]) + (b[0] * b[0] + b[1] * b[1]) + (b[2] * b[2] + b[3] * b[3]);
        ss = wave_sum(ss);
        const float rs = rsqrtf(ss * (1.0f / 512.0f) + RMS_EPS);
        f32x4 sa, sb; unpack8(*(const u32x4*)(sg + off), sa, sb);
        *(u32x4*)(yg + (size_t)(rw >> 2) * (2 * DM) + (rw & 3) * 512 + 8 * lane) = pack8(a * rs * g0 * sa, b * rs * g1 * sb);
    }
}

__device__ __forceinline__ void route_phase(const Frame& F, int rep) {
    const float* x1 = (const float*)(F.ws + WS_X1); const float* gf = F.in[19]; const float* wr = F.in[20]; const float* rb = F.in[21];
    bf16_t* h2 = (bf16_t*)(F.ws + WS_H2);
    int* topi = (int*)(F.ws + WS_ROUTE + rep * 524288); float* gate = (float*)(F.ws + WS_ROUTE + 131072 + rep * 524288); int* posn = (int*)(F.ws + WS_ROUTE + 262144 + rep * 524288);
    unsigned* cnt = (unsigned*)(F.ws + WS_CTL) + CW_CNT + rep * 2048;
    const int lane = F.lane, gw = blockIdx.x * 8 + F.wave, NGW = F.G * 8, e = lane & 31, hf = lane >> 5;
    LAS float* wsh = (LAS float*)(F.lds);
    LAS float* hs = (LAS float*)(F.lds + 65536) + F.wave * 2048;
    for (int base = blockIdx.x * 8; base < TOK / 4; base += NGW) {
        const int gp = base + F.wave;
        float lg[4];
        f32x4 xv[4][8];
#pragma unroll
        for (int i = 0; i < 4; ++i) { const float* xrow = x1 + (size_t)(4 * gp + i) * DM + 4 * lane;
#pragma unroll
            for (int j = 0; j < 8; ++j) xv[i][j] = *(const f32x4*)(xrow + 256 * j); }
#pragma unroll
        for (int i = 0; i < 4; ++i) { float ss = 0.f;
#pragma unroll
            for (int j = 0; j < 8; ++j) ss += (xv[i][j][0] * xv[i][j][0] + xv[i][j][1] * xv[i][j][1]) + (xv[i][j][2] * xv[i][j][2] + xv[i][j][3] * xv[i][j][3]);
            ss = wave_sum(ss);
            const float rs = rsqrtf(ss * (1.0f / DM) + RMS_EPS);
            unsigned char* hrow = (unsigned char*)h2 + (size_t)(4 * gp + i) * DM + 4 * lane; const float* gfl = gf + 4 * lane; asm volatile("" : "+v"(hrow), "+v"(gfl));
#pragma unroll
            for (int j = 0; j < 8; ++j) { const f32x4 g = *(const f32x4*)(gfl + 256 * j); const f32x4 hv = xv[i][j] * rs * g; xv[i][j] = hv;
                *(unsigned*)(hrow + 256 * j) = pack_fp8x4(hv[0], hv[1], hv[2], hv[3]); }
        }
        float a[4] = {0.f, 0.f, 0.f, 0.f};
        f32x4 wreg[8];
        { const float* wb = wr + 4 * F.tid; asm volatile("" : "+v"(wb));
#pragma unroll
        for (int m = 0; m < 8; ++m) wreg[m] = *(const f32x4*)(wb + 2048 * m); }
#pragma unroll
        for (int wd = 0; wd < 4; ++wd) {
            __syncthreads();
#pragma unroll
            for (int m = 0; m < 8; ++m) *(LAS f32x4*)(wsh + 4 * (F.tid + 512 * m)) = wreg[m];
            if (wd < 3) { const float* wb = wr + (size_t)(512 * (wd + 1)) * NEXP + 4 * F.tid; asm volatile("" : "+v"(wb));
#pragma unroll
                for (int m = 0; m < 8; ++m) wreg[m] = *(const f32x4*)(wb + 2048 * m); }
#pragma unroll
            for (int i = 0; i < 4; ++i)
#pragma unroll
                for (int jj = 0; jj < 2; ++jj) *(LAS f32x4*)(hs + i * 512 + 4 * (lane + 64 * jj)) = xv[i][2 * wd + jj];
            LDS_WAIT(); __syncthreads();
            const LAS float* wp = wsh + (256 * hf) * NEXP + e; const LAS float* hp = hs + 256 * hf;
#pragma unroll 2
            for (int k = 0; k < 256; k += 4) {
                const float w0 = wp[(k + 0) * NEXP], w1 = wp[(k + 1) * NEXP], w2 = wp[(k + 2) * NEXP], w3 = wp[(k + 3) * NEXP];
#pragma unroll
                for (int i = 0; i < 4; ++i) { const f32x4 h = *(const LAS f32x4*)(hp + i * 512 + k); a[i] += h[0] * w0; a[i] += h[1] * w1; a[i] += h[2] * w2; a[i] += h[3] * w3; }
            }
        }
#pragma unroll
        for (int i = 0; i < 4; ++i) lg[i] = a[i] + __shfl_xor(a[i], 32);
        LAS unsigned* lc = (LAS unsigned*)(F.lds + 131072);
        if (F.tid < 32) lc[F.tid] = 0u;
        LDS_WAIT(); __syncthreads();
        int lr[2][4];
#pragma unroll
        for (int rd = 0; rd < 2; ++rd) {
            const size_t t = (size_t)(4 * gp + 2 * hf + rd);
            float v = (hf ? lg[2 + rd] : lg[rd]) + rb[e];
            float selv[4]; int sele[4];
#pragma unroll
            for (int k = 0; k < TOPK; ++k) {
                float mx = v;
#pragma unroll
                for (int o = 1; o < 32; o <<= 1) mx = fmaxf(mx, __shfl_xor(mx, o));
                int idx = (v == mx) ? e : 64;
#pragma unroll
                for (int o = 1; o < 32; o <<= 1) idx = min(idx, __shfl_xor(idx, o));
                selv[k] = mx; sele[k] = idx;
                if (e == idx) v = -__builtin_inff();
            }
            const float e1 = __expf(selv[1] - selv[0]), e2 = __expf(selv[2] - selv[0]), e3 = __expf(selv[3] - selv[0]);
            const float inv = 1.0f / (1.0f + e1 + e2 + e3);
            const float gk[4] = {inv, e1 * inv, e2 * inv, e3 * inv};
#pragma unroll
            for (int k = 0; k < TOPK; ++k)
                if (e == sele[k]) { lr[rd][k] = (int)__hip_atomic_fetch_add(lc + e, 1u, __ATOMIC_RELAXED, __HIP_MEMORY_SCOPE_WORKGROUP); topi[t * 4 + k] = e; gate[t * 4 + k] = gk[k]; }
                else lr[rd][k] = -1;
        }
        LDS_WAIT(); __syncthreads();
        if (F.tid < 32) { const unsigned n = lc[F.tid]; lc[32 + F.tid] = n ? __hip_atomic_fetch_add(cnt + 64 * F.tid, n, RLX_AGENT) : 0u; }
        LDS_WAIT(); __syncthreads();
        const int rbase = (int)lc[32 + e];
#pragma unroll
        for (int rd = 0; rd < 2; ++rd)
#pragma unroll
            for (int k = 0; k < TOPK; ++k) if (lr[rd][k] >= 0) posn[(size_t)(4 * gp + 2 * hf + rd) * 4 + k] = rbase + lr[rd][k];
    }
}

__device__ __forceinline__ void build_mtoff(const Frame& F, LAS int* mt) {
    const unsigned* cnt = (const unsigned*)(F.ws + WS_CTL) + CW_CNT;
    if (F.wave == 0) {
        const int e = F.lane & 31;
        const unsigned c = __hip_atomic_load(cnt + 64 * e, RLX_AGENT);
        const int nt_ = (int)((c + 255u) >> 8); int incl = nt_;
#pragma unroll
        for (int o = 1; o < 32; o <<= 1) { const int v = __shfl_up(incl, o, 32); if (e >= o) incl += v; }
        if (F.lane < 32) { mt[e] = incl - nt_; mt[34 + e] = (int)c; if (e == 31) mt[NEXP] = incl; }
    }
    LDS_WAIT(); __syncthreads();
}

__device__ __forceinline__ void scatter_phase(const Frame& F, const LAS int* mt) {
    const bf16_t* h2 = (const bf16_t*)(F.ws + WS_H2); bf16_t* xs = (bf16_t*)(F.ws + WS_XS);
    const int* topi = (const int*)(F.ws + WS_ROUTE); const int* posn = (const int*)(F.ws + WS_ROUTE + 262144); int* rowof = (int*)(F.ws + WS_ROUTE + 393216);
    const int lane = F.lane, gw = blockIdx.x * 8 + F.wave, NGW = F.G * 8;
    for (int pi = gw; pi < TOK * TOPK; pi += NGW) {
        const int e = topi[pi], dest = 256 * mt[e] + posn[pi], t = pi >> 2;
        if (lane == 0) rowof[pi] = dest;
#pragma unroll
        for (int j = 0; j < 2; ++j) *(u32x4*)((unsigned char*)xs + (size_t)dest * DM + 16 * (lane + 64 * j)) = *(const u32x4*)((const unsigned char*)h2 + (size_t)t * DM + 16 * (lane + 64 * j));
    }
}

__device__ __forceinline__ void combine_phase(const Frame& F) {
    const float* x1 = (const float*)(F.ws + WS_X1); const bf16_t* yb = (const bf16_t*)(F.ws + WS_YB); float* x2 = (float*)(F.ws + WS_X2);
    bf16_t* h3 = (bf16_t*)(F.ws + WS_H3); const bf16_t* ub = (const bf16_t*)(F.ws + WS_UB); bf16_t* pnb = (bf16_t*)(F.ws + WS_PN);
    const float* gate = (const float*)(F.ws + WS_ROUTE + 131072); const int* rowof = (const int*)(F.ws + WS_ROUTE + 393216);
    const float* gp = F.in[26]; const float* gpost = F.in[29];
    const int lane = F.lane, gw = blockIdx.x * 8 + F.wave, NGW = F.G * 8;
    for (int t = gw; t < TOK; t += NGW) {
        f32x4 xa[4], xb[4];
#pragma unroll
        for (int j = 0; j < 4; ++j) { xa[j] = *(const f32x4*)(x1 + (size_t)t * DM + 8 * (lane + 64 * j)); xb[j] = *(const f32x4*)(x1 + (size_t)t * DM + 8 * (lane + 64 * j) + 4); }
#pragma unroll
        for (int k = 0; k < TOPK; ++k) { const float g = gate[t * 4 + k]; const size_t r = (size_t)rowof[t * 4 + k];
#pragma unroll
            for (int j = 0; j < 4; ++j) { f32x4 ya, ybv; unpack8(*(const u32x4*)(yb + r * DM + 8 * (lane + 64 * j)), ya, ybv); xa[j] += g * ya; xb[j] += g * ybv; } }
        float ss = 0.f;
#pragma unroll
        for (int j = 0; j < 4; ++j) { *(f32x4*)(x2 + (size_t)t * DM + 8 * (lane + 64 * j)) = xa[j]; *(f32x4*)(x2 + (size_t)t * DM + 8 * (lane + 64 * j) + 4) = xb[j];
            ss += (xa[j][0] * xa[j][0] + xa[j][1] * xa[j][1]) + (xa[j][2] * xa[j][2] + xa[j][3] * xa[j][3]) + (xb[j][0] * xb[j][0] + xb[j][1] * xb[j][1]) + (xb[j][2] * xb[j][2] + xb[j][3] * xb[j][3]); }
        ss = wave_sum(ss);
        const float rs = rsqrtf(ss * (1.0f / DM) + RMS_EPS);
#pragma unroll
        for (int j = 0; j < 4; ++j) { const f32x4 g0 = *(const f32x4*)(gp + 8 * (lane + 64 * j)), g1 = *(const f32x4*)(gp + 8 * (lane + 64 * j) + 4);
            const f32x4 ha_ = xa[j] * rs * g0, hb_ = xb[j] * rs * g1; u32x2 w8; w8.x = pack_fp8x4(ha_[0], ha_[1], ha_[2], ha_[3]); w8.y = pack_fp8x4(hb_[0], hb_[1], hb_[2], hb_[3]);
            *(u32x2*)((unsigned char*)h3 + (size_t)t * DM + 8 * (lane + 64 * j)) = w8; }
        f32x4 ua[4], uc[4]; float su = 0.f;
#pragma unroll
        for (int j = 0; j < 4; ++j) { unpack8(*(const u32x4*)(ub + (size_t)t * DM + 8 * (lane + 64 * j)), ua[j], uc[j]);
            su += (ua[j][0] * ua[j][0] + ua[j][1] * ua[j][1]) + (ua[j][2] * ua[j][2] + ua[j][3] * ua[j][3]) + (uc[j][0] * uc[j][0] + uc[j][1] * uc[j][1]) + (uc[j][2] * uc[j][2] + uc[j][3] * uc[j][3]); }
        su = wave_sum(su);
        const float ru = rsqrtf(su * (1.0f / DM) + RMS_EPS);
#pragma unroll
        for (int j = 0; j < 4; ++j) { const f32x4 g0 = *(const f32x4*)(gpost + 8 * (lane + 64 * j)), g1 = *(const f32x4*)(gpost + 8 * (lane + 64 * j) + 4);
            *(u32x4*)(pnb + (size_t)t * DM + 8 * (lane + 64 * j)) = pack8(ua[j] * ru * g0, uc[j] * ru * g1); }
    }
}

struct EpiPlain {
    static constexpr bool PERM = true, AFTER_DRAIN = false, HAS_MID = false;
    bf16_t* O;
    __device__ __forceinline__ void operator()(const f32x4 (&acc)[2][2][4][2], const Unit& u, int wr, int wc, int fr, int fq) const {
        const size_t row0 = (size_t)u.pm * 256 + wr * 64 + fr; const int c0 = u.pn * 256 + wc * 32 + 8 * fq;
#pragma unroll
        for (int ai = 0; ai < 2; ++ai)
#pragma unroll
            for (int m = 0; m < 4; ++m)
#pragma unroll
                for (int bj = 0; bj < 2; ++bj) *(u32x4*)(O + (row0 + ai * 128 + m * 16) * DM + c0 + bj * 128) = pack8(acc[ai][bj][m][0], acc[ai][bj][m][1]);
    }
};

#ifndef NCONV
#define NCONV 112
#endif
#ifndef NC1
#define NC1 0
#endif
constexpr int MOE_NIT = CV_NIT, MOE_SPLIT = NC1 ? (MOE_NIT * 27 / 100) / (NC1 * 8 + (NC1 == 0)) * (NC1 * 8) : 0;
__device__ __forceinline__ void attn_gla_phase(Frame& F, int rep) {
    volatile LAS unsigned* misc = (volatile LAS unsigned*)(F.lds + MISC_OFF);
    unsigned* ctl = (unsigned*)(F.ws + WS_CTL);
    const bool do_gla = (rep == 0 || rep == 1 || rep == 2 || rep == 6), do_att = (rep == 0 || rep == 1 || rep == 3 || rep == 6), do_conv = (rep == 0 || rep == 4 || rep == 5 || rep == 6);
    if ((int)blockIdx.x < NB * GL_H * 4) { if (do_gla) gla_scan_unit(F, (int)blockIdx.x); }
    else if ((int)blockIdx.x < NB * GL_H * 4 + NCONV) { if (do_conv) moe_convert(F, (int)blockIdx.x - NB * GL_H * 4, NCONV, MOE_SPLIT, MOE_NIT, rep == 5); }
    const float lam = __uint_as_float((unsigned)__builtin_amdgcn_readfirstlane((int)__hip_atomic_load(ctl + CW_LAM, RLX_AGENT)));
    if (do_att) for (;;) {
        if (F.tid == 0) misc[4] = __hip_atomic_fetch_add(ctl + CW_QUEUE + 64 * rep, 1u, RLX_AGENT);
        LDS_WAIT(); __syncthreads();
        const unsigned unit = (unsigned)__builtin_amdgcn_readfirstlane((int)misc[4]);
        if (unit >= (unsigned)(NB * DA_H * (SEQ / 128))) break;
        const int qb = 31 - (int)(unit >> 4), bh = (int)(unit & 15);
        attn_unit(F, bh >> 3, bh & 7, qb, lam);
    }
    __syncthreads();
}

constexpr int NPHASE = 14;
struct Args { const float* in[30]; float* out; unsigned char* ws; int ph_lo, ph_hi, rep, pad; };
__global__ void __launch_bounds__(512, 2) mk_fwd(Args args) {
    extern __shared__ __attribute__((aligned(16))) unsigned char lds_raw[];
    Frame F;
    F.lds = (LAS unsigned char*)lds_raw;
    F.wave = __builtin_amdgcn_readfirstlane((int)threadIdx.x >> 6); refresh(F);
    F.G = gridDim.x; { const int bx = blockIdx.x; F.vcu = (F.G % 8 == 0) ? (bx % 8) * (F.G / 8) + bx / 8 : bx; }
    F.ws = args.ws; F.out = args.out;
#pragma unroll
    for (int i = 0; i < 30; ++i) F.in[i] = args.in[i];
    volatile LAS unsigned* misc = (volatile LAS unsigned*)(F.lds + MISC_OFF);
    if (F.tid < 64) misc[F.tid] = 0u;
    __syncthreads();
    unsigned* ctl = (unsigned*)(F.ws + WS_CTL);
    const int lo = args.ph_lo, hi = args.ph_hi;
    const bool multi = (hi - lo) > 1;
    XcdBarrier bar; bar.bar = ctl + CW_BAR; bar.x = 0; bar.st = nullptr; bar.wave = 0;
    if (multi) bar = xcd_barrier_post(ctl + CW_BAR, misc + 8);
    bar.wave = F.wave;
#ifndef PH_MASK
#define PH_MASK 0xFFFF
#endif
#define IN(k) (((PH_MASK >> (k)) & 1) && lo <= (k) && (k) < hi)
#define SEAM(k) do { if (IN(k) && IN((k) + 1)) xcd_barrier(bar); } while (0)
#ifndef REP_MASK
#define REP_MASK 0
#endif
#define NREP(k) ((((REP_MASK) >> (k)) & 1) ? 2 : 1)
#define REPSEAM(k) do { if (rep + 1 < NREP(k)) xcd_barrier(bar); } while (0)
    LAS int* mt = (LAS int*)(F.lds + MISC_OFF + 64);
    LAS unsigned char* ring = F.lds;

    if (IN(0)) { refresh(F); p0_prologue(F, args.rep); } SEAM(0);
    if (IN(1)) { refresh(F);
        const int ncomp = F.G - NC1;
        if ((int)blockIdx.x < ncomp) {
        pg8::Gemm g{(const bf16_t*)(F.ws + WS_H1), (const bf16_t*)(F.ws + WS_WTIN), TOK, IN_MAIN, DM, F.tid}; pg8::StaticOrder S; S.init(TOK, IN_MAIN, ncomp, (int)blockIdx.x);
        EpiInProj E{(bf16_t*)(F.ws + WS_Q), (bf16_t*)(F.ws + WS_K), (bf16_t*)(F.ws + WS_V), (bf16_t*)(F.ws + WS_GQP), (bf16_t*)(F.ws + WS_GQM), (bf16_t*)(F.ws + WS_GKP), (bf16_t*)(F.ws + WS_GKM),
                    (bf16_t*)(F.ws + WS_GV), (bf16_t*)(F.ws + WS_SG), (bf16_t*)(F.ws + WS_GATES), F.in[3], F.in[4], (const float*)(F.ws + WS_BCUM), F.in[16], (LAS float*)(F.lds + EX_OFF)};
        pg8::gemm_phase<EpiInProj, pg8::StaticOrder, true, true>(ring, g, S, E);
        refresh(F);
        { pg8::Gemm g2{(const bf16_t*)(F.ws + WS_H1F8), (const bf16_t*)(F.ws + WS_WTMG8), TOK, 2 * DM, DM / 2, F.tid}; pg8::StaticOrder S2; S2.init(TOK, 2 * DM, ncomp, (int)blockIdx.x);
          EpiGates E2{(bf16_t*)(F.ws + WS_GATES), F.in[16]};
          pg8::gemm_phase<EpiGates, pg8::StaticOrder, true, true, 2>(ring, g2, S2, E2); }
        }
#if NC1 > 0
        else if (args.rep == 0) moe_convert(F, (int)blockIdx.x - ncomp, NC1, 0, MOE_SPLIT);
#endif
    } SEAM(1);
    if (IN(2)) { refresh(F); gla_scores_phase(F); } SEAM(2);
    if (IN(3)) { refresh(F); attn_gla_phase(F, args.rep); } SEAM(3);
    if (IN(4)) { refresh(F); gla_out_phase(F); } SEAM(4);
    if (IN(5)) { refresh(F);
        pg8::Gemm g{(const bf16_t*)(F.ws + WS_YCAT), (const bf16_t*)(F.ws + WS_WTBR), TOK, DM, 2 * DM, F.tid}; pg8::StaticOrder S; S.init(TOK, DM, F.G, (int)blockIdx.x);
        EpiMixed2 E{(const bf16_t*)(F.ws + WS_GATES), (bf16_t*)(F.ws + WS_MIXED)};
        pg8::gemm_phase<EpiMixed2, pg8::StaticOrder, true, true>(ring, g, S, E);
    } SEAM(5);
    if (IN(6)) { refresh(F);
#ifndef NO_X1
        { pg8::Gemm g{(const bf16_t*)(F.ws + WS_MIXED), (const bf16_t*)(F.ws + WS_WTOUT), TOK, DM, DM, F.tid}; pg8::StaticOrder S; S.init(TOK, DM, F.G, (int)blockIdx.x);
          EpiX1 E{F.in[0], (float*)(F.ws + WS_X1)};
          pg8::gemm_phase<EpiX1, pg8::StaticOrder, true, true>(ring, g, S, E); }
#endif
#ifndef NO_PLEUP
        { int kple = PLE; asm volatile("" : "+s"(kple));
          pg8::Gemm g{(const bf16_t*)(F.ws + WS_PB), (const bf16_t*)(F.ws + WS_WTPLEUP), TOK, DM, kple, F.tid}; pg8::StaticOrder S; S.init(TOK, DM, F.G, (int)blockIdx.x);
          EpiPlain E{(bf16_t*)(F.ws + WS_UB)};
          pg8::gemm_phase<EpiPlain, pg8::StaticOrder, true, true>(ring, g, S, E); }
#endif
    } SEAM(6);
    if (IN(7)) { refresh(F); route_phase(F, args.rep); } SEAM(7);
    if (IN(8)) { refresh(F); build_mtoff(F, mt); scatter_phase(F, mt); } SEAM(8);
    if (IN(9)) { refresh(F);
        build_mtoff(F, mt);
        pg8::Gemm g{(const bf16_t*)(F.ws + WS_XS), (const bf16_t*)(F.ws + WS_WTGU), MAXROWS, 2 * DEXP, DM / 2, F.tid}; GroupedOrder S; S.init(mt, 16, F.G, (int)blockIdx.x);
        EpiGU8 E{F.in[23], (unsigned char*)(F.ws + WS_ACT)};
        pg8::gemm_phase<EpiGU8, GroupedOrder, true, true, 2>(ring, g, S, E);
    } SEAM(9);
    if (IN(10)) { refresh(F);
        build_mtoff(F, mt);
        pg8::Gemm g{(const bf16_t*)(F.ws + WS_ACT), (const bf16_t*)(F.ws + WS_WTDN), MAXROWS, DM, DEXP / 2, F.tid}; GroupedOrder S; S.init(mt, 8, F.G, (int)blockIdx.x);
        EpiDN8 E{F.in[25], (bf16_t*)(F.ws + WS_YB)};
        pg8::gemm_phase<EpiDN8, GroupedOrder, true, true, 2>(ring, g, S, E);
    } SEAM(10);
    if (IN(11)) { refresh(F); combine_phase(F); } SEAM(11);
    if (IN(12)) { refresh(F);
        pg8::Gemm g{(const bf16_t*)(F.ws + WS_H3), (const bf16_t*)(F.ws + WS_WTPLEG), TOK, DM, DM / 2, F.tid}; pg8::StaticOrder S; S.init(TOK, DM, F.G, (int)blockIdx.x);
        EpiOut E{(const float*)(F.ws + WS_X2), (const bf16_t*)(F.ws + WS_PN), F.out, W8_INV};
        pg8::gemm_phase<EpiOut, pg8::StaticOrder, true, true, 2>(ring, g, S, E);
    }
#undef IN
#undef SEAM
}

#ifndef MK_LAUNCHES
#define MK_LAUNCHES 1
#endif
extern "C" void kernel_launch(void* const* d_in, const int* in_sizes, int n_in, void* d_out, int out_size, void* d_ws, size_t ws_size, hipStream_t stream) {
    static int grid = 0;
    if (grid == 0) {
        if (n_in != 30 || out_size != TOK * DM || ws_size < WS_END) { fprintf(stderr, "kernel_launch: unexpected shapes (n_in %d out %d ws %zu)\n", n_in, out_size, ws_size); grid = -1; return; }
        int dev = 0, cus = 0, per_cu = 0;
        if (hipGetDevice(&dev) != hipSuccess || hipDeviceGetAttribute(&cus, hipDeviceAttributeMultiprocessorCount, dev) != hipSuccess) { grid = -1; return; }
        if (hipFuncSetAttribute((const void*)mk_fwd, hipFuncAttributeMaxDynamicSharedMemorySize, LDS_BYTES) != hipSuccess) { fprintf(stderr, "kernel_launch: hipFuncSetAttribute failed\n"); grid = -1; return; }
        if (hipOccupancyMaxActiveBlocksPerMultiprocessor(&per_cu, (const void*)mk_fwd, 512, LDS_BYTES) != hipSuccess || per_cu < 1) { fprintf(stderr, "kernel_launch: occupancy query says %d\n", per_cu); (void)hipGetLastError(); per_cu = 1; }
        grid = cus;
    }
    if (grid < 0) return;
    (void)hipMemsetAsync((char*)d_ws + WS_CTL, 0, CTL_ZERO_BYTES, stream);
    Args a{};
    for (int i = 0; i < 30; ++i) a.in[i] = (const float*)d_in[i];
    a.out = (float*)d_out; a.ws = (unsigned char*)d_ws;
#if MK_LAUNCHES == 1
    a.ph_lo = 0; a.ph_hi = NPHASE;
    hipLaunchKernelGGL(mk_fwd, dim3(grid), dim3(512), LDS_BYTES, stream, a);
#else
    for (int p = 0; p < 13; ++p) for (int rep = 0; rep < NREP(p); ++rep) { a.ph_lo = p; a.ph_hi = p + 1; a.rep = rep;
#ifdef PROBE3_MODE
        if (p == 3 && rep == 1) a.rep = PROBE3_MODE;
#endif
#ifdef PROBE0_MODE
        if (p == 0 && rep == 1) a.rep = PROBE0_MODE;
#endif
        hipLaunchKernelGGL(mk_fwd, dim3(grid), dim3(512), LDS_BYTES, stream, a); }
#endif
}
```

```cpp
#include <hip/hip_runtime.h>
#define MK_LAUNCHES 1
#include <cstdio>
#include <cstdint>
namespace pg8 {
#define PG8_LAS __attribute__((address_space(3)))
typedef unsigned short bf16_t;
typedef short bf16x8 __attribute__((ext_vector_type(8)));
typedef float f32x4 __attribute__((ext_vector_type(4)));
typedef unsigned u32x4 __attribute__((ext_vector_type(4)));
typedef long i64x2_t __attribute__((ext_vector_type(2)));
typedef short bf16x16_t __attribute__((ext_vector_type(16)));
typedef int i32x8_t __attribute__((ext_vector_type(8)));
constexpr int BM = 256, BK = 64, HALF = 128, HTB = HALF * BK * 2  , STAGE_BYTES = 8 * HTB, NXCD = 8, WGM = 8;

__host__ __device__ __forceinline__ int lds_byte(int r, int c) { const int st = (r >> 4) * 2 + (c >> 5), rr = r & 15, cc = c & 31, ob = rr * 64 + cc * 2; return st * 1024 + (ob ^ (((ob >> 9) & 1) << 5)); }
__host__ __device__ __forceinline__ void stage_rc(int b, int& R, int& C) { const int st = b / 1024, sb = b % 1024, swz = sb ^ (((sb >> 9) & 1) << 5); R = (st >> 1) * 16 + swz / 64; C = (st & 1) * 32 + (swz % 64) / 2; }
__host__ __device__ __forceinline__ int perm32(int rho) { const int n = rho >> 4, i = rho & 15; return 8 * (i >> 2) + 4 * n + (i & 3); }

struct Unit { int pm, pn, flags; };
struct Gemm { const bf16_t* A; const bf16_t* Bt; int M, N, K, tid; };

struct StaticOrder {
    int nM, nN, nwg, G, c;
    __host__ __device__ void init(int M, int N, int G_, int c_) { nM = M / BM; nN = N / BM; nwg = nM * nN; G = G_; c = c_; }
    __host__ __device__ bool next(int i, Unit& u) const {
        const long L = (long)i * G + c; if (L >= nwg) return false;
        int wgid = (int)L; { const int q = nwg / NXCD, r = nwg % NXCD, xcd = wgid % NXCD, off = wgid / NXCD; wgid = (xcd < r ? xcd * (q + 1) : r * (q + 1) + (xcd - r) * q) + off; }
        const int nig = WGM * nN, gid = wgid / nig, fm = gid * WGM, gsz = (nM - fm) < WGM ? (nM - fm) : WGM;
        u.pm = fm + ((wgid % nig) % gsz); u.pn = (wgid % nig) / gsz; u.flags = 0; return true;
    }
    __device__ __forceinline__ void a_ready(const Unit&) const {}
    __device__ __forceinline__ void done(const Unit&) const {}
};

__device__ __forceinline__ unsigned cvt_pk_bf16(float lo, float hi) { unsigned r; asm volatile("v_cvt_pk_bf16_f32 %0, %1, %2" : "=v"(r) : "v"(lo), "v"(hi)); return r; }
template <class Epi, class Sched, bool ALIGN_EPI = false, bool SP2 = false, int FP8 = 0  >
__device__ __forceinline__ void gemm_phase(PG8_LAS unsigned char* lds, const Gemm g, const Sched& S, const Epi& E) {
    const int tid = g.tid, wid = __builtin_amdgcn_readfirstlane(tid >> 6), lane = tid & 63, wr = wid >> 2, wc = wid & 3, fr = lane & 15, fq = lane >> 4;
    const int K = g.K, nt = K / BK;
    unsigned voffA[2], voffB[2];
#pragma unroll
    for (int i = 0; i < 2; ++i) { int R, C; stage_rc(tid * 16 + i * 8192, R, C); const int Rb = Epi::PERM ? ((R & ~31) + perm32(R & 31)) : R;
        voffA[i] = (unsigned)(R * K + C) * 2u; voffB[i] = (unsigned)(Rb * K + C) * 2u; }
    const size_t kstep = (size_t)(BK * 2);
    const size_t hstep = (size_t)HALF * K * 2;
    const size_t tstep = 2 * hstep;
    const unsigned ldsw = (unsigned)wid * 1024u;
    const int aoff = lds_byte(wr * 64 + fr, fq * 8), boff = lds_byte(wc * 32 + fr, fq * 8);
#define PG8_SA(b, h) (((b) * 2 + (h)) * HTB)
#define PG8_SB(b, h) ((4 + (b) * 2 + (h)) * HTB)
#define PG8_STAGE(bufoff, gbase, voff) do { _Pragma("unroll") for (int _i = 0; _i < 2; ++_i) { unsigned vo_ = (voff)[_i]; asm volatile("" : "+v"(vo_));   \
        __builtin_amdgcn_global_load_lds((const unsigned*)((const char*)(gbase) + vo_), (PG8_LAS unsigned*)(lds + (bufoff) + ldsw + _i * 8192), 16, 0, 0); } } while (0)
#define PG8_LDA(dst, b, h) do { _Pragma("unroll") for (int m = 0; m < 4; ++m) _Pragma("unroll") for (int k = 0; k < 2; ++k) dst[m][k] = *(const PG8_LAS bf16x8*)(lds + PG8_SA(b, h) + aoff + m * 2048 + k * 1024); } while (0)
#define PG8_LDB(dst, b, h) do { _Pragma("unroll") for (int n = 0; n < 2; ++n) _Pragma("unroll") for (int k = 0; k < 2; ++k) dst[n][k] = *(const PG8_LAS bf16x8*)(lds + PG8_SB(b, h) + boff + n * 2048 + k * 1024); } while (0)
#define PG8_MMA(ai, bj, At, Bt) do { __builtin_amdgcn_s_setprio(1); \
        if constexpr (FP8 == 2) { _Pragma("unroll") for (int m = 0; m < 4; ++m) _Pragma("unroll") for (int n = 0; n < 2; ++n) { \
            const bf16x16_t b16_ = __builtin_shufflevector(Bt[n][0], Bt[n][1], 0, 1, 2, 3, 4, 5, 6, 7, 8, 9, 10, 11, 12, 13, 14, 15), a16_ = __builtin_shufflevector(At[m][0], At[m][1], 0, 1, 2, 3, 4, 5, 6, 7, 8, 9, 10, 11, 12, 13, 14, 15); \
            acc[ai][bj][m][n] = __builtin_amdgcn_mfma_scale_f32_16x16x128_f8f6f4(__builtin_bit_cast(i32x8_t, b16_), __builtin_bit_cast(i32x8_t, a16_), acc[ai][bj][m][n], 0, 0, 0, 0, 0, 0); } } \
        else { _Pragma("unroll") for (int m = 0; m < 4; ++m) _Pragma("unroll") for (int n = 0; n < 2; ++n) _Pragma("unroll") for (int k = 0; k < 2; ++k) { \
        if constexpr (FP8 == 1) { const i64x2_t b2_ = __builtin_bit_cast(i64x2_t, Bt[n][k]), a2_ = __builtin_bit_cast(i64x2_t, At[m][k]); \
            acc[ai][bj][m][n] = __builtin_amdgcn_mfma_f32_16x16x32_fp8_fp8(b2_[0], a2_[0], acc[ai][bj][m][n], 0, 0, 0); \
            acc[ai][bj][m][n] = __builtin_amdgcn_mfma_f32_16x16x32_fp8_fp8(b2_[1], a2_[1], acc[ai][bj][m][n], 0, 0, 0); } \
        else acc[ai][bj][m][n] = __builtin_amdgcn_mfma_f32_16x16x32_bf16(Bt[n][k], At[m][k], acc[ai][bj][m][n], 0, 0, 0); } } __builtin_amdgcn_s_setprio(0); } while (0)
#define PG8_WAIT_V(n) asm volatile("s_waitcnt vmcnt(" #n ")" ::: "memory")
#define PG8_WAIT_L(n) asm volatile("s_waitcnt lgkmcnt(" #n ")" ::: "memory")
#define PG8_BAR __builtin_amdgcn_s_barrier()
#define PG8_SCHED __builtin_amdgcn_sched_barrier(0)
    Unit cur, nxt; int ui = 0;
    if (!S.next(0, cur)) return;
    f32x4 acc[2][2][4][2];
#pragma unroll
    for (int a = 0; a < 2; ++a)
#pragma unroll
        for (int b = 0; b < 2; ++b)
#pragma unroll
            for (int m = 0; m < 4; ++m)
#pragma unroll
                for (int n = 0; n < 2; ++n) acc[a][b][m][n] = (f32x4){0.f, 0.f, 0.f, 0.f};
    bf16x8 At[4][2], B0[2][2], B1[2][2];
    const char* cA = (const char*)g.A + (size_t)cur.pm * tstep; const char* cB = (const char*)g.Bt + (size_t)cur.pn * tstep;
    S.a_ready(cur);
    if constexpr (SP2) {
        PG8_STAGE(PG8_SB(0, 0), cB, voffB); PG8_STAGE(PG8_SB(0, 1), cB + hstep, voffB); PG8_STAGE(PG8_SA(0, 0), cA, voffA); PG8_STAGE(PG8_SA(0, 1), cA + hstep, voffA);
        if (wr == 1) PG8_BAR;
        PG8_WAIT_V(2); PG8_BAR;
        PG8_STAGE(PG8_SB(1, 0), cB + kstep, voffB); PG8_STAGE(PG8_SA(1, 0), cA + kstep, voffA); PG8_STAGE(PG8_SB(1, 1), cB + hstep + kstep, voffB);
        PG8_WAIT_V(6); PG8_BAR;
    } else {
        PG8_STAGE(PG8_SB(0, 0), cB, voffB); PG8_STAGE(PG8_SA(0, 0), cA, voffA); PG8_STAGE(PG8_SB(0, 1), cB + hstep, voffB); PG8_STAGE(PG8_SA(0, 1), cA + hstep, voffA);
        if (wr == 1) PG8_BAR;
        PG8_WAIT_V(4); PG8_BAR;
        PG8_STAGE(PG8_SB(1, 0), cB + kstep, voffB); PG8_STAGE(PG8_SA(1, 0), cA + kstep, voffA); PG8_STAGE(PG8_SB(1, 1), cB + hstep + kstep, voffB);
        PG8_WAIT_V(6); PG8_BAR;
    }
    for (;;) {
        const bool has_next = S.next(ui + 1, nxt);
        const char* nA = has_next ? (const char*)g.A + (size_t)nxt.pm * tstep : cA; const char* nB = has_next ? (const char*)g.Bt + (size_t)nxt.pn * tstep : cB;
        for (int t = 0; t < nt; t += 2) {
            const bool last = (t == nt - 2);
            const char* a1 = cA + (size_t)(t + 1) * kstep;
            const char* a2 = last ? nA : cA + (size_t)(t + 2) * kstep; const char* b2 = last ? nB : cB + (size_t)(t + 2) * kstep;
            const char* a3 = a2 + kstep; const char* b3 = b2 + kstep;
            if (last && has_next) S.a_ready(nxt);
            if constexpr (Epi::HAS_MID) { if (t == nt / 2) E.mid(acc, cur, wr, wc, fr, fq); }
            if constexpr (SP2) {
            PG8_LDB(B0, 0, 0); PG8_LDB(B1, 0, 1); PG8_SCHED; PG8_LDA(At, 0, 0); PG8_STAGE(PG8_SA(1, 1), a1 + hstep, voffA);
            PG8_WAIT_V(8); PG8_WAIT_L(0); PG8_BAR; PG8_MMA(0, 0, At, B0); PG8_MMA(0, 1, At, B1); PG8_BAR; PG8_SCHED;
            PG8_LDA(At, 0, 1); PG8_STAGE(PG8_SB(0, 0), b2, voffB); PG8_STAGE(PG8_SB(0, 1), b2 + hstep, voffB); PG8_STAGE(PG8_SA(0, 0), a2, voffA);
            PG8_WAIT_V(8); PG8_WAIT_L(0); PG8_BAR; if (!(cur.flags & 1)) { PG8_MMA(1, 0, At, B0); PG8_MMA(1, 1, At, B1); } PG8_BAR; PG8_SCHED;
            PG8_LDB(B0, 1, 0); PG8_LDB(B1, 1, 1); PG8_SCHED; PG8_LDA(At, 1, 0); PG8_STAGE(PG8_SA(0, 1), a2 + hstep, voffA);
            PG8_WAIT_V(8); PG8_WAIT_L(0); PG8_BAR; PG8_MMA(0, 0, At, B0); PG8_MMA(0, 1, At, B1); PG8_BAR; PG8_SCHED;
            PG8_LDA(At, 1, 1); PG8_STAGE(PG8_SB(1, 0), b3, voffB); PG8_STAGE(PG8_SB(1, 1), b3 + hstep, voffB); PG8_STAGE(PG8_SA(1, 0), a3, voffA);
            PG8_WAIT_V(8); PG8_WAIT_L(0); PG8_BAR; if (!(cur.flags & 1)) { PG8_MMA(1, 0, At, B0); PG8_MMA(1, 1, At, B1); } PG8_BAR; PG8_SCHED;
            } else {
            PG8_LDB(B0, 0, 0); PG8_SCHED; PG8_LDA(At, 0, 0); PG8_STAGE(PG8_SA(1, 1), a1 + hstep, voffA);
            PG8_WAIT_L(8); PG8_BAR; PG8_WAIT_L(0); PG8_MMA(0, 0, At, B0); PG8_BAR; PG8_SCHED;
            PG8_LDB(B1, 0, 1); PG8_STAGE(PG8_SB(0, 0), b2, voffB);
            PG8_BAR; PG8_WAIT_L(0); PG8_MMA(0, 1, At, B1); PG8_BAR;
            PG8_LDA(At, 0, 1); PG8_STAGE(PG8_SA(0, 0), a2, voffA);
            PG8_BAR; PG8_WAIT_L(0); PG8_MMA(1, 0, At, B0); PG8_BAR; PG8_SCHED;
            PG8_STAGE(PG8_SB(0, 1), b2 + hstep, voffB);
            PG8_WAIT_V(6); PG8_BAR; PG8_MMA(1, 1, At, B1); PG8_BAR;
            PG8_LDB(B0, 1, 0); PG8_SCHED; PG8_LDA(At, 1, 0); PG8_STAGE(PG8_SA(0, 1), a2 + hstep, voffA);
            PG8_WAIT_L(8); PG8_BAR; PG8_WAIT_L(0); PG8_MMA(0, 0, At, B0); PG8_BAR; PG8_SCHED;
            PG8_LDB(B1, 1, 1); PG8_STAGE(PG8_SB(1, 0), b3, voffB);
            PG8_BAR; PG8_WAIT_L(0); PG8_MMA(0, 1, At, B1); PG8_BAR;
            PG8_LDA(At, 1, 1); PG8_STAGE(PG8_SA(1, 0), a3, voffA);
            PG8_BAR; PG8_WAIT_L(0); PG8_MMA(1, 0, At, B0); PG8_BAR; PG8_SCHED;
            PG8_STAGE(PG8_SB(1, 1), b3 + hstep, voffB);
            PG8_WAIT_V(6); PG8_BAR; PG8_MMA(1, 1, At, B1); PG8_BAR;
            }
        }
        if constexpr (ALIGN_EPI) { if (wr == 0) PG8_BAR; }
        if constexpr (!Epi::AFTER_DRAIN) { E(acc, cur, wr, wc, fr, fq); S.done(cur); }
        if (!has_next) break;
#pragma unroll
        for (int a = 0; a < 2; ++a)
#pragma unroll
            for (int b = 0; b < 2; ++b)
#pragma unroll
                for (int m = 0; m < 4; ++m)
#pragma unroll
                    for (int n = 0; n < 2; ++n) acc[a][b][m][n] = (f32x4){0.f, 0.f, 0.f, 0.f};
        cur = nxt; cA = nA; cB = nB; ++ui;
        if constexpr (ALIGN_EPI) { if (wr == 1) PG8_BAR; }
    }
    PG8_WAIT_V(0);
    if constexpr (!ALIGN_EPI) { if (wr == 0) PG8_BAR; }
    PG8_BAR;
    if constexpr (Epi::AFTER_DRAIN) { E.fused(acc, cur, wr, wc, fr, fq, lds, wid, lane); S.done(cur); }
#undef PG8_SA
#undef PG8_SB
#undef PG8_STAGE
#undef PG8_LDA
#undef PG8_LDB
#undef PG8_MMA
#undef PG8_WAIT_V
#undef PG8_WAIT_L
#undef PG8_BAR
#undef PG8_SCHED
}
}
#define XB_TMO      128
#define XB_XCNT(j)  (256  + 64 * (j))
#define XB_XSUB(j)  (1280 + 64 * (j))
#define XB_XGEN(j)  (2304 + 64 * (j))
#define XB_TOP      3328
#define XB_TOPGEN   3392
#define XCD_BAR_WORDS 3456
#define XB_SPIN_CAP (1u << 18)
#define LAS __attribute__((address_space(3)))

__device__ __forceinline__ unsigned xb_ld(unsigned* p)              { return __hip_atomic_load(p, __ATOMIC_RELAXED, __HIP_MEMORY_SCOPE_AGENT); }
__device__ __forceinline__ unsigned xb_add(unsigned* p, unsigned v) { return __hip_atomic_fetch_add(p, v, __ATOMIC_RELAXED, __HIP_MEMORY_SCOPE_AGENT); }
__device__ __forceinline__ unsigned xb_xcc_id() { return (unsigned)__builtin_amdgcn_s_getreg((3 << 11) | 20) & 0xFu; }
#define XB_SPIN(cond, bar) do { unsigned _sp = 0; while (cond) { __builtin_amdgcn_s_sleep(1); \
    if ((++_sp & 255u) == 0u) { if (xb_ld(&(bar)[XB_TMO])) break; if (_sp > XB_SPIN_CAP) { atomicAdd(&(bar)[XB_TMO], 1u); break; } } } } while (0)

struct XcdBarrier {
    unsigned* bar; unsigned x; int wave;
    volatile LAS unsigned* st;
};

__device__ __forceinline__ XcdBarrier xcd_barrier_post(unsigned* bar, volatile LAS unsigned* st) {
    XcdBarrier b; b.bar = bar; b.x = xb_xcc_id(); b.st = st;
    if (threadIdx.x == 0) (void)xb_add(&bar[XB_XCNT(b.x)], 1u);
    return b;
}
__device__ __forceinline__ void xcd_barrier_complete(unsigned* bar, unsigned x, unsigned& nloc, unsigned& nx) {
    const unsigned G = gridDim.x * gridDim.y * gridDim.z;
    unsigned sum, cnt, mine, sp = 0u;
    for (;;) {
        sum = 0u; cnt = 0u; mine = 0u;
#pragma unroll
        for (unsigned j = 0; j < 16; ++j) { const unsigned c = xb_ld(&bar[XB_XCNT(j)]); sum += c; cnt += (c > 0u) ? 1u : 0u; mine = (j == x) ? c : mine; }
        if (sum == G) break;
        __builtin_amdgcn_s_sleep(1);
        if ((++sp & 255u) == 0u) { if (xb_ld(&bar[XB_TMO])) break; if (sp > XB_SPIN_CAP) { atomicAdd(&bar[XB_TMO], 1u); break; } }
    }
    nloc = mine > 0u ? mine : 1u; nx = cnt > 0u ? cnt : 1u;
}

__device__ __forceinline__ void xcd_barrier(const XcdBarrier& b) {
    asm volatile("s_waitcnt vmcnt(0)" ::: "memory");
    __syncthreads();
    if (b.wave == 0 && __builtin_amdgcn_mbcnt_hi(~0u, __builtin_amdgcn_mbcnt_lo(~0u, 0u)) == 0u) {
        unsigned* bar = b.bar;
        __builtin_amdgcn_s_waitcnt(0);
        unsigned nloc = b.st[0], nx = b.st[1];
        if (nloc == 0u) { xcd_barrier_complete(bar, b.x, nloc, nx); b.st[0] = nloc; b.st[1] = nx; }
        const unsigned old = xb_add(&bar[XB_XSUB(b.x)], 1u);
        const unsigned gen = old / nloc;
        if (old + 1u == (gen + 1u) * nloc) {
            __builtin_amdgcn_fence(__ATOMIC_RELEASE, "agent");
            asm volatile("s_waitcnt vmcnt(0)" ::: "memory");
            const unsigned og = xb_add(&bar[XB_TOP], 1u);
            const unsigned tg = og / nx;
            if (og + 1u == (tg + 1u) * nx) xb_add(&bar[XB_TOPGEN], 1u);
            else XB_SPIN(xb_ld(&bar[XB_TOPGEN]) == tg, bar);
            __builtin_amdgcn_fence(__ATOMIC_ACQUIRE, "agent");
            xb_add(&bar[XB_XGEN(b.x)], 1u);
            asm volatile("s_waitcnt vmcnt(0)" ::: "memory");
        } else {
            XB_SPIN(xb_ld(&bar[XB_XGEN(b.x)]) == gen, bar);
            __builtin_amdgcn_fence(__ATOMIC_ACQUIRE, "agent");
            asm volatile("s_waitcnt vmcnt(0)" ::: "memory");
        }
    }
    __syncthreads();
}


#define GAS __attribute__((address_space(1)))
using pg8::bf16_t; using pg8::bf16x8; using pg8::f32x4; using pg8::u32x4; using pg8::cvt_pk_bf16;
typedef short s16x4 __attribute__((ext_vector_type(4)));
typedef float f32x16 __attribute__((ext_vector_type(16)));
typedef float f32x2 __attribute__((ext_vector_type(2)));
typedef unsigned u32x2 __attribute__((ext_vector_type(2)));
#define RLX_AGENT __ATOMIC_RELAXED, __HIP_MEMORY_SCOPE_AGENT
#define LDS_WAIT() asm volatile("s_waitcnt lgkmcnt(0)" ::: "memory")
#define VM_WAIT() asm volatile("s_waitcnt vmcnt(0)" ::: "memory")

constexpr int NB = 2, SEQ = 4096, DM = 2048, TOK = NB * SEQ;
constexpr int PLE = 256;
constexpr int DA_H = 8, DA_D = 128, DA_V = 256;
constexpr int GL_H = 4, GL_DK = 256, GL_DV = 512, GL_KW = 1024, GL_VW = 2048, GL_R = 16;
constexpr int NEXP = 32, TOPK = 4, DEXP = 2048;
constexpr int IN_W = 12304, IN_MAIN = 12288;
constexpr int N_INP = IN_MAIN + 2 * DM;
constexpr int CHUNK = 64, NCH = SEQ / CHUNK;
constexpr float RMS_EPS = 1e-6f;
constexpr float LOG2E = 1.4426950408889634f;
constexpr int MAXROWS = 40960;

constexpr size_t MiB = 1u << 20;
constexpr size_t WS_CTL = 0, CTL_ZERO_BYTES = 1 * MiB;
constexpr size_t WS_WTIN = 1 * MiB;
constexpr size_t WS_WTBR = 65 * MiB;
constexpr size_t WS_WTOUT = 81 * MiB, WS_WTPLEG = 89 * MiB;
constexpr size_t WS_WTPLEUP = 97 * MiB;
constexpr size_t WS_WTGU = 98 * MiB;
constexpr size_t WS_WTDN = 610 * MiB;
constexpr size_t WS_H1 = 866 * MiB;
constexpr size_t WS_Q = 898 * MiB, WS_K = 930 * MiB, WS_V = 962 * MiB;
constexpr size_t WS_GQP = 994 * MiB, WS_GQM = 1010 * MiB, WS_GKP = 1026 * MiB, WS_GKM = 1042 * MiB;
constexpr size_t WS_GV = 1058 * MiB, WS_SG = 1090 * MiB;
constexpr size_t WS_GATES = 1122 * MiB;
constexpr size_t WS_BCUM = 1186 * MiB;
constexpr size_t WS_ATTC = 1218 * MiB;
constexpr size_t WS_YDA = 1222 * MiB;
constexpr size_t WS_OGLA = 1254 * MiB;
constexpr size_t WS_YGLA = 1318 * MiB;
constexpr size_t WS_YCAT = 1350 * MiB;
constexpr size_t WS_MIXED = 1414 * MiB;
constexpr size_t WS_X1 = 1446 * MiB;
constexpr size_t WS_H2 = 1510 * MiB;
constexpr size_t WS_ROUTE = 1542 * MiB;
constexpr size_t WS_XS = 1543 * MiB;
constexpr size_t WS_ACT = 1703 * MiB;
constexpr size_t WS_YB = 1863 * MiB;
constexpr size_t WS_X2 = 2023 * MiB;
constexpr size_t WS_H3 = 2087 * MiB;
constexpr size_t WS_PN = 2119 * MiB;
constexpr size_t WS_PB = 2151 * MiB;
constexpr size_t WS_UB = 2155 * MiB;
constexpr size_t WS_H1F8 = 2103 * MiB;
constexpr size_t WS_WTMG8 = 49 * MiB;
constexpr size_t WS_END = 2187 * MiB;
constexpr int CW_BAR = 4096;
constexpr int CW_CNT = 8192;
constexpr int CW_QUEUE = 12288;
constexpr int CW_LAM = 16384;

constexpr int RING_BYTES = 131072;
constexpr int EX_OFF = 131072;
constexpr int MISC_OFF = 139264 + 1024;
constexpr int LDS_BYTES = 160 * 1024;

struct Frame {
    LAS unsigned char* lds;
    int tid, lane, wave, G, vcu;
    unsigned char* ws;
    const float* in[30];
    float* out;
};

__device__ __forceinline__ void refresh(Frame& F) { int l; asm volatile("v_mbcnt_lo_u32_b32 %0, -1, 0\n\tv_mbcnt_hi_u32_b32 %0, -1, %0" : "=v"(l)); F.lane = l; F.tid = F.wave * 64 + l; }
__device__ __forceinline__ float wave_sum(float v) {
#pragma unroll
    for (int o = 1; o < 64; o <<= 1) v += __shfl_xor(v, o);
    return v;
}
__device__ __forceinline__ float bf2f(unsigned short b) { return __uint_as_float(((unsigned)b) << 16); }
__device__ __forceinline__ float bflo(unsigned w) { return __uint_as_float(w << 16); }
__device__ __forceinline__ float bfhi(unsigned w) { return __uint_as_float(w & 0xffff0000u); }
__device__ __forceinline__ float fast_sigmoid(float x) { return 1.0f / (1.0f + __expf(-x)); }
typedef short v4i16_t __attribute__((ext_vector_type(4)));
__device__ __forceinline__ s16x4 lds_tr16(const LAS unsigned char* p) { return __builtin_bit_cast(s16x4, __builtin_amdgcn_ds_read_tr16_b64_v4i16((LAS v4i16_t*)p)); }
__device__ __forceinline__ bf16x8 cat8(const s16x4 a, const s16x4 b) { bf16x8 r; r[0] = a[0]; r[1] = a[1]; r[2] = a[2]; r[3] = a[3]; r[4] = b[0]; r[5] = b[1]; r[6] = b[2]; r[7] = b[3]; return r; }

__device__ __forceinline__ void p0_tr_load(f32x4 (&v)[16], const float* W, int ldw, int kb, int nb, int lane) {
    const int k0 = 64 * kb, n0 = 64 * nb, lk = lane >> 4, ln = (lane & 15) * 4;
#pragma unroll
    for (int i = 0; i < 16; ++i) v[i] = __builtin_nontemporal_load((const f32x4*)(W + (size_t)(k0 + 4 * i + lk) * ldw + n0 + ln));
}
__device__ __forceinline__ void p0_tr_finish(const f32x4 (&v)[16], int Kdst, bf16_t* WT, size_t row_off, LAS float* scr, int kb, int nb, int lane, bool nostore = false) {
    const int k0 = 64 * kb, n0 = 64 * nb, lk = lane >> 4, ln = (lane & 15) * 4;
#pragma unroll
    for (int i = 0; i < 16; ++i) { LAS float* s = scr + (4 * i + lk) * 65 + ln; s[0] = v[i][0]; s[1] = v[i][1]; s[2] = v[i][2]; s[3] = v[i][3]; }
    LDS_WAIT(); asm volatile("" ::: "memory");
    const int c = lane & 7;
#pragma unroll
    for (int j = 0; j < 8; ++j) { const int n = (lane >> 3) + 8 * j; const LAS float* s = scr + (8 * c) * 65 + n;
        u32x4 o; o.x = cvt_pk_bf16(s[0 * 65], s[1 * 65]); o.y = cvt_pk_bf16(s[2 * 65], s[3 * 65]); o.z = cvt_pk_bf16(s[4 * 65], s[5 * 65]); o.w = cvt_pk_bf16(s[6 * 65], s[7 * 65]);
        if (!nostore || o.x == 0x12345678u) __builtin_nontemporal_store(o, (u32x4*)(WT + (row_off + n0 + n) * (size_t)Kdst + k0 + 8 * c)); }
    LDS_WAIT(); asm volatile("" ::: "memory");
}
constexpr float W8_SCALE = 32.0f, W8_INV = 1.0f / 32.0f;
__device__ __forceinline__ unsigned pack_fp8x4(float a, float b, float c, float d) {
    a = fminf(fmaxf(a, -448.f), 448.f); b = fminf(fmaxf(b, -448.f), 448.f); c = fminf(fmaxf(c, -448.f), 448.f); d = fminf(fmaxf(d, -448.f), 448.f);
    int w = 0; w = __builtin_amdgcn_cvt_pk_fp8_f32(a, b, w, false); w = __builtin_amdgcn_cvt_pk_fp8_f32(c, d, w, true); return (unsigned)w;
}
__device__ __forceinline__ void p0_tr_finish8(const f32x4 (&v)[16], int Kdst, unsigned char* WT, size_t row_off, LAS float* scr, int kb, int nb, int lane, bool nostore = false) {
    const int k0 = 64 * kb, n0 = 64 * nb, lk = lane >> 4, ln = (lane & 15) * 4;
#pragma unroll
    for (int i = 0; i < 16; ++i) { LAS float* s = scr + (4 * i + lk) * 65 + ln; s[0] = v[i][0]; s[1] = v[i][1]; s[2] = v[i][2]; s[3] = v[i][3]; }
    LDS_WAIT(); asm volatile("" ::: "memory");
    const int c = lane & 7;
#pragma unroll
    for (int j = 0; j < 8; ++j) { const int n = (lane >> 3) + 8 * j; const LAS float* s = scr + (8 * c) * 65 + n;
        u32x2 o; o.x = pack_fp8x4(s[0 * 65] * W8_SCALE, s[1 * 65] * W8_SCALE, s[2 * 65] * W8_SCALE, s[3 * 65] * W8_SCALE); o.y = pack_fp8x4(s[4 * 65] * W8_SCALE, s[5 * 65] * W8_SCALE, s[6 * 65] * W8_SCALE, s[7 * 65] * W8_SCALE);
        if (!nostore || o.x == 0x12345678u) __builtin_nontemporal_store(o, (u32x2*)(WT + (row_off + n0 + n) * (size_t)Kdst + k0 + 8 * c)); }
    LDS_WAIT(); asm volatile("" ::: "memory");
}
__device__ __forceinline__ void p0_transpose_item8(const float* W, int ldw, int Kdst, unsigned char* WT, size_t row_off, LAS float* scr, int kb, int nb, int lane) {
    f32x4 v[16]; p0_tr_load(v, W, ldw, kb, nb, lane); p0_tr_finish8(v, Kdst, WT, row_off, scr, kb, nb, lane);
}
__device__ __forceinline__ void p0_transpose_item(const float* W, int ldw, int Kdst, bf16_t* WT, size_t row_off, LAS float* scr, int kb, int nb, int lane, bool nostore = false) {
    f32x4 v[16]; p0_tr_load(v, W, ldw, kb, nb, lane); p0_tr_finish(v, Kdst, WT, row_off, scr, kb, nb, lane, nostore);
}

__device__ __forceinline__ float log_sigmoid_f(float z) { return fminf(z, 0.f) - __logf(1.0f + __expf(-fabsf(z))); }

__device__ __forceinline__ void p0_chunk_job(Frame& F, int ci) {
    const float* x = F.in[0]; const float* gmix = F.in[18]; const float* w_in = F.in[2];
    const float* w2 = F.in[10]; const float* gb = F.in[11];
    bf16_t* h1 = (bf16_t*)(F.ws + WS_H1); float* bcum = (float*)(F.ws + WS_BCUM);
    LAS float* glr_s = (LAS float*)(F.lds);
    int lane_ = F.lane; asm volatile("" : "+v"(lane_));
    const int t0 = ci * 64, lane = lane_, w = F.wave;
    {
        const float* pin = F.in[1]; bf16_t* pb = (bf16_t*)(F.ws + WS_PB);
#pragma unroll
        for (int r = 0; r < 8; ++r) { const size_t t = (size_t)(t0 + 8 * w + r); const f32x4 pv = *(const f32x4*)(pin + t * PLE + 4 * lane);
            u32x2 o; o.x = cvt_pk_bf16(pv[0], pv[1]); o.y = cvt_pk_bf16(pv[2], pv[3]); *(u32x2*)(pb + t * PLE + 4 * lane) = o; }
    }
    LAS float* wl = (LAS float*)(F.lds + 4096);
    for (int k = F.tid; k < DM; k += 512) { const float gk = gmix[k]; const int slot = (k & 3) * 512 + (k >> 2);
#pragma unroll
        for (int q = 0; q < 4; ++q) { const f32x4 wq = *(const f32x4*)(w_in + (size_t)k * IN_W + IN_MAIN + 4 * q) * gk; *(LAS f32x4*)(wl + slot * 16 + 4 * (q ^ ((slot >> 2) & 3))) = wq; } }
    LDS_WAIT(); __syncthreads();
    {
        f32x4 g[8];
#pragma unroll
        for (int j = 0; j < 8; ++j) g[j] = *(const f32x4*)(gmix + 4 * (lane + 64 * j));
        const int sw = (lane >> 2) & 3;
#pragma unroll 1
        for (int p = 0; p < 4; ++p) {
            f32x4 xv[2][8]; float rs2[2];
#pragma unroll
            for (int r = 0; r < 2; ++r) { const size_t t = (size_t)(t0 + 8 * w + 2 * p + r);
                const float* xrow = x + t * DM + 4 * lane; asm volatile("" : "+v"(xrow));
#pragma unroll
                for (int j = 0; j < 8; ++j) xv[r][j] = *(const f32x4*)(xrow + 256 * j); }
#pragma unroll
            for (int r = 0; r < 2; ++r) { const size_t t = (size_t)(t0 + 8 * w + 2 * p + r); float ss = 0.f;
#pragma unroll
                for (int j = 0; j < 8; ++j) ss += (xv[r][j][0] * xv[r][j][0] + xv[r][j][1] * xv[r][j][1]) + (xv[r][j][2] * xv[r][j][2] + xv[r][j][3] * xv[r][j][3]);
                ss = wave_sum(ss);
                const float rs = rsqrtf(ss * (1.0f / DM) + RMS_EPS); rs2[r] = rs;
                bf16_t* hrow = h1 + t * DM + 4 * lane; unsigned char* frow = F.ws + WS_H1F8 + t * DM + 4 * lane; asm volatile("" : "+v"(hrow), "+v"(frow));
#pragma unroll
                for (int j = 0; j < 8; ++j) { u32x2 o; o.x = cvt_pk_bf16(xv[r][j][0] * rs * g[j][0], xv[r][j][1] * rs * g[j][1]); o.y = cvt_pk_bf16(xv[r][j][2] * rs * g[j][2], xv[r][j][3] * rs * g[j][3]);
                    *(u32x2*)(hrow + 256 * j) = o;
                    *(unsigned*)(frow + 256 * j) = pack_fp8x4(xv[r][j][0] * rs * g[j][0], xv[r][j][1] * rs * g[j][1], xv[r][j][2] * rs * g[j][2], xv[r][j][3] * rs * g[j][3]); }
            }
            float acc[32];
#pragma unroll
            for (int i = 0; i < 32; ++i) acc[i] = 0.f;
            unsigned wb[8];
#pragma unroll
            for (int q = 0; q < 4; ++q) { unsigned b0 = 4096u + (unsigned)lane * 64u + 16u * (unsigned)(q ^ sw); asm volatile("" : "+v"(b0)); wb[q] = b0; unsigned b1 = b0 + 65536u; asm volatile("" : "+v"(b1)); wb[4 + q] = b1; }
#pragma unroll
            for (int j = 0; j < 8; ++j)
#pragma unroll
                for (int c = 0; c < 4; ++c) {
                    f32x4 wv[4];
#pragma unroll
                    for (int q = 0; q < 4; ++q) wv[q] = *(const LAS f32x4*)((const LAS unsigned char*)F.lds + wb[(c >> 1) * 4 + q] + ((c & 1) * 512 + 64 * j) * 64);
#pragma unroll
                    for (int r = 0; r < 2; ++r) { const float xg = xv[r][j][c];
#pragma unroll
                        for (int q = 0; q < 4; ++q) { acc[r * 16 + 4 * q + 0] += xg * wv[q][0]; acc[r * 16 + 4 * q + 1] += xg * wv[q][1]; acc[r * 16 + 4 * q + 2] += xg * wv[q][2]; acc[r * 16 + 4 * q + 3] += xg * wv[q][3]; } }
                    if (c & 1) asm volatile("" ::: "memory");
                }
#pragma unroll
            for (int n = 16, m = 32; n >= 1; n >>= 1, m >>= 1) {
                const bool up = (lane & m) != 0;
#pragma unroll
                for (int i = 0; i < n; ++i) { const float a = acc[i], b = acc[i + n]; const float send = up ? a : b, keep = up ? b : a; acc[i] = keep + __shfl_xor(send, m); }
            }
            acc[0] += __shfl_xor(acc[0], 1);
            const int idx = lane >> 1;
            if ((lane & 1) == 0) glr_s[(8 * w + 2 * p + (idx >> 4)) * 16 + (idx & 15)] = acc[0] * ((idx >> 4) ? rs2[1] : rs2[0]);
        }
    }
    LDS_WAIT(); __syncthreads();
    {
        const int c0 = F.tid, c1 = F.tid + 512;
        float wa[16], wb[16];
#pragma unroll
        for (int j = 0; j < 16; ++j) { wa[j] = w2[j * GL_KW + c0]; wb[j] = w2[j * GL_KW + c1]; }
        const float ba = gb[c0], bb = gb[c1]; float ra = 0.f, rb = 0.f;
        for (int r = 0; r < 64; ++r) {
            float za = ba, zb = bb;
#pragma unroll
            for (int q = 0; q < 4; ++q) { const f32x4 gv = *(const LAS f32x4*)(glr_s + r * 16 + 4 * q);
                za += gv[0] * wa[4 * q] + gv[1] * wa[4 * q + 1] + gv[2] * wa[4 * q + 2] + gv[3] * wa[4 * q + 3];
                zb += gv[0] * wb[4 * q] + gv[1] * wb[4 * q + 1] + gv[2] * wb[4 * q + 2] + gv[3] * wb[4 * q + 3]; }
            ra += log_sigmoid_f(za) * (1.0f / 16.0f); rb += log_sigmoid_f(zb) * (1.0f / 16.0f);
            bcum[(size_t)(t0 + r) * GL_KW + c0] = ra; bcum[(size_t)(t0 + r) * GL_KW + c1] = rb;
        }
    }
    LDS_WAIT(); __syncthreads();
}

__device__ __forceinline__ void p0_prologue(Frame& F, int rep = 0) {
    if (rep != 1) for (int ci = F.vcu; ci < TOK / CHUNK; ci += F.G) p0_chunk_job(F, ci);
    if (F.vcu == F.G - 1 && F.wave == 0) {
        const float* q1 = F.in[5]; const float* k1 = F.in[6]; const float* q2 = F.in[7]; const float* k2 = F.in[8];
        float s1 = q1[F.lane] * k1[F.lane] + q1[F.lane + 64] * k1[F.lane + 64], s2 = q2[F.lane] * k2[F.lane] + q2[F.lane + 64] * k2[F.lane + 64];
        s1 = wave_sum(s1); s2 = wave_sum(s2);
        if (F.lane == 0) { const float lam = expf(s1) - expf(s2) + 0.2f; ((unsigned*)(F.ws + WS_CTL))[CW_LAM] = __float_as_uint(lam); }
    }
    LAS float* scr = (LAS float*)(F.lds + F.wave * 16640);
    const int nch = TOK / CHUNK, ncv = (F.G > nch) ? F.G - nch : F.G;
    const int gw = ((F.G > nch) ? F.vcu - nch : F.vcu) * 8 + F.wave, NGW = ncv * 8;
    constexpr int I0 = 32 * 192, I1 = 32 * 64, I2 = 32 * 32, I6 = 4 * 32;
    constexpr int NITEMS = I0 + I1 + 4 * I2 + I6;
    struct It { const float* W; unsigned char* WT; int ldw, Kdst, kb, nb, f8; };
    auto decode = [&](int r) -> It {
        if (r < I0) return It{F.in[2], F.ws + WS_WTIN, IN_W, DM, r / 192, r % 192, 0}; r -= I0;
        if (r < I1) return It{F.in[15], F.ws + WS_WTMG8, 2 * DM, DM, r / 64, r % 64, 1}; r -= I1;
        if (r < I2) return It{F.in[13], F.ws + WS_WTBR, DM, 2 * DM, r / 32, r % 32, 0}; r -= I2;
        if (r < I2) return It{F.in[14], F.ws + WS_WTBR + 2 * DM, DM, 2 * DM, r / 32, r % 32, 0}; r -= I2;
        if (r < I2) return It{F.in[17], F.ws + WS_WTOUT, DM, DM, r / 32, r % 32, 0}; r -= I2;
        if (r < I2) return It{F.in[27], F.ws + WS_WTPLEG, DM, DM, r / 32, r % 32, 1}; r -= I2;
        return It{F.in[28], F.ws + WS_WTPLEUP, DM, PLE, r / 32, r % 32, 0};
    };
    for (int it = ((gw >= 0 && rep != 2) ? gw : NITEMS); it < NITEMS; it += 2 * NGW) {
        const int it2 = it + NGW; const bool two = it2 < NITEMS;
        const It a = decode(it), b = decode(two ? it2 : it);
        f32x4 va[16], vb[16];
        p0_tr_load(va, a.W, a.ldw, a.kb, a.nb, F.lane); p0_tr_load(vb, b.W, b.ldw, b.kb, b.nb, F.lane);
        if (a.f8) p0_tr_finish8(va, a.Kdst, a.WT, 0, scr, a.kb, a.nb, F.lane); else p0_tr_finish(va, a.Kdst, (bf16_t*)a.WT, 0, scr, a.kb, a.nb, F.lane);
        if (two) { if (b.f8) p0_tr_finish8(vb, b.Kdst, b.WT, 0, scr, b.kb, b.nb, F.lane); else p0_tr_finish(vb, b.Kdst, (bf16_t*)b.WT, 0, scr, b.kb, b.nb, F.lane); }
    }
    LDS_WAIT(); __syncthreads();
}

constexpr int CV_GU = 32 * 32 * 64, CV_DN = 32 * 32 * 32, CV_NIT = CV_GU + CV_DN;
__device__ __forceinline__ void moe_item(int it, const Frame& F, const float*& W, int& ldw, int& Kdst, bf16_t*& WT, size_t& ro, int& kb, int& nb) {
    if (it < CV_GU) { const int e = it / 2048, q = it % 2048; W = F.in[22] + (size_t)e * DM * 2 * DEXP; ldw = 2 * DEXP; Kdst = DM; WT = (bf16_t*)(F.ws + WS_WTGU); ro = (size_t)e * 2 * DEXP; kb = q / 64; nb = q % 64; }
    else { const int r = it - CV_GU, e = r / 1024, q = r % 1024; W = F.in[24] + (size_t)e * DEXP * DM; ldw = DM; Kdst = DEXP; WT = (bf16_t*)(F.ws + WS_WTDN); ro = (size_t)e * DM; kb = q / 32; nb = q % 32; }
}
__device__ __forceinline__ void small_convert(Frame& F, int rank, int nconv) {
    LAS float* scr = (LAS float*)(F.lds + F.wave * 16640);
    const int gw = rank * 8 + F.wave, NGW = nconv * 8;
    for (int it = gw; it < 4 * 1024 + 128; it += NGW) {
        if (it < 1024) p0_transpose_item(F.in[13], DM, 2 * DM, (bf16_t*)(F.ws + WS_WTBR), 0, scr, it / 32, it % 32, F.lane);
        else if (it < 2048) p0_transpose_item(F.in[14], DM, 2 * DM, (bf16_t*)(F.ws + WS_WTBR) + DM, 0, scr, (it - 1024) / 32, it % 32, F.lane);
        else if (it < 3072) p0_transpose_item(F.in[17], DM, DM, (bf16_t*)(F.ws + WS_WTOUT), 0, scr, (it - 2048) / 32, it % 32, F.lane);
        else if (it < 4096) p0_transpose_item(F.in[27], DM, DM, (bf16_t*)(F.ws + WS_WTPLEG), 0, scr, (it - 3072) / 32, it % 32, F.lane);
        else p0_transpose_item(F.in[28], DM, PLE, (bf16_t*)(F.ws + WS_WTPLEUP), 0, scr, (it - 4096) / 32, it % 32, F.lane);
    }
}
__device__ __forceinline__ void moe_convert(Frame& F, int rank, int nconv, int it_lo, int it_hi, bool nostore = false) {
    LAS float* scr = (LAS float*)(F.lds + F.wave * 16640);
    const int gw = rank * 8 + F.wave, NGW = nconv * 8;
    const int NIT = it_hi;
    f32x4 va[16], vb[16];
    const float* W; int ldw, Kdst, kb, nb; bf16_t* WT; size_t ro;
    int it = it_lo + gw;
    if (it < NIT) { moe_item(it, F, W, ldw, Kdst, WT, ro, kb, nb); p0_tr_load(va, W, ldw, kb, nb, F.lane); }
    for (; it < NIT; it += 2 * NGW) {
        const float* W2; int ldw2, Kdst2, kb2, nb2; bf16_t* WT2; size_t ro2;
        const int it2 = it + NGW;
        if (it2 < NIT) { moe_item(it2, F, W2, ldw2, Kdst2, WT2, ro2, kb2, nb2); p0_tr_load(vb, W2, ldw2, kb2, nb2, F.lane); }
        p0_tr_finish8(va, Kdst, (unsigned char*)WT, ro, scr, kb, nb, F.lane, nostore);
        const int it3 = it2 + NGW;
        if (it3 < NIT) { moe_item(it3, F, W, ldw, Kdst, WT, ro, kb, nb); p0_tr_load(va, W, ldw, kb, nb, F.lane); }
        if (it2 < NIT) p0_tr_finish8(vb, Kdst2, (unsigned char*)WT2, ro2, scr, kb2, nb2, F.lane, nostore);
    }
    LDS_WAIT(); __syncthreads();
}

using pg8::Unit;
__device__ __forceinline__ u32x4 pack8(const f32x4 a, const f32x4 b) { u32x4 w; w.x = cvt_pk_bf16(a[0], a[1]); w.y = cvt_pk_bf16(a[2], a[3]); w.z = cvt_pk_bf16(b[0], b[1]); w.w = cvt_pk_bf16(b[2], b[3]); return w; }
__device__ __forceinline__ void unpack8(const u32x4 w, f32x4& a, f32x4& b) { a[0] = bflo(w.x); a[1] = bfhi(w.x); a[2] = bflo(w.y); a[3] = bfhi(w.y); b[0] = bflo(w.z); b[1] = bfhi(w.z); b[2] = bflo(w.w); b[3] = bfhi(w.w); }
__device__ __forceinline__ f32x4 exp4(const f32x4 v) { f32x4 r; r[0] = __expf(v[0]); r[1] = __expf(v[1]); r[2] = __expf(v[2]); r[3] = __expf(v[3]); return r; }
__device__ __forceinline__ f32x4 sig4(const f32x4 v) { f32x4 r; r[0] = fast_sigmoid(v[0]); r[1] = fast_sigmoid(v[1]); r[2] = fast_sigmoid(v[2]); r[3] = fast_sigmoid(v[3]); return r; }

constexpr float QSCALE = 0.08838834764831845f * LOG2E;

struct EpiInProj {
    static constexpr bool PERM = true, AFTER_DRAIN = false, HAS_MID = false;
    bf16_t *q, *k, *v, *gqp, *gqm, *gkp, *gkm, *gv, *sg, *gates;
    const float *gqn, *gkn, *bcum, *bmerge;
    LAS float* ex;
    __device__ __forceinline__ void operator()(const f32x4 (&acc)[2][2][4][2], const Unit& u, int wr, int wc, int fr, int fq) const {
        const int pn = u.pn, cl = wc * 32 + 8 * fq;
        const size_t row0 = (size_t)u.pm * 256 + wr * 64 + fr;
        if (pn < 16) {
#pragma unroll
            for (int ai = 0; ai < 2; ++ai)
#pragma unroll
                for (int m = 0; m < 4; ++m)
#pragma unroll
                    for (int bj = 0; bj < 2; ++bj) {
                        const f32x4 a = acc[ai][bj][m][0], b = acc[ai][bj][m][1];
                        float s = (a[0] * a[0] + a[1] * a[1]) + (a[2] * a[2] + a[3] * a[3]) + (b[0] * b[0] + b[1] * b[1]) + (b[2] * b[2] + b[3] * b[3]);
                        s += __shfl_xor(s, 16); s += __shfl_xor(s, 32);
                        if (fq == 0) ex[((ai * 128 + wr * 64 + m * 16 + fr) * 2 + bj) * 4 + wc] = s;
                    }
            LDS_WAIT(); __builtin_amdgcn_s_barrier(); asm volatile("" ::: "memory");
            const float* gn = (pn < 8) ? gqn : gkn; const float sc = (pn < 8) ? QSCALE : 1.0f;
            const f32x4 g0 = *(const f32x4*)(gn + cl), g1 = *(const f32x4*)(gn + cl + 4);
            bf16_t* base = ((pn < 8) ? q : k) + (pn & 7) * 256 + cl;
#pragma unroll
            for (int ai = 0; ai < 2; ++ai)
#pragma unroll
                for (int m = 0; m < 4; ++m) {
                    const int rl = ai * 128 + wr * 64 + m * 16 + fr;
#pragma unroll
                    for (int bj = 0; bj < 2; ++bj) {
                        const f32x4 p4 = *(const LAS f32x4*)(ex + (rl * 2 + bj) * 4);
                        const float rs = rsqrtf(((p4[0] + p4[1]) + (p4[2] + p4[3])) * (1.0f / 128.0f) + RMS_EPS) * sc;
                        *(u32x4*)(base + (row0 + ai * 128 + m * 16) * DM + bj * 128) = pack8(acc[ai][bj][m][0] * rs * g0, acc[ai][bj][m][1] * rs * g1);
                    }
                }
            return;
        }
        if (pn < 24 || (pn >= 32 && pn < 48)) {
            bf16_t* base = (pn < 24) ? v + (pn - 16) * 256 : (pn < 40 ? gv + (pn - 32) * 256 : sg + (pn - 40) * 256);
            const bool silu = pn >= 40;
            base += cl;
#pragma unroll
            for (int ai = 0; ai < 2; ++ai)
#pragma unroll
                for (int m = 0; m < 4; ++m)
#pragma unroll
                    for (int bj = 0; bj < 2; ++bj) {
                        f32x4 a = acc[ai][bj][m][0], b = acc[ai][bj][m][1];
                        if (silu) { a = a * sig4(a); b = b * sig4(b); }
                        *(u32x4*)(base + (row0 + ai * 128 + m * 16) * DM + bj * 128) = pack8(a, b);
                    }
            return;
        }
        if (pn < 32) {
            const bool isq = pn < 28; const int cg = ((pn - 24) & 3) * 256 + cl;
            bf16_t* bp = (isq ? gqp : gkp) + cg; bf16_t* bm = (isq ? gqm : gkm) + cg; const float sc = isq ? 0.0625f : 1.0f;
#pragma unroll
            for (int ai = 0; ai < 2; ++ai)
#pragma unroll
                for (int m = 0; m < 4; ++m)
#pragma unroll
                    for (int bj = 0; bj < 2; ++bj) {
                        const size_t r = row0 + ai * 128 + m * 16;
                        const f32x4 b0 = *(const f32x4*)(bcum + r * GL_KW + cg + bj * 128), b1 = *(const f32x4*)(bcum + r * GL_KW + cg + bj * 128 + 4);
                        const f32x4 a = acc[ai][bj][m][0] * sc, b = acc[ai][bj][m][1] * sc;
                        *(u32x4*)(bp + r * GL_KW + bj * 128) = pack8(a * exp4(b0), b * exp4(b1));
                        *(u32x4*)(bm + r * GL_KW + bj * 128) = pack8(a * exp4(-b0), b * exp4(-b1));
                    }
            return;
        }
    }
};
struct EpiGates {
    static constexpr bool PERM = true, AFTER_DRAIN = false, HAS_MID = false;
    bf16_t* gates; const float* bmerge;
    __device__ __forceinline__ void operator()(const f32x4 (&acc)[2][2][4][2], const Unit& u, int wr_, int wc_, int fr_, int fq_) const {
        int fr = fr_, fq = fq_, wr = wr_, wc = wc_; asm volatile("" : "+v"(fr), "+v"(fq), "+v"(wr), "+v"(wc));
        const int cg = u.pn * 256 + wc * 32 + 8 * fq;
        const size_t row0 = (size_t)u.pm * 256 + wr * 64 + fr;
#pragma unroll
        for (int bj = 0; bj < 2; ++bj) {
            const f32x4 bb0 = *(const f32x4*)(bmerge + cg + bj * 128), bb1 = *(const f32x4*)(bmerge + cg + bj * 128 + 4);
#pragma unroll
            for (int ai = 0; ai < 2; ++ai)
#pragma unroll
                for (int m = 0; m < 4; ++m)
                    *(u32x4*)(gates + (row0 + ai * 128 + m * 16) * (2 * DM) + cg + bj * 128) = pack8(sig4(acc[ai][bj][m][0] * W8_INV + bb0), sig4(acc[ai][bj][m][1] * W8_INV + bb1));
        }
    }
};

struct EpiMixed2 {
    static constexpr bool PERM = true, AFTER_DRAIN = false, HAS_MID = true;
    const bf16_t* gates; bf16_t* mixed;
    __device__ __forceinline__ void mid(f32x4 (&acc)[2][2][4][2], const Unit& u, int wr, int wc, int fr_, int fq_) const {
        int fr = fr_, fq = fq_; asm volatile("" : "+v"(fr), "+v"(fq));
        const size_t row0 = (size_t)u.pm * 256 + wr * 64 + fr; const int c0 = u.pn * 256 + wc * 32 + 8 * fq;
#pragma unroll
        for (int ai = 0; ai < 2; ++ai)
#pragma unroll
            for (int m = 0; m < 4; ++m)
#pragma unroll
                for (int bj = 0; bj < 2; ++bj) {
                    const size_t r = row0 + ai * 128 + m * 16; const int c = c0 + bj * 128;
                    f32x4 da, db, ga, gb; unpack8(*(const u32x4*)(gates + r * (2 * DM) + c), da, db); unpack8(*(const u32x4*)(gates + r * (2 * DM) + DM + c), ga, gb);
#pragma unroll
                    for (int j = 0; j < 4; ++j) { acc[ai][bj][m][0][j] *= da[j] * __builtin_amdgcn_rcpf(fmaxf(ga[j], 1e-30f)); acc[ai][bj][m][1][j] *= db[j] * __builtin_amdgcn_rcpf(fmaxf(gb[j], 1e-30f)); }
                    asm volatile("" ::: "memory");
                }
    }
    __device__ __forceinline__ void operator()(const f32x4 (&acc)[2][2][4][2], const Unit& u, int wr, int wc, int fr, int fq) const {
        const size_t row0 = (size_t)u.pm * 256 + wr * 64 + fr; const int c0 = u.pn * 256 + wc * 32 + 8 * fq;
#pragma unroll
        for (int ai = 0; ai < 2; ++ai)
#pragma unroll
            for (int m = 0; m < 4; ++m)
#pragma unroll
                for (int bj = 0; bj < 2; ++bj) {
                    const size_t r = row0 + ai * 128 + m * 16; const int c = c0 + bj * 128;
                    f32x4 ga, gb; unpack8(*(const u32x4*)(gates + r * (2 * DM) + DM + c), ga, gb);
#pragma unroll
                    for (int j = 0; j < 4; ++j) { ga[j] = fmaxf(ga[j], 1e-30f); gb[j] = fmaxf(gb[j], 1e-30f); }
                    *(u32x4*)(mixed + r * DM + c) = pack8(acc[ai][bj][m][0] * ga, acc[ai][bj][m][1] * gb);
                }
    }
};
struct EpiX1 {
    static constexpr bool PERM = false, AFTER_DRAIN = false, HAS_MID = false;
    const float* x; float* x1;
    __device__ __forceinline__ void operator()(const f32x4 (&acc)[2][2][4][2], const Unit& u, int wr, int wc, int fr, int fq) const {
        const size_t row0 = (size_t)u.pm * 256 + wr * 64 + fr; const int c0 = u.pn * 256 + wc * 32 + 4 * fq;
#pragma unroll
        for (int ai = 0; ai < 2; ++ai)
#pragma unroll
            for (int m = 0; m < 4; ++m)
#pragma unroll
                for (int bj = 0; bj < 2; ++bj)
#pragma unroll
                    for (int n = 0; n < 2; ++n) { const size_t o = (row0 + ai * 128 + m * 16) * DM + c0 + bj * 128 + n * 16;
                        *(f32x4*)(x1 + o) = *(const f32x4*)(x + o) + acc[ai][bj][m][n]; if (n) asm volatile("" ::: "memory"); }
    }
};
struct EpiOut {
    static constexpr bool PERM = false, AFTER_DRAIN = false, HAS_MID = false;
    const float* x2; const bf16_t* pnorm; float* out; float sc;
    __device__ __forceinline__ void operator()(const f32x4 (&acc)[2][2][4][2], const Unit& u, int wr, int wc, int fr_, int fq_) const {
        int fr = fr_, fq = fq_; asm volatile("" : "+v"(fr), "+v"(fq));
        const size_t row0 = (size_t)u.pm * 256 + wr * 64 + fr; const int c0 = u.pn * 256 + wc * 32 + 4 * fq;
#pragma unroll
        for (int ai = 0; ai < 2; ++ai)
#pragma unroll
            for (int m = 0; m < 4; ++m)
#pragma unroll
                for (int bj = 0; bj < 2; ++bj)
#pragma unroll
                    for (int n = 0; n < 2; ++n) { const size_t o = (row0 + ai * 128 + m * 16) * DM + c0 + bj * 128 + n * 16;
                        const u32x2 pw = *(const u32x2*)(pnorm + o); f32x4 pv; pv[0] = bflo(pw.x); pv[1] = bfhi(pw.x); pv[2] = bflo(pw.y); pv[3] = bfhi(pw.y);
                        *(f32x4*)(out + o) = *(const f32x4*)(x2 + o) + pv * sig4(acc[ai][bj][m][n] * sc); asm volatile("" ::: "memory"); }
    }
};
struct EpiGU {
    static constexpr bool PERM = true, AFTER_DRAIN = false, HAS_MID = false;
    const float* bgu; bf16_t* act;
    __device__ __forceinline__ void operator()(const f32x4 (&acc)[2][2][4][2], const Unit& u, int wr, int wc, int fr, int fq) const {
        const size_t row0 = (size_t)u.pm * 256 + wr * 64 + fr; const int e = u.pn >> 4, n16 = u.pn & 15, cl = wc * 32 + 8 * fq;
#pragma unroll
        for (int bj = 0; bj < 2; ++bj) {
            const float* bp = bgu + (size_t)e * (2 * DEXP) + n16 * 256 + bj * 128 + cl;
            const f32x4 b0 = *(const f32x4*)bp, b1 = *(const f32x4*)(bp + 4);
#pragma unroll
            for (int ai = 0; ai < 2; ++ai)
#pragma unroll
                for (int m = 0; m < 4; ++m) {
                    const f32x4 a = acc[ai][bj][m][0] + b0, b = acc[ai][bj][m][1] + b1;
                    float o[4];
#pragma unroll
                    for (int p = 0; p < 4; ++p) { const float gt = fminf(p < 2 ? a[2 * p] : b[2 * p - 4], 7.0f); const float up = fminf(fmaxf(p < 2 ? a[2 * p + 1] : b[2 * p - 3], -7.0f), 7.0f);
                        o[p] = (up + 1.0f) * gt * fast_sigmoid(1.702f * gt); }
                    u32x2 w; w.x = cvt_pk_bf16(o[0], o[1]); w.y = cvt_pk_bf16(o[2], o[3]);
                    *(u32x2*)(act + (row0 + ai * 128 + m * 16) * DEXP + n16 * 128 + bj * 64 + (cl >> 1)) = w;
                }
        }
    }
};
struct EpiGU8 {
    static constexpr bool PERM = true, AFTER_DRAIN = false, HAS_MID = false;
    const float* bgu; unsigned char* act;
    __device__ __forceinline__ void operator()(const f32x4 (&acc)[2][2][4][2], const Unit& u, int wr, int wc, int fr, int fq) const {
        const size_t row0 = (size_t)u.pm * 256 + wr * 64 + fr; const int e = u.pn >> 4, n16 = u.pn & 15, cl = wc * 32 + 8 * fq;
#pragma unroll
        for (int bj = 0; bj < 2; ++bj) {
            const float* bp = bgu + (size_t)e * (2 * DEXP) + n16 * 256 + bj * 128 + cl;
            const f32x4 b0 = *(const f32x4*)bp, b1 = *(const f32x4*)(bp + 4);
#pragma unroll
            for (int ai = 0; ai < 2; ++ai)
#pragma unroll
                for (int m = 0; m < 4; ++m) {
                    const f32x4 a = acc[ai][bj][m][0] * W8_INV + b0, b = acc[ai][bj][m][1] * W8_INV + b1;
                    float o[4];
#pragma unroll
                    for (int p = 0; p < 4; ++p) { const float gt = fminf(p < 2 ? a[2 * p] : b[2 * p - 4], 7.0f); const float up = fminf(fmaxf(p < 2 ? a[2 * p + 1] : b[2 * p - 3], -7.0f), 7.0f);
                        o[p] = (up + 1.0f) * gt * fast_sigmoid(1.702f * gt); }
                    *(unsigned*)(act + (row0 + ai * 128 + m * 16) * DEXP + n16 * 128 + bj * 64 + (cl >> 1)) = pack_fp8x4(o[0], o[1], o[2], o[3]);
                }
        }
    }
};
struct EpiDN8 {
    static constexpr bool PERM = true, AFTER_DRAIN = false, HAS_MID = false;
    const float* bdn; bf16_t* yb;
    __device__ __forceinline__ void operator()(const f32x4 (&acc)[2][2][4][2], const Unit& u, int wr, int wc, int fr, int fq) const {
        const size_t row0 = (size_t)u.pm * 256 + wr * 64 + fr; const int e = u.pn >> 3, n8 = u.pn & 7, cl = wc * 32 + 8 * fq;
#pragma unroll
        for (int bj = 0; bj < 2; ++bj) {
            const int c = n8 * 256 + bj * 128 + cl;
            const f32x4 b0 = *(const f32x4*)(bdn + (size_t)e * DM + c), b1 = *(const f32x4*)(bdn + (size_t)e * DM + c + 4);
#pragma unroll
            for (int ai = 0; ai < 2; ++ai)
#pragma unroll
                for (int m = 0; m < 4; ++m)
                    *(u32x4*)(yb + (row0 + ai * 128 + m * 16) * DM + c) = pack8(acc[ai][bj][m][0] * W8_INV + b0, acc[ai][bj][m][1] * W8_INV + b1);
        }
    }
};
struct EpiDN {
    static constexpr bool PERM = true, AFTER_DRAIN = false, HAS_MID = false;
    const float* bdn; bf16_t* yb;
    __device__ __forceinline__ void operator()(const f32x4 (&acc)[2][2][4][2], const Unit& u, int wr, int wc, int fr, int fq) const {
        const size_t row0 = (size_t)u.pm * 256 + wr * 64 + fr; const int e = u.pn >> 3, n8 = u.pn & 7, cl = wc * 32 + 8 * fq;
#pragma unroll
        for (int bj = 0; bj < 2; ++bj) {
            const int c = n8 * 256 + bj * 128 + cl;
            const f32x4 b0 = *(const f32x4*)(bdn + (size_t)e * DM + c), b1 = *(const f32x4*)(bdn + (size_t)e * DM + c + 4);
#pragma unroll
            for (int ai = 0; ai < 2; ++ai)
#pragma unroll
                for (int m = 0; m < 4; ++m)
                    *(u32x4*)(yb + (row0 + ai * 128 + m * 16) * DM + c) = pack8(acc[ai][bj][m][0] + b0, acc[ai][bj][m][1] + b1);
        }
    }
};

struct GroupedOrder {
    const LAS int* mtoff;
    int nN, lo, hi, r, step;
    __device__ __forceinline__ void init(const LAS int* mt, int nN_, int G, int c) {
        mtoff = mt; nN = nN_; const int U = mt[32] * nN_;
        if ((G & 7) == 0) { const int per = (U + 7) >> 3, xcd = c & 7; lo = xcd * per; hi = (lo + per < U) ? lo + per : U; r = c >> 3; step = G >> 3; }
        else { lo = 0; hi = U; r = c; step = G; }
    }
    __device__ __forceinline__ bool next(int i, Unit& u) const {
        const int L = lo + i * step + r; if (L >= hi) return false;
        int e = 0;
#pragma unroll 1
        for (int j = 1; j < 32; ++j) if (L >= mtoff[j] * nN) e = j;
        const int mt = mtoff[e + 1] - mtoff[e], rem = L - mtoff[e] * nN, n = rem / mt, m = rem - n * mt;
        u.pm = __builtin_amdgcn_readfirstlane(mtoff[e] + m); u.pn = __builtin_amdgcn_readfirstlane(e * nN + n); u.flags = __builtin_amdgcn_readfirstlane((mtoff[34 + e] - 256 * m <= 128) ? 1 : 0); return true;
    }
    __device__ __forceinline__ void a_ready(const Unit&) const {}
    __device__ __forceinline__ void done(const Unit&) const {}
};

__device__ __forceinline__ bf16x8 pk8(const float a0, const float a1, const float a2, const float a3, const float a4, const float a5, const float a6, const float a7) {
    u32x4 w; w.x = cvt_pk_bf16(a0, a1); w.y = cvt_pk_bf16(a2, a3); w.z = cvt_pk_bf16(a4, a5); w.w = cvt_pk_bf16(a6, a7); return __builtin_bit_cast(bf16x8, w); }
constexpr int ATT_STAGE = 65536, ATT_K1 = 16384, ATT_V = 32768;
constexpr float ATT_THR = 8.0f;

struct AttnOffs { unsigned k, v; };
__device__ __forceinline__ AttnOffs attn_offs(int lane, int w) {
    AttnOffs o;
    { const int key = 4 * w + (lane >> 4), ch = (lane & 15) ^ (key & 7); o.k = (unsigned)(key * DM + ch * 8) * 2u; }
    { const int key = 2 * w + (lane >> 5), ch = (lane & 31) ^ ((key & 3) << 2); o.v = (unsigned)(key * DM + ch * 8) * 2u; }
    return o;
}
__device__ __forceinline__ void attn_issue_tile(const Frame& F, const AttnOffs& ao, const char* kg, const char* vg, int stage) {
    const int w = F.wave;
#pragma unroll
    for (int c = 0; c < 2; ++c)
#pragma unroll
        for (int i = 0; i < 2; ++i)
            __builtin_amdgcn_global_load_lds((const unsigned*)(kg + c * 256 + i * (32 * DM * 2) + ao.k), (LAS unsigned*)(F.lds + stage * ATT_STAGE + c * ATT_K1 + (w + 8 * i) * 1024), 16, 0, 0);
#pragma unroll
    for (int i = 0; i < 4; ++i)
        __builtin_amdgcn_global_load_lds((const unsigned*)(vg + i * (16 * DM * 2) + ao.v), (LAS unsigned*)(F.lds + stage * ATT_STAGE + ATT_V + (w + 8 * i) * 1024), 16, 0, 0);
}

__device__ __forceinline__ void attn_unit(const Frame& F, int b, int h, int qb, float lam) {
    const bf16_t* Qg = (const bf16_t*)(F.ws + WS_Q); const bf16_t* Kg = (const bf16_t*)(F.ws + WS_K); const bf16_t* Vg = (const bf16_t*)(F.ws + WS_V);
    bf16_t* Y = (bf16_t*)(F.ws + WS_YCAT);
    int lane; asm volatile("v_mbcnt_lo_u32_b32 %0, -1, 0\n\tv_mbcnt_hi_u32_b32 %0, -1, %0" : "=v"(lane));
    const int w = F.wave, c = w >> 2, r0 = (w & 3) * 32, hi = lane >> 5, ql = lane & 31;
    const int NT = 2 * qb + 2, jlast = 2 * qb + (r0 >> 6);
    const size_t tok0 = (size_t)b * SEQ;
    const char* kbase = (const char*)(Kg + tok0 * DM + h * 256); const char* vbase = (const char*)(Vg + tok0 * DM + h * 256);
    const AttnOffs ao = attn_offs(lane, w);
    bf16x8 qf[8];
    { const char* qbase = (const char*)(Qg + (tok0 + qb * 128 + r0) * DM + h * 256 + c * 128); const unsigned qo = (unsigned)(ql * DM + 8 * hi) * 2u;
#pragma unroll
      for (int st = 0; st < 8; ++st) qf[st] = *(const bf16x8*)(qbase + qo + 32 * st); }
    attn_issue_tile(F, ao, kbase, vbase, 0);
    f32x16 o[8];
#pragma unroll
    for (int d = 0; d < 8; ++d)
#pragma unroll
        for (int r = 0; r < 16; ++r) o[d][r] = 0.f;
    float m_run = -1e30f, l_run = 0.f;
    const float slope = exp2f(-(float)(h + 1)) * LOG2E;
    const float tpos = (float)(qb * 128 + r0 + ql);
    const int kx = (ql & 7) << 4;
    const int koff = ql * 256;
    const int g1 = (lane >> 4) & 1, qq = (lane & 15) >> 2, pp = lane & 3;
    const int voff = (4 * hi + qq) * 512 + 32 * g1 + 16 * (pp >> 1) + 8 * (pp & 1);
    VM_WAIT(); __builtin_amdgcn_s_barrier(); asm volatile("" ::: "memory");
#define ATT_TR(dst, addr, off) asm volatile("ds_read_b64_tr_b16 %0, %1 offset:%2" : "=v"(dst) : "v"(addr), "n"(off))
#define ATT_VLOAD4(buf, A, dd, kh_) do { ATT_TR(buf[0], A, ((dd) >> 2) * 256 + (2 * (kh_)) * 8192); ATT_TR(buf[1], A, ((dd) >> 2) * 256 + (2 * (kh_)) * 8192 + 4096); \
        ATT_TR(buf[2], A, ((dd) >> 2) * 256 + (2 * (kh_) + 1) * 8192); ATT_TR(buf[3], A, ((dd) >> 2) * 256 + (2 * (kh_) + 1) * 8192 + 4096); } while (0)
#define ATT_VLOAD(buf, dd, kh_) do { if (((dd) & 3) == 0) ATT_VLOAD4(buf, va0, dd, kh_); else if (((dd) & 3) == 1) ATT_VLOAD4(buf, va1, dd, kh_); else if (((dd) & 3) == 2) ATT_VLOAD4(buf, va2, dd, kh_); else ATT_VLOAD4(buf, va3, dd, kh_); } while (0)
#define ATT_TILE(j, st_) do { \
        const int jj_ = (j); \
        if (jj_ + 1 < NT) attn_issue_tile(F, ao, kbase + (size_t)(jj_ + 1) * 64 * DM * 2, vbase + (size_t)(jj_ + 1) * 64 * DM * 2, st_ ^ 1); \
        if (jj_ <= jlast) { \
            const LAS unsigned char* Ks = F.lds + st_ * ATT_STAGE + c * ATT_K1; \
            const unsigned vbase = (unsigned)(size_t)(F.lds + st_ * ATT_STAGE + ATT_V) + (unsigned)voff; \
            const unsigned va0 = vbase + ((0 ^ qq) << 6), va1 = vbase + ((1 ^ qq) << 6), va2 = vbase + ((2 ^ qq) << 6), va3 = vbase + ((3 ^ qq) << 6); \
_Pragma("unroll") \
            for (int kh = 0; kh < 2; ++kh) {                            \
                f32x16 p0; \
_Pragma("unroll") \
                for (int r = 0; r < 16; ++r) p0[r] = 0.f; \
bf16x8 kf[4], kg_[4]; \
_Pragma("unroll") \
                for (int st = 0; st < 4; ++st) { const int co = ((2 * st + hi) << 4) ^ kx; kf[st] = *(const LAS bf16x8*)(Ks + kh * 8192 + koff + co); } \
                __builtin_amdgcn_sched_barrier(0); \
_Pragma("unroll") \
                for (int st = 0; st < 4; ++st) { const int co = ((2 * (st + 4) + hi) << 4) ^ kx; kg_[st] = *(const LAS bf16x8*)(Ks + kh * 8192 + koff + co); } \
_Pragma("unroll") \
                for (int st = 0; st < 4; ++st) p0 = __builtin_amdgcn_mfma_f32_32x32x16_bf16(kf[st], qf[st], p0, 0, 0, 0); \
                __builtin_amdgcn_sched_barrier(0); \
_Pragma("unroll") \
                for (int st = 0; st < 4; ++st) p0 = __builtin_amdgcn_mfma_f32_32x32x16_bf16(kg_[st], qf[st + 4], p0, 0, 0, 0); \
                __builtin_amdgcn_sched_barrier(0); \
                 \
                const float dq = tpos - (float)(64 * jj_ + 32 * kh + 4 * hi); \
                float mx = -1e30f; \
_Pragma("unroll") \
                for (int r = 0; r < 16; ++r) { const float cr = (float)((r & 3) + 8 * (r >> 2)); \
                    p0[r] = fmaf(-slope, fabsf(dq - cr), p0[r]); mx = fmaxf(mx, p0[r]); } \
                { auto rr_ = __builtin_amdgcn_permlane32_swap(__float_as_uint(mx), __float_as_uint(mx), false, false); mx = fmaxf(__uint_as_float(rr_[0]), __uint_as_float(rr_[1])); } \
                if (!__all(mx - m_run <= ATT_THR)) { \
                    const float mn = fmaxf(m_run, mx), al = __builtin_amdgcn_exp2f(m_run - mn); m_run = mn; l_run *= al; \
_Pragma("unroll") \
                    for (int d = 0; d < 8; ++d) \
_Pragma("unroll") \
                        for (int r = 0; r < 16; ++r) o[d][r] *= al; \
                } \
                float ps = 0.f; \
_Pragma("unroll") \
                for (int r = 0; r < 16; ++r) { p0[r] = __builtin_amdgcn_exp2f(p0[r] - m_run); ps += p0[r]; } \
                l_run += ps; \
                bf16x8 pf[2]; \
                pf[0] = pk8(p0[0], p0[1], p0[2], p0[3], p0[4], p0[5], p0[6], p0[7]); pf[1] = pk8(p0[8], p0[9], p0[10], p0[11], p0[12], p0[13], p0[14], p0[15]); \
                __builtin_amdgcn_sched_barrier(0); \
{ u32x2 vb[4][4]; \
                  ATT_VLOAD(vb[0], 0, kh); ATT_VLOAD(vb[1], 1, kh); ATT_VLOAD(vb[2], 2, kh); \
_Pragma("unroll") \
                  for (int d = 0; d < 8; ++d) { \
                    if (d < 5) { ATT_VLOAD(vb[(d + 3) & 3], d + 3, kh); asm volatile("s_waitcnt lgkmcnt(12)" ::: "memory"); } \
                    else if (d == 5) asm volatile("s_waitcnt lgkmcnt(8)" ::: "memory"); \
                    else if (d == 6) asm volatile("s_waitcnt lgkmcnt(4)" ::: "memory"); \
                    else asm volatile("s_waitcnt lgkmcnt(0)" ::: "memory"); \
                    __builtin_amdgcn_sched_barrier(0); \
                    { u32x4 w0, w1; w0.x = vb[d & 3][0].x; w0.y = vb[d & 3][0].y; w0.z = vb[d & 3][1].x; w0.w = vb[d & 3][1].y; w1.x = vb[d & 3][2].x; w1.y = vb[d & 3][2].y; w1.z = vb[d & 3][3].x; w1.w = vb[d & 3][3].y; \
                      o[d] = __builtin_amdgcn_mfma_f32_32x32x16_bf16(__builtin_bit_cast(bf16x8, w0), pf[0], o[d], 0, 0, 0); \
                      o[d] = __builtin_amdgcn_mfma_f32_32x32x16_bf16(__builtin_bit_cast(bf16x8, w1), pf[1], o[d], 0, 0, 0); } \
                    __builtin_amdgcn_sched_barrier(0); \
                  } } \
            } \
        } \
        VM_WAIT(); LDS_WAIT(); __builtin_amdgcn_s_barrier(); asm volatile("" ::: "memory"); \
    } while (0)
    for (int j = 0; j < NT; j += 2) { ATT_TILE(j, 0); ATT_TILE(j + 1, 1); }
#undef ATT_TILE
#undef ATT_VLOAD
#undef ATT_VLOAD4
#undef ATT_TR
    const float linv = 1.0f / (l_run + __shfl_xor(l_run, 32));
    LAS float* X = (LAS float*)F.lds + (size_t)(w & 3) * 128 * 64 + lane;
    if (c == 1) {
#pragma unroll
        for (int d = 0; d < 8; ++d)
#pragma unroll
            for (int r = 0; r < 16; ++r) X[(d * 16 + r) * 64] = o[d][r] * linv;
    }
    LDS_WAIT(); __builtin_amdgcn_s_barrier(); asm volatile("" ::: "memory");
    if (c == 0) {
        float ss = 0.f;
#pragma unroll
        for (int d = 0; d < 8; ++d) {
#pragma unroll
            for (int r = 0; r < 16; ++r) { const float v = o[d][r] * linv - lam * X[(d * 16 + r) * 64]; o[d][r] = v; ss += v * v; }
            asm volatile("" ::: "memory"); }
        ss += __shfl_xor(ss, 32);
        const float rs = rsqrtf(ss * (1.0f / 256.0f) + RMS_EPS) * 0.8f;
        const float* sg = F.in[9];
        bf16_t* yp = (bf16_t*)((char*)(Y + (tok0 + qb * 128 + r0) * (2 * DM) + h * 256) + (unsigned)(ql * (2 * DM) + 4 * hi) * 2u);
#pragma unroll
        for (int d = 0; d < 8; ++d) {
            asm volatile("" ::: "memory");
#pragma unroll
            for (int r4 = 0; r4 < 4; ++r4) { const int dv = 32 * d + 8 * r4; const f32x4 g = *(const f32x4*)(sg + dv + 4 * hi);
                u32x2 wv; wv.x = cvt_pk_bf16(o[d][4 * r4] * rs * g[0], o[d][4 * r4 + 1] * rs * g[1]); wv.y = cvt_pk_bf16(o[d][4 * r4 + 2] * rs * g[2], o[d][4 * r4 + 3] * rs * g[3]);
                *(u32x2*)(yp + dv) = wv; }
        }
    }
    LDS_WAIT(); __builtin_amdgcn_s_barrier(); asm volatile("" ::: "memory");
}

__device__ __forceinline__ void gla_scores_phase(const Frame& F) {
    const bf16_t* qp = (const bf16_t*)(F.ws + WS_GQP); const bf16_t* qm = (const bf16_t*)(F.ws + WS_GQM);
    const bf16_t* kp = (const bf16_t*)(F.ws + WS_GKP); const bf16_t* km = (const bf16_t*)(F.ws + WS_GKM);
    bf16_t* attc = (bf16_t*)(F.ws + WS_ATTC);
    LAS float* tmp = (LAS float*)F.lds;
    const int lane = F.lane, w = F.wave, which = w >> 2, mi = (w >> 1) & 1, si = w & 1, hi = lane >> 5, l31 = lane & 31;
    for (int unit = blockIdx.x; unit < NB * GL_H * NCH; unit += F.G) {
        const int b = unit >> 8, h = (unit >> 6) & 3, ch = unit & 63;
        const size_t t0 = (size_t)b * SEQ + ch * 64;
        const bf16_t* A = (which ? qm : qp) + (t0 + 32 * mi + l31) * GL_KW + h * 256 + 8 * hi;
        const bf16_t* Bm = (which ? kp : km) + (t0 + 32 * si + l31) * GL_KW + h * 256 + 8 * hi;
        f32x16 acc;
#pragma unroll
        for (int r = 0; r < 16; ++r) acc[r] = 0.f;
#pragma unroll
        for (int st = 0; st < 16; ++st) acc = __builtin_amdgcn_mfma_f32_32x32x16_bf16(*(const bf16x8*)(A + 16 * st), *(const bf16x8*)(Bm + 16 * st), acc, 0, 0, 0);
        const int s = 32 * si + l31;
#pragma unroll
        for (int r = 0; r < 16; ++r) { const int t = 32 * mi + (r & 3) + 8 * (r >> 2) + 4 * hi; const bool keep = which ? (s > t) : (s <= t); acc[r] = keep ? acc[r] : 0.f; }
        if (which) {
#pragma unroll
            for (int r = 0; r < 16; ++r) { const int t = 32 * mi + (r & 3) + 8 * (r >> 2) + 4 * hi; tmp[t * 64 + s] = acc[r]; }
        }
        LDS_WAIT(); __syncthreads();
        if (!which) {
#pragma unroll
            for (int r = 0; r < 16; ++r) { const int t = 32 * mi + (r & 3) + 8 * (r >> 2) + 4 * hi; const float v = acc[r] + tmp[t * 64 + s];
                attc[((size_t)unit * 64 + t) * 64 + s] = (bf16_t)(cvt_pk_bf16(v, 0.f) & 0xffffu); }
        }
        LDS_WAIT(); __syncthreads();
    }
}

constexpr int GL_KST = 544, GL_AST = 144, GL_VST = 272;
constexpr int GL_KM = 0, GL_QP = 64 * GL_KST, GL_AT = 2 * 64 * GL_KST, GL_VV = GL_AT + 64 * GL_AST, GL_DEC = GL_VV + 64 * GL_VST;
__device__ __forceinline__ void gla_scan_unit(const Frame& F, int g) {
    const int b = g >> 4, h = (g >> 2) & 3, vg = g & 3;
    const bf16_t* qp = (const bf16_t*)(F.ws + WS_GQP); const bf16_t* km = (const bf16_t*)(F.ws + WS_GKM);
    const bf16_t* gv = (const bf16_t*)(F.ws + WS_GV); const bf16_t* attc = (const bf16_t*)(F.ws + WS_ATTC);
    const float* bcum = (const float*)(F.ws + WS_BCUM); float* og = (float*)(F.ws + WS_OGLA);
    const int tid = F.tid, lane = F.lane, w = F.wave, gq = lane >> 4, li = lane & 15, q4 = li >> 2, p4 = li & 3;
    f32x4 S[16];
#pragma unroll
    for (int i = 0; i < 16; ++i) S[i] = (f32x4){0.f, 0.f, 0.f, 0.f};
    u32x4 rk[4], rq[4], ra, rv[2]; float rdec = 0.f;
    const size_t tb0 = (size_t)b * SEQ;
#define GLA_LOAD(c) do { const size_t t0_ = tb0 + (size_t)(c) * 64; \
        _Pragma("unroll") for (int i = 0; i < 4; ++i) { const int idx = tid + 512 * i, row = idx >> 5, cc = idx & 31; \
            rk[i] = *(const u32x4*)(km + (t0_ + row) * GL_KW + h * 256 + cc * 8); rq[i] = *(const u32x4*)(qp + (t0_ + row) * GL_KW + h * 256 + cc * 8); } \
        ra = *(const u32x4*)(attc + ((size_t)((b * GL_H + h) * NCH + (c)) * 64 + (tid >> 3)) * 64 + (tid & 7) * 8); \
        _Pragma("unroll") for (int i = 0; i < 2; ++i) { const int idx = tid + 512 * i, row = idx >> 4, cc = idx & 15; \
            rv[i] = *(const u32x4*)(gv + (t0_ + row) * GL_VW + h * 512 + vg * 128 + cc * 8); } \
        if (tid < 256) rdec = bcum[(t0_ + 63) * GL_KW + h * 256 + tid]; } while (0)
    GLA_LOAD(0);
    for (int c = 0; c < NCH; ++c) {
        __syncthreads();
#pragma unroll
        for (int i = 0; i < 4; ++i) { const int idx = tid + 512 * i, row = idx >> 5, cc = idx & 31;
            *(LAS u32x4*)(F.lds + GL_KM + row * GL_KST + cc * 16) = rk[i]; *(LAS u32x4*)(F.lds + GL_QP + row * GL_KST + cc * 16) = rq[i]; }
        *(LAS u32x4*)(F.lds + GL_AT + (tid >> 3) * GL_AST + (tid & 7) * 16) = ra;
#pragma unroll
        for (int i = 0; i < 2; ++i) { const int idx = tid + 512 * i, row = idx >> 4, cc = idx & 15; *(LAS u32x4*)(F.lds + GL_VV + row * GL_VST + cc * 16) = rv[i]; }
        if (tid < 256) *(LAS float*)(F.lds + GL_DEC + tid * 4) = __expf(rdec);
        LDS_WAIT(); __syncthreads();
        if (c + 1 < NCH) GLA_LOAD(c + 1);
        const size_t t0 = tb0 + (size_t)c * 64;
        bf16x8 bv[2];
#pragma unroll
        for (int st = 0; st < 2; ++st) { const LAS unsigned char* p = F.lds + GL_VV + (32 * st + 8 * gq + q4) * GL_VST + (16 * w + 4 * p4) * 2;
            bv[st] = cat8(lds_tr16(p), lds_tr16(p + 4 * GL_VST)); }
        bf16x8 af[2][4];
#pragma unroll
        for (int st = 0; st < 2; ++st)
#pragma unroll
            for (int tb = 0; tb < 4; ++tb) af[st][tb] = *(const LAS bf16x8*)(F.lds + GL_AT + (16 * tb + li) * GL_AST + (32 * st + 8 * gq) * 2);
        f32x4 o[4];
#pragma unroll
        for (int tb = 0; tb < 4; ++tb) o[tb] = (f32x4){0.f, 0.f, 0.f, 0.f};
        u32x4 qa[2][4];
#define GLA_LOADQ(buf, ks_) do { _Pragma("unroll") for (int tb = 0; tb < 4; ++tb) { const LAS unsigned char* p = F.lds + GL_QP + (16 * tb + li) * GL_KST + (32 * (ks_) + 4 * gq) * 2; \
            const u32x2 a0 = *(const LAS u32x2*)p, a1 = *(const LAS u32x2*)(p + 32); buf[tb].x = a0.x; buf[tb].y = a0.y; buf[tb].z = a1.x; buf[tb].w = a1.y; } } while (0)
        GLA_LOADQ(qa[0], 0);
#pragma unroll
        for (int ks = 0; ks < 8; ++ks) {
            if (ks < 7) GLA_LOADQ(qa[(ks + 1) & 1], ks + 1);
            __builtin_amdgcn_sched_barrier(0);
            const bf16x8 sb = pk8(S[2 * ks][0], S[2 * ks][1], S[2 * ks][2], S[2 * ks][3], S[2 * ks + 1][0], S[2 * ks + 1][1], S[2 * ks + 1][2], S[2 * ks + 1][3]);
#pragma unroll
            for (int tb = 0; tb < 4; ++tb) o[tb] = __builtin_amdgcn_mfma_f32_16x16x32_bf16(__builtin_bit_cast(bf16x8, qa[ks & 1][tb]), sb, o[tb], 0, 0, 0);
            __builtin_amdgcn_sched_barrier(0);
        }
#undef GLA_LOADQ
#pragma unroll
        for (int st = 0; st < 2; ++st)
#pragma unroll
            for (int tb = 0; tb < 4; ++tb) o[tb] = __builtin_amdgcn_mfma_f32_16x16x32_bf16(af[st][tb], bv[st], o[tb], 0, 0, 0);
        bf16x8 ak[2][2];
#define GLA_LOADK(buf, kb_) do { _Pragma("unroll") for (int st = 0; st < 2; ++st) { const LAS unsigned char* p = F.lds + GL_KM + (32 * st + 8 * gq + q4) * GL_KST + (16 * (kb_) + 4 * p4) * 2; \
            buf[st] = cat8(lds_tr16(p), lds_tr16(p + 4 * GL_KST)); } } while (0)
        GLA_LOADK(ak[0], 0);
#pragma unroll
        for (int kb = 0; kb < 16; ++kb) {
            if (kb < 15) GLA_LOADK(ak[(kb + 1) & 1], kb + 1);
            const f32x4 d = *(const LAS f32x4*)(F.lds + GL_DEC + (16 * kb + 4 * gq) * 4);
            __builtin_amdgcn_sched_barrier(0);
            S[kb] = __builtin_amdgcn_mfma_f32_16x16x32_bf16(ak[kb & 1][0], bv[0], S[kb], 0, 0, 0);
            S[kb] = __builtin_amdgcn_mfma_f32_16x16x32_bf16(ak[kb & 1][1], bv[1], S[kb], 0, 0, 0);
            S[kb] = S[kb] * d;
            __builtin_amdgcn_sched_barrier(0);
        }
#undef GLA_LOADK
#pragma unroll
        for (int tb = 0; tb < 4; ++tb)
#pragma unroll
            for (int r = 0; r < 4; ++r) og[(t0 + 16 * tb + 4 * gq + r) * GL_VW + h * 512 + vg * 128 + 16 * w + li] = o[tb][r];
    }
#undef GLA_LOAD
    __syncthreads();
}

__device__ __forceinline__ void gla_out_phase(const Frame& F) {
    const float* og = (const float*)(F.ws + WS_OGLA); const bf16_t* sg = (const bf16_t*)(F.ws + WS_SG); bf16_t* yg = (bf16_t*)(F.ws + WS_YCAT) + DM;
    const float* gn = F.in[12];
    const int gw = blockIdx.x * 8 + F.wave, NGW = F.G * 8, lane = F.lane;
    const f32x4 g0 = *(const f32x4*)(gn + 8 * lane), g1 = *(const f32x4*)(gn + 8 * lane + 4);
    for (int rw = gw; rw < TOK * GL_H; rw += NGW) {
        const size_t off = (size_t)rw * 512 + 8 * lane;
        const f32x4 a = *(const f32x4*)(og + off), b = *(const f32x4*)(og + off + 4);
        float ss = (a[0] * a[0] + a[1] * a[1]) + (a[2] * a[2] + a[3] * a[3]) + (b[0] * b[0] + b[1] * b[1]) + (b[2] * b[2] + b[3] * b[3]);
        ss = wave_sum(ss);
        const float rs = rsqrtf(ss * (1.0f / 512.0f) + RMS_EPS);
        f32x4 sa, sb; unpack8(*(const u32x4*)(sg + off), sa, sb);
        *(u32x4*)(yg + (size_t)(rw >> 2) * (2 * DM) + (rw & 3) * 512 + 8 * lane) = pack8(a * rs * g0 * sa, b * rs * g1 * sb);
    }
}

__device__ __forceinline__ void route_phase(const Frame& F, int rep) {
    const float* x1 = (const float*)(F.ws + WS_X1); const float* gf = F.in[19]; const float* wr = F.in[20]; const float* rb = F.in[21];
    bf16_t* h2 = (bf16_t*)(F.ws + WS_H2);
    int* topi = (int*)(F.ws + WS_ROUTE + rep * 524288); float* gate = (float*)(F.ws + WS_ROUTE + 131072 + rep * 524288); int* posn = (int*)(F.ws + WS_ROUTE + 262144 + rep * 524288);
    unsigned* cnt = (unsigned*)(F.ws + WS_CTL) + CW_CNT + rep * 2048;
    const int lane = F.lane, gw = blockIdx.x * 8 + F.wave, NGW = F.G * 8, e = lane & 31, hf = lane >> 5;
    LAS float* wsh = (LAS float*)(F.lds);
    for (int base = blockIdx.x * 8; base < TOK / 4; base += NGW) {
        const int gp = base + F.wave;
        float lg[4];
        f32x4 xv[4][8];
#pragma unroll
        for (int i = 0; i < 4; ++i) { const float* xrow = x1 + (size_t)(4 * gp + i) * DM + 4 * lane;
#pragma unroll
            for (int j = 0; j < 8; ++j) xv[i][j] = *(const f32x4*)(xrow + 256 * j); }
#pragma unroll
        for (int i = 0; i < 4; ++i) { float ss = 0.f;
#pragma unroll
            for (int j = 0; j < 8; ++j) ss += (xv[i][j][0] * xv[i][j][0] + xv[i][j][1] * xv[i][j][1]) + (xv[i][j][2] * xv[i][j][2] + xv[i][j][3] * xv[i][j][3]);
            ss = wave_sum(ss);
            const float rs = rsqrtf(ss * (1.0f / DM) + RMS_EPS);
            unsigned char* hrow = (unsigned char*)h2 + (size_t)(4 * gp + i) * DM + 4 * lane; const float* gfl = gf + 4 * lane; asm volatile("" : "+v"(hrow), "+v"(gfl));
#pragma unroll
            for (int j = 0; j < 8; ++j) { const f32x4 g = *(const f32x4*)(gfl + 256 * j); const f32x4 hv = xv[i][j] * rs * g; xv[i][j] = hv;
                *(unsigned*)(hrow + 256 * j) = pack_fp8x4(hv[0], hv[1], hv[2], hv[3]); }
        }
        f32x4 acc[2][2];
#pragma unroll
        for (int tg = 0; tg < 2; ++tg)
#pragma unroll
            for (int eg = 0; eg < 2; ++eg) acc[tg][eg] = (f32x4){0.f, 0.f, 0.f, 0.f};
        LAS float* hsm = (LAS float*)(F.lds + 65536);
        f32x4 wreg[8];
        { const float* wb = wr + 4 * F.tid; asm volatile("" : "+v"(wb));
#pragma unroll
        for (int m = 0; m < 8; ++m) wreg[m] = *(const f32x4*)(wb + 2048 * m); }
#pragma unroll
        for (int wd = 0; wd < 4; ++wd) {
            __syncthreads();
#pragma unroll
            for (int m = 0; m < 8; ++m) *(LAS f32x4*)(wsh + 4 * (F.tid + 512 * m)) = wreg[m];
            if (wd < 3) { const float* wb = wr + (size_t)(512 * (wd + 1)) * NEXP + 4 * F.tid; asm volatile("" : "+v"(wb));
#pragma unroll
                for (int m = 0; m < 8; ++m) wreg[m] = *(const f32x4*)(wb + 2048 * m); }
#pragma unroll
            for (int i = 0; i < 4; ++i)
#pragma unroll
                for (int jj = 0; jj < 2; ++jj) *(LAS f32x4*)(hsm + (4 * F.wave + i) * 516 + 4 * (lane + 64 * jj)) = xv[i][2 * wd + jj];
            LDS_WAIT(); __syncthreads();
            const LAS float* ap = hsm + (lane & 15) * 516 + 64 * F.wave + (lane >> 4);
            const LAS float* bp = wsh + (64 * F.wave + (lane >> 4)) * NEXP + (lane & 15);
#pragma unroll 4
            for (int ks = 0; ks < 16; ++ks) {
                const float a0 = ap[4 * ks], a1 = ap[16 * 516 + 4 * ks], b0 = bp[4 * ks * NEXP], b1 = bp[4 * ks * NEXP + 16];
                acc[0][0] = __builtin_amdgcn_mfma_f32_16x16x4f32(a0, b0, acc[0][0], 0, 0, 0); acc[0][1] = __builtin_amdgcn_mfma_f32_16x16x4f32(a0, b1, acc[0][1], 0, 0, 0);
                acc[1][0] = __builtin_amdgcn_mfma_f32_16x16x4f32(a1, b0, acc[1][0], 0, 0, 0); acc[1][1] = __builtin_amdgcn_mfma_f32_16x16x4f32(a1, b1, acc[1][1], 0, 0, 0);
            }
        }
        __syncthreads();
#pragma unroll
        for (int tg = 0; tg < 2; ++tg)
#pragma unroll
            for (int eg = 0; eg < 2; ++eg)
#pragma unroll
                for (int r = 0; r < 4; ++r) wsh[F.wave * 1024 + (16 * tg + 4 * (lane >> 4) + r) * 32 + 16 * eg + (lane & 15)] = acc[tg][eg][r];
        LDS_WAIT(); __syncthreads();
#pragma unroll
        for (int i = 0; i < 4; ++i) { float sum = 0.f;
#pragma unroll
            for (int w8 = 0; w8 < 8; ++w8) sum += wsh[w8 * 1024 + (4 * F.wave + i) * 32 + e];
            lg[i] = sum; }
        LAS unsigned* lc = (LAS unsigned*)(F.lds + 133120);
        if (F.tid < 32) lc[F.tid] = 0u;
        LDS_WAIT(); __syncthreads();
        int lr[2][4];
#pragma unroll
        for (int rd = 0; rd < 2; ++rd) {
            const size_t t = (size_t)(4 * gp + 2 * hf + rd);
            float v = (hf ? lg[2 + rd] : lg[rd]) + rb[e];
            float selv[4]; int sele[4];
#pragma unroll
            for (int k = 0; k < TOPK; ++k) {
                float mx = v;
#pragma unroll
                for (int o = 1; o < 32; o <<= 1) mx = fmaxf(mx, __shfl_xor(mx, o));
                int idx = (v == mx) ? e : 64;
#pragma unroll
                for (int o = 1; o < 32; o <<= 1) idx = min(idx, __shfl_xor(idx, o));
                selv[k] = mx; sele[k] = idx;
                if (e == idx) v = -__builtin_inff();
            }
            const float e1 = __expf(selv[1] - selv[0]), e2 = __expf(selv[2] - selv[0]), e3 = __expf(selv[3] - selv[0]);
            const float inv = 1.0f / (1.0f + e1 + e2 + e3);
            const float gk[4] = {inv, e1 * inv, e2 * inv, e3 * inv};
#pragma unroll
            for (int k = 0; k < TOPK; ++k)
                if (e == sele[k]) { lr[rd][k] = (int)__hip_atomic_fetch_add(lc + e, 1u, __ATOMIC_RELAXED, __HIP_MEMORY_SCOPE_WORKGROUP); topi[t * 4 + k] = e; gate[t * 4 + k] = gk[k]; }
                else lr[rd][k] = -1;
        }
        LDS_WAIT(); __syncthreads();
        if (F.tid < 32) { const unsigned n = lc[F.tid]; lc[32 + F.tid] = n ? __hip_atomic_fetch_add(cnt + 64 * F.tid, n, RLX_AGENT) : 0u; }
        LDS_WAIT(); __syncthreads();
        const int rbase = (int)lc[32 + e];
#pragma unroll
        for (int rd = 0; rd < 2; ++rd)
#pragma unroll
            for (int k = 0; k < TOPK; ++k) if (lr[rd][k] >= 0) posn[(size_t)(4 * gp + 2 * hf + rd) * 4 + k] = rbase + lr[rd][k];
    }
}

__device__ __forceinline__ void build_mtoff(const Frame& F, LAS int* mt) {
    const unsigned* cnt = (const unsigned*)(F.ws + WS_CTL) + CW_CNT;
    if (F.wave == 0) {
        const int e = F.lane & 31;
        const unsigned c = __hip_atomic_load(cnt + 64 * e, RLX_AGENT);
        const int nt_ = (int)((c + 255u) >> 8); int incl = nt_;
#pragma unroll
        for (int o = 1; o < 32; o <<= 1) { const int v = __shfl_up(incl, o, 32); if (e >= o) incl += v; }
        if (F.lane < 32) { mt[e] = incl - nt_; mt[34 + e] = (int)c; if (e == 31) mt[NEXP] = incl; }
    }
    LDS_WAIT(); __syncthreads();
}

__device__ __forceinline__ void scatter_phase(const Frame& F, const LAS int* mt) {
    const bf16_t* h2 = (const bf16_t*)(F.ws + WS_H2); bf16_t* xs = (bf16_t*)(F.ws + WS_XS);
    const int* topi = (const int*)(F.ws + WS_ROUTE); const int* posn = (const int*)(F.ws + WS_ROUTE + 262144); int* rowof = (int*)(F.ws + WS_ROUTE + 393216);
    const int lane = F.lane, gw = blockIdx.x * 8 + F.wave, NGW = F.G * 8;
    for (int pi = gw; pi < TOK * TOPK; pi += NGW) {
        const int e = topi[pi], dest = 256 * mt[e] + posn[pi], t = pi >> 2;
        if (lane == 0) rowof[pi] = dest;
#pragma unroll
        for (int j = 0; j < 2; ++j) *(u32x4*)((unsigned char*)xs + (size_t)dest * DM + 16 * (lane + 64 * j)) = *(const u32x4*)((const unsigned char*)h2 + (size_t)t * DM + 16 * (lane + 64 * j));
    }
}

__device__ __forceinline__ void combine_phase(const Frame& F) {
    const float* x1 = (const float*)(F.ws + WS_X1); const bf16_t* yb = (const bf16_t*)(F.ws + WS_YB); float* x2 = (float*)(F.ws + WS_X2);
    bf16_t* h3 = (bf16_t*)(F.ws + WS_H3); const bf16_t* ub = (const bf16_t*)(F.ws + WS_UB); bf16_t* pnb = (bf16_t*)(F.ws + WS_PN);
    const float* gate = (const float*)(F.ws + WS_ROUTE + 131072); const int* rowof = (const int*)(F.ws + WS_ROUTE + 393216);
    const float* gp = F.in[26]; const float* gpost = F.in[29];
    const int lane = F.lane, gw = blockIdx.x * 8 + F.wave, NGW = F.G * 8;
    for (int t = gw; t < TOK; t += NGW) {
        f32x4 xa[4], xb[4];
#pragma unroll
        for (int j = 0; j < 4; ++j) { xa[j] = *(const f32x4*)(x1 + (size_t)t * DM + 8 * (lane + 64 * j)); xb[j] = *(const f32x4*)(x1 + (size_t)t * DM + 8 * (lane + 64 * j) + 4); }
#pragma unroll
        for (int k = 0; k < TOPK; ++k) { const float g = gate[t * 4 + k]; const size_t r = (size_t)rowof[t * 4 + k];
#pragma unroll
            for (int j = 0; j < 4; ++j) { f32x4 ya, ybv; unpack8(*(const u32x4*)(yb + r * DM + 8 * (lane + 64 * j)), ya, ybv); xa[j] += g * ya; xb[j] += g * ybv; } }
        float ss = 0.f;
#pragma unroll
        for (int j = 0; j < 4; ++j) { *(f32x4*)(x2 + (size_t)t * DM + 8 * (lane + 64 * j)) = xa[j]; *(f32x4*)(x2 + (size_t)t * DM + 8 * (lane + 64 * j) + 4) = xb[j];
            ss += (xa[j][0] * xa[j][0] + xa[j][1] * xa[j][1]) + (xa[j][2] * xa[j][2] + xa[j][3] * xa[j][3]) + (xb[j][0] * xb[j][0] + xb[j][1] * xb[j][1]) + (xb[j][2] * xb[j][2] + xb[j][3] * xb[j][3]); }
        ss = wave_sum(ss);
        const float rs = rsqrtf(ss * (1.0f / DM) + RMS_EPS);
#pragma unroll
        for (int j = 0; j < 4; ++j) { const f32x4 g0 = *(const f32x4*)(gp + 8 * (lane + 64 * j)), g1 = *(const f32x4*)(gp + 8 * (lane + 64 * j) + 4);
            const f32x4 ha_ = xa[j] * rs * g0, hb_ = xb[j] * rs * g1; u32x2 w8; w8.x = pack_fp8x4(ha_[0], ha_[1], ha_[2], ha_[3]); w8.y = pack_fp8x4(hb_[0], hb_[1], hb_[2], hb_[3]);
            *(u32x2*)((unsigned char*)h3 + (size_t)t * DM + 8 * (lane + 64 * j)) = w8; }
        f32x4 ua[4], uc[4]; float su = 0.f;
#pragma unroll
        for (int j = 0; j < 4; ++j) { unpack8(*(const u32x4*)(ub + (size_t)t * DM + 8 * (lane + 64 * j)), ua[j], uc[j]);
            su += (ua[j][0] * ua[j][0] + ua[j][1] * ua[j][1]) + (ua[j][2] * ua[j][2] + ua[j][3] * ua[j][3]) + (uc[j][0] * uc[j][0] + uc[j][1] * uc[j][1]) + (uc[j][2] * uc[j][2] + uc[j][3] * uc[j][3]); }
        su = wave_sum(su);
        const float ru = rsqrtf(su * (1.0f / DM) + RMS_EPS);
#pragma unroll
        for (int j = 0; j < 4; ++j) { const f32x4 g0 = *(const f32x4*)(gpost + 8 * (lane + 64 * j)), g1 = *(const f32x4*)(gpost + 8 * (lane + 64 * j) + 4);
            *(u32x4*)(pnb + (size_t)t * DM + 8 * (lane + 64 * j)) = pack8(ua[j] * ru * g0, uc[j] * ru * g1); }
    }
}

struct EpiPlain {
    static constexpr bool PERM = true, AFTER_DRAIN = false, HAS_MID = false;
    bf16_t* O;
    __device__ __forceinline__ void operator()(const f32x4 (&acc)[2][2][4][2], const Unit& u, int wr, int wc, int fr, int fq) const {
        const size_t row0 = (size_t)u.pm * 256 + wr * 64 + fr; const int c0 = u.pn * 256 + wc * 32 + 8 * fq;
#pragma unroll
        for (int ai = 0; ai < 2; ++ai)
#pragma unroll
            for (int m = 0; m < 4; ++m)
#pragma unroll
                for (int bj = 0; bj < 2; ++bj) *(u32x4*)(O + (row0 + ai * 128 + m * 16) * DM + c0 + bj * 128) = pack8(acc[ai][bj][m][0], acc[ai][bj][m][1]);
    }
};

#ifndef NCONV
#define NCONV 112
#endif
#ifndef NC1
#define NC1 0
#endif
constexpr int MOE_NIT = CV_NIT, MOE_SPLIT = NC1 ? (MOE_NIT * 27 / 100) / (NC1 * 8 + (NC1 == 0)) * (NC1 * 8) : 0;
__device__ __forceinline__ void attn_gla_phase(Frame& F, int rep) {
    volatile LAS unsigned* misc = (volatile LAS unsigned*)(F.lds + MISC_OFF);
    unsigned* ctl = (unsigned*)(F.ws + WS_CTL);
    const bool do_gla = (rep == 0 || rep == 1 || rep == 2 || rep == 6), do_att = (rep == 0 || rep == 1 || rep == 3 || rep == 6), do_conv = (rep == 0 || rep == 4 || rep == 5 || rep == 6);
    if ((int)blockIdx.x < NB * GL_H * 4) { if (do_gla) gla_scan_unit(F, (int)blockIdx.x); }
    else if ((int)blockIdx.x < NB * GL_H * 4 + NCONV) { if (do_conv) moe_convert(F, (int)blockIdx.x - NB * GL_H * 4, NCONV, MOE_SPLIT, MOE_NIT, rep == 5); }
    const float lam = __uint_as_float((unsigned)__builtin_amdgcn_readfirstlane((int)__hip_atomic_load(ctl + CW_LAM, RLX_AGENT)));
    if (do_att) for (;;) {
        if (F.tid == 0) misc[4] = __hip_atomic_fetch_add(ctl + CW_QUEUE + 64 * rep, 1u, RLX_AGENT);
        LDS_WAIT(); __syncthreads();
        const unsigned unit = misc[4];
        if (unit >= (unsigned)(NB * DA_H * (SEQ / 128))) break;
        const int qb = 31 - (int)(unit >> 4), bh = (int)(unit & 15);
        attn_unit(F, bh >> 3, bh & 7, qb, lam);
    }
    __syncthreads();
}

constexpr int NPHASE = 14;
struct Args { const float* in[30]; float* out; unsigned char* ws; int ph_lo, ph_hi, rep, pad; };
__global__ void __launch_bounds__(512, 2) mk_fwd(Args args) {
    extern __shared__ __attribute__((aligned(16))) unsigned char lds_raw[];
    Frame F;
    F.lds = (LAS unsigned char*)lds_raw;
    F.wave = __builtin_amdgcn_readfirstlane((int)threadIdx.x >> 6); refresh(F);
    F.G = gridDim.x; { const int bx = blockIdx.x; F.vcu = (F.G % 8 == 0) ? (bx % 8) * (F.G / 8) + bx / 8 : bx; }
    F.ws = args.ws; F.out = args.out;
#pragma unroll
    for (int i = 0; i < 30; ++i) F.in[i] = args.in[i];
    volatile LAS unsigned* misc = (volatile LAS unsigned*)(F.lds + MISC_OFF);
    if (F.tid < 64) misc[F.tid] = 0u;
    __syncthreads();
    unsigned* ctl = (unsigned*)(F.ws + WS_CTL);
    const int lo = args.ph_lo, hi = args.ph_hi;
    const bool multi = (hi - lo) > 1;
    XcdBarrier bar; bar.bar = ctl + CW_BAR; bar.x = 0; bar.st = nullptr; bar.wave = 0;
    if (multi) bar = xcd_barrier_post(ctl + CW_BAR, misc + 8);
    bar.wave = F.wave;
#ifndef PH_MASK
#define PH_MASK 0xFFFF
#endif
#define IN(k) (((PH_MASK >> (k)) & 1) && lo <= (k) && (k) < hi)
#define SEAM(k) do { if (IN(k) && IN((k) + 1)) xcd_barrier(bar); } while (0)
#ifndef REP_MASK
#define REP_MASK 0
#endif
#define NREP(k) ((((REP_MASK) >> (k)) & 1) ? 2 : 1)
#define REPSEAM(k) do { if (rep + 1 < NREP(k)) xcd_barrier(bar); } while (0)
    LAS int* mt = (LAS int*)(F.lds + MISC_OFF + 64);
    LAS unsigned char* ring = F.lds;

    if (IN(0)) { refresh(F); p0_prologue(F, args.rep); } SEAM(0);
    if (IN(1)) { refresh(F);
        const int ncomp = F.G - NC1;
        if ((int)blockIdx.x < ncomp) {
        pg8::Gemm g{(const bf16_t*)(F.ws + WS_H1), (const bf16_t*)(F.ws + WS_WTIN), TOK, IN_MAIN, DM, F.tid}; pg8::StaticOrder S; S.init(TOK, IN_MAIN, ncomp, (int)blockIdx.x);
        EpiInProj E{(bf16_t*)(F.ws + WS_Q), (bf16_t*)(F.ws + WS_K), (bf16_t*)(F.ws + WS_V), (bf16_t*)(F.ws + WS_GQP), (bf16_t*)(F.ws + WS_GQM), (bf16_t*)(F.ws + WS_GKP), (bf16_t*)(F.ws + WS_GKM),
                    (bf16_t*)(F.ws + WS_GV), (bf16_t*)(F.ws + WS_SG), (bf16_t*)(F.ws + WS_GATES), F.in[3], F.in[4], (const float*)(F.ws + WS_BCUM), F.in[16], (LAS float*)(F.lds + EX_OFF)};
        pg8::gemm_phase<EpiInProj, pg8::StaticOrder, true, true>(ring, g, S, E);
        refresh(F);
        { pg8::Gemm g2{(const bf16_t*)(F.ws + WS_H1F8), (const bf16_t*)(F.ws + WS_WTMG8), TOK, 2 * DM, DM / 2, F.tid}; pg8::StaticOrder S2; S2.init(TOK, 2 * DM, ncomp, (int)blockIdx.x);
          EpiGates E2{(bf16_t*)(F.ws + WS_GATES), F.in[16]};
          pg8::gemm_phase<EpiGates, pg8::StaticOrder, true, true, 2>(ring, g2, S2, E2); }
        }
#if NC1 > 0
        else if (args.rep == 0) moe_convert(F, (int)blockIdx.x - ncomp, NC1, 0, MOE_SPLIT);
#endif
    } SEAM(1);
    if (IN(2)) { refresh(F); gla_scores_phase(F); } SEAM(2);
    if (IN(3)) { refresh(F); attn_gla_phase(F, args.rep); } SEAM(3);
    if (IN(4)) { refresh(F); gla_out_phase(F); } SEAM(4);
    if (IN(5)) { refresh(F);
        pg8::Gemm g{(const bf16_t*)(F.ws + WS_YCAT), (const bf16_t*)(F.ws + WS_WTBR), TOK, DM, 2 * DM, F.tid}; pg8::StaticOrder S; S.init(TOK, DM, F.G, (int)blockIdx.x);
        EpiMixed2 E{(const bf16_t*)(F.ws + WS_GATES), (bf16_t*)(F.ws + WS_MIXED)};
        pg8::gemm_phase<EpiMixed2, pg8::StaticOrder, true, true>(ring, g, S, E);
    } SEAM(5);
    if (IN(6)) { refresh(F);
#ifndef NO_X1
        { pg8::Gemm g{(const bf16_t*)(F.ws + WS_MIXED), (const bf16_t*)(F.ws + WS_WTOUT), TOK, DM, DM, F.tid}; pg8::StaticOrder S; S.init(TOK, DM, F.G, (int)blockIdx.x);
          EpiX1 E{F.in[0], (float*)(F.ws + WS_X1)};
          pg8::gemm_phase<EpiX1, pg8::StaticOrder, true, true>(ring, g, S, E); }
#endif
#ifndef NO_PLEUP
        { int kple = PLE; asm volatile("" : "+s"(kple));
          pg8::Gemm g{(const bf16_t*)(F.ws + WS_PB), (const bf16_t*)(F.ws + WS_WTPLEUP), TOK, DM, kple, F.tid}; pg8::StaticOrder S; S.init(TOK, DM, F.G, (int)blockIdx.x);
          EpiPlain E{(bf16_t*)(F.ws + WS_UB)};
          pg8::gemm_phase<EpiPlain, pg8::StaticOrder, true, true>(ring, g, S, E); }
#endif
    } SEAM(6);
    if (IN(7)) { refresh(F); route_phase(F, args.rep); } SEAM(7);
    if (IN(8)) { refresh(F); build_mtoff(F, mt); scatter_phase(F, mt); } SEAM(8);
    if (IN(9)) { refresh(F);
        build_mtoff(F, mt);
        pg8::Gemm g{(const bf16_t*)(F.ws + WS_XS), (const bf16_t*)(F.ws + WS_WTGU), MAXROWS, 2 * DEXP, DM / 2, F.tid}; GroupedOrder S; S.init(mt, 16, F.G, (int)blockIdx.x);
        EpiGU8 E{F.in[23], (unsigned char*)(F.ws + WS_ACT)};
        pg8::gemm_phase<EpiGU8, GroupedOrder, true, true, 2>(ring, g, S, E);
    } SEAM(9);
    if (IN(10)) { refresh(F);
        build_mtoff(F, mt);
        pg8::Gemm g{(const bf16_t*)(F.ws + WS_ACT), (const bf16_t*)(F.ws + WS_WTDN), MAXROWS, DM, DEXP / 2, F.tid}; GroupedOrder S; S.init(mt, 8, F.G, (int)blockIdx.x);
        EpiDN8 E{F.in[25], (bf16_t*)(F.ws + WS_YB)};
        pg8::gemm_phase<EpiDN8, GroupedOrder, true, true, 2>(ring, g, S, E);
    } SEAM(10);
    if (IN(11)) { refresh(F); combine_phase(F); } SEAM(11);
    if (IN(12)) { refresh(F);
        pg8::Gemm g{(const bf16_t*)(F.ws + WS_H3), (const bf16_t*)(F.ws + WS_WTPLEG), TOK, DM, DM / 2, F.tid}; pg8::StaticOrder S; S.init(TOK, DM, F.G, (int)blockIdx.x);
        EpiOut E{(const float*)(F.ws + WS_X2), (const bf16_t*)(F.ws + WS_PN), F.out, W8_INV};
        pg8::gemm_phase<EpiOut, pg8::StaticOrder, true, true, 2>(ring, g, S, E);
    }
#undef IN
#undef SEAM
}

#ifndef MK_LAUNCHES
#define MK_LAUNCHES 1
#endif
extern "C" void kernel_launch(void* const* d_in, const int* in_sizes, int n_in, void* d_out, int out_size, void* d_ws, size_t ws_size, hipStream_t stream) {
    static int grid = 0;
    if (grid == 0) {
        if (n_in != 30 || out_size != TOK * DM || ws_size < WS_END) { fprintf(stderr, "kernel_launch: unexpected shapes (n_in %d out %d ws %zu)\n", n_in, out_size, ws_size); grid = -1; return; }
        int dev = 0, cus = 0, per_cu = 0;
        if (hipGetDevice(&dev) != hipSuccess || hipDeviceGetAttribute(&cus, hipDeviceAttributeMultiprocessorCount, dev) != hipSuccess) { grid = -1; return; }
        if (hipFuncSetAttribute((const void*)mk_fwd, hipFuncAttributeMaxDynamicSharedMemorySize, LDS_BYTES) != hipSuccess) { fprintf(stderr, "kernel_launch: hipFuncSetAttribute failed\n"); grid = -1; return; }
        if (hipOccupancyMaxActiveBlocksPerMultiprocessor(&per_cu, (const void*)mk_fwd, 512, LDS_BYTES) != hipSuccess || per_cu < 1) { fprintf(stderr, "kernel_launch: occupancy query says %d\n", per_cu); (void)hipGetLastError(); per_cu = 1; }
        grid = cus;
    }
    if (grid < 0) return;
    (void)hipMemsetAsync((char*)d_ws + WS_CTL, 0, CTL_ZERO_BYTES, stream);
    Args a{};
    for (int i = 0; i < 30; ++i) a.in[i] = (const float*)d_in[i];
    a.out = (float*)d_out; a.ws = (unsigned char*)d_ws;
#if MK_LAUNCHES == 1
    a.ph_lo = 0; a.ph_hi = NPHASE;
    hipLaunchKernelGGL(mk_fwd, dim3(grid), dim3(512), LDS_BYTES, stream, a);
#else
    for (int p = 0; p < 13; ++p) for (int rep = 0; rep < NREP(p); ++rep) { a.ph_lo = p; a.ph_hi = p + 1; a.rep = rep;
#ifdef PROBE3_MODE
        if (p == 3 && rep == 1) a.rep = PROBE3_MODE;
#endif
#ifdef PROBE0_MODE
        if (p == 0 && rep == 1) a.rep = PROBE0_MODE;
#endif
        hipLaunchKernelGGL(mk_fwd, dim3(grid), dim3(512), LDS_BYTES, stream, a); }
#endif
}
```

```cpp
#include <hip/hip_runtime.h>
#define MK_LAUNCHES 1
#include <cstdio>
#include <cstdint>
namespace pg8 {
#define PG8_LAS __attribute__((address_space(3)))
typedef unsigned short bf16_t;
typedef short bf16x8 __attribute__((ext_vector_type(8)));
typedef float f32x4 __attribute__((ext_vector_type(4)));
typedef unsigned u32x4 __attribute__((ext_vector_type(4)));
typedef long i64x2_t __attribute__((ext_vector_type(2)));
typedef short bf16x16_t __attribute__((ext_vector_type(16)));
typedef int i32x8_t __attribute__((ext_vector_type(8)));
constexpr int BM = 256, BK = 64, HALF = 128, HTB = HALF * BK * 2  , STAGE_BYTES = 8 * HTB, NXCD = 8, WGM = 8;

__host__ __device__ __forceinline__ int lds_byte(int r, int c) { const int st = (r >> 4) * 2 + (c >> 5), rr = r & 15, cc = c & 31, ob = rr * 64 + cc * 2; return st * 1024 + (ob ^ (((ob >> 9) & 1) << 5)); }
__host__ __device__ __forceinline__ void stage_rc(int b, int& R, int& C) { const int st = b / 1024, sb = b % 1024, swz = sb ^ (((sb >> 9) & 1) << 5); R = (st >> 1) * 16 + swz / 64; C = (st & 1) * 32 + (swz % 64) / 2; }
__host__ __device__ __forceinline__ int perm32(int rho) { const int n = rho >> 4, i = rho & 15; return 8 * (i >> 2) + 4 * n + (i & 3); }

struct Unit { int pm, pn, flags; };
struct Gemm { const bf16_t* A; const bf16_t* Bt; int M, N, K, tid; };

struct StaticOrder {
    int nM, nN, nwg, G, c;
    __host__ __device__ void init(int M, int N, int G_, int c_) { nM = M / BM; nN = N / BM; nwg = nM * nN; G = G_; c = c_; }
    __host__ __device__ bool next(int i, Unit& u) const {
        const long L = (long)i * G + c; if (L >= nwg) return false;
        int wgid = (int)L; { const int q = nwg / NXCD, r = nwg % NXCD, xcd = wgid % NXCD, off = wgid / NXCD; wgid = (xcd < r ? xcd * (q + 1) : r * (q + 1) + (xcd - r) * q) + off; }
        const int nig = WGM * nN, gid = wgid / nig, fm = gid * WGM, gsz = (nM - fm) < WGM ? (nM - fm) : WGM;
        u.pm = fm + ((wgid % nig) % gsz); u.pn = (wgid % nig) / gsz; u.flags = 0; return true;
    }
    __device__ __forceinline__ void a_ready(const Unit&) const {}
    __device__ __forceinline__ void done(const Unit&) const {}
};

__device__ __forceinline__ unsigned cvt_pk_bf16(float lo, float hi) { unsigned r; asm volatile("v_cvt_pk_bf16_f32 %0, %1, %2" : "=v"(r) : "v"(lo), "v"(hi)); return r; }
template <class Epi, class Sched, bool ALIGN_EPI = false, bool SP2 = false, int FP8 = 0  >
__device__ __forceinline__ void gemm_phase(PG8_LAS unsigned char* lds, const Gemm g, const Sched& S, const Epi& E) {
    const int tid = g.tid, wid = __builtin_amdgcn_readfirstlane(tid >> 6), lane = tid & 63, wr = wid >> 2, wc = wid & 3, fr = lane & 15, fq = lane >> 4;
    const int K = g.K, nt = K / BK;
    unsigned voffA[2], voffB[2];
#pragma unroll
    for (int i = 0; i < 2; ++i) { int R, C; stage_rc(tid * 16 + i * 8192, R, C); const int Rb = Epi::PERM ? ((R & ~31) + perm32(R & 31)) : R;
        voffA[i] = (unsigned)(R * K + C) * 2u; voffB[i] = (unsigned)(Rb * K + C) * 2u; }
    const size_t kstep = (size_t)(BK * 2);
    const size_t hstep = (size_t)HALF * K * 2;
    const size_t tstep = 2 * hstep;
    const unsigned ldsw = (unsigned)wid * 1024u;
    const int aoff = lds_byte(wr * 64 + fr, fq * 8), boff = lds_byte(wc * 32 + fr, fq * 8);
#define PG8_SA(b, h) (((b) * 2 + (h)) * HTB)
#define PG8_SB(b, h) ((4 + (b) * 2 + (h)) * HTB)
#define PG8_STAGE(bufoff, gbase, voff) do { _Pragma("unroll") for (int _i = 0; _i < 2; ++_i) { unsigned vo_ = (voff)[_i]; asm volatile("" : "+v"(vo_));   \
        __builtin_amdgcn_global_load_lds((const unsigned*)((const char*)(gbase) + vo_), (PG8_LAS unsigned*)(lds + (bufoff) + ldsw + _i * 8192), 16, 0, 0); } } while (0)
#define PG8_LDA(dst, b, h) do { _Pragma("unroll") for (int m = 0; m < 4; ++m) _Pragma("unroll") for (int k = 0; k < 2; ++k) dst[m][k] = *(const PG8_LAS bf16x8*)(lds + PG8_SA(b, h) + aoff + m * 2048 + k * 1024); } while (0)
#define PG8_LDB(dst, b, h) do { _Pragma("unroll") for (int n = 0; n < 2; ++n) _Pragma("unroll") for (int k = 0; k < 2; ++k) dst[n][k] = *(const PG8_LAS bf16x8*)(lds + PG8_SB(b, h) + boff + n * 2048 + k * 1024); } while (0)
#define PG8_MMA(ai, bj, At, Bt) do { __builtin_amdgcn_s_setprio(1); \
        if constexpr (FP8 == 2) { _Pragma("unroll") for (int m = 0; m < 4; ++m) _Pragma("unroll") for (int n = 0; n < 2; ++n) { \
            const bf16x16_t b16_ = __builtin_shufflevector(Bt[n][0], Bt[n][1], 0, 1, 2, 3, 4, 5, 6, 7, 8, 9, 10, 11, 12, 13, 14, 15), a16_ = __builtin_shufflevector(At[m][0], At[m][1], 0, 1, 2, 3, 4, 5, 6, 7, 8, 9, 10, 11, 12, 13, 14, 15); \
            acc[ai][bj][m][n] = __builtin_amdgcn_mfma_scale_f32_16x16x128_f8f6f4(__builtin_bit_cast(i32x8_t, b16_), __builtin_bit_cast(i32x8_t, a16_), acc[ai][bj][m][n], 0, 0, 0, 0, 0, 0); } } \
        else { _Pragma("unroll") for (int m = 0; m < 4; ++m) _Pragma("unroll") for (int n = 0; n < 2; ++n) _Pragma("unroll") for (int k = 0; k < 2; ++k) { \
        if constexpr (FP8 == 1) { const i64x2_t b2_ = __builtin_bit_cast(i64x2_t, Bt[n][k]), a2_ = __builtin_bit_cast(i64x2_t, At[m][k]); \
            acc[ai][bj][m][n] = __builtin_amdgcn_mfma_f32_16x16x32_fp8_fp8(b2_[0], a2_[0], acc[ai][bj][m][n], 0, 0, 0); \
            acc[ai][bj][m][n] = __builtin_amdgcn_mfma_f32_16x16x32_fp8_fp8(b2_[1], a2_[1], acc[ai][bj][m][n], 0, 0, 0); } \
        else acc[ai][bj][m][n] = __builtin_amdgcn_mfma_f32_16x16x32_bf16(Bt[n][k], At[m][k], acc[ai][bj][m][n], 0, 0, 0); } } __builtin_amdgcn_s_setprio(0); } while (0)
#define PG8_WAIT_V(n) asm volatile("s_waitcnt vmcnt(" #n ")" ::: "memory")
#define PG8_WAIT_L(n) asm volatile("s_waitcnt lgkmcnt(" #n ")" ::: "memory")
#define PG8_BAR __builtin_amdgcn_s_barrier()
#define PG8_SCHED __builtin_amdgcn_sched_barrier(0)
    Unit cur, nxt; int ui = 0;
    if (!S.next(0, cur)) return;
    f32x4 acc[2][2][4][2];
#pragma unroll
    for (int a = 0; a < 2; ++a)
#pragma unroll
        for (int b = 0; b < 2; ++b)
#pragma unroll
            for (int m = 0; m < 4; ++m)
#pragma unroll
                for (int n = 0; n < 2; ++n) acc[a][b][m][n] = (f32x4){0.f, 0.f, 0.f, 0.f};
    bf16x8 At[4][2], B0[2][2], B1[2][2];
    const char* cA = (const char*)g.A + (size_t)cur.pm * tstep; const char* cB = (const char*)g.Bt + (size_t)cur.pn * tstep;
    S.a_ready(cur);
    if constexpr (SP2) {
        PG8_STAGE(PG8_SB(0, 0), cB, voffB); PG8_STAGE(PG8_SB(0, 1), cB + hstep, voffB); PG8_STAGE(PG8_SA(0, 0), cA, voffA); PG8_STAGE(PG8_SA(0, 1), cA + hstep, voffA);
        if (wr == 1) PG8_BAR;
        PG8_WAIT_V(2); PG8_BAR;
        PG8_STAGE(PG8_SB(1, 0), cB + kstep, voffB); PG8_STAGE(PG8_SA(1, 0), cA + kstep, voffA); PG8_STAGE(PG8_SB(1, 1), cB + hstep + kstep, voffB);
        PG8_WAIT_V(6); PG8_BAR;
    } else {
        PG8_STAGE(PG8_SB(0, 0), cB, voffB); PG8_STAGE(PG8_SA(0, 0), cA, voffA); PG8_STAGE(PG8_SB(0, 1), cB + hstep, voffB); PG8_STAGE(PG8_SA(0, 1), cA + hstep, voffA);
        if (wr == 1) PG8_BAR;
        PG8_WAIT_V(4); PG8_BAR;
        PG8_STAGE(PG8_SB(1, 0), cB + kstep, voffB); PG8_STAGE(PG8_SA(1, 0), cA + kstep, voffA); PG8_STAGE(PG8_SB(1, 1), cB + hstep + kstep, voffB);
        PG8_WAIT_V(6); PG8_BAR;
    }
    for (;;) {
        const bool has_next = S.next(ui + 1, nxt);
        const char* nA = has_next ? (const char*)g.A + (size_t)nxt.pm * tstep : cA; const char* nB = has_next ? (const char*)g.Bt + (size_t)nxt.pn * tstep : cB;
        for (int t = 0; t < nt; t += 2) {
            const bool last = (t == nt - 2);
            const char* a1 = cA + (size_t)(t + 1) * kstep;
            const char* a2 = last ? nA : cA + (size_t)(t + 2) * kstep; const char* b2 = last ? nB : cB + (size_t)(t + 2) * kstep;
            const char* a3 = a2 + kstep; const char* b3 = b2 + kstep;
            if (last && has_next) S.a_ready(nxt);
            if constexpr (Epi::HAS_MID) { if (t == nt / 2) E.mid(acc, cur, wr, wc, fr, fq); }
            if constexpr (SP2) {
            PG8_LDB(B0, 0, 0); PG8_LDB(B1, 0, 1); PG8_SCHED; PG8_LDA(At, 0, 0); PG8_STAGE(PG8_SA(1, 1), a1 + hstep, voffA);
            PG8_WAIT_V(8); PG8_WAIT_L(0); PG8_BAR; PG8_MMA(0, 0, At, B0); PG8_MMA(0, 1, At, B1); PG8_BAR; PG8_SCHED;
            PG8_LDA(At, 0, 1); PG8_STAGE(PG8_SB(0, 0), b2, voffB); PG8_STAGE(PG8_SB(0, 1), b2 + hstep, voffB); PG8_STAGE(PG8_SA(0, 0), a2, voffA);
            PG8_WAIT_V(8); PG8_WAIT_L(0); PG8_BAR; if (!(cur.flags & 1)) { PG8_MMA(1, 0, At, B0); PG8_MMA(1, 1, At, B1); } PG8_BAR; PG8_SCHED;
            PG8_LDB(B0, 1, 0); PG8_LDB(B1, 1, 1); PG8_SCHED; PG8_LDA(At, 1, 0); PG8_STAGE(PG8_SA(0, 1), a2 + hstep, voffA);
            PG8_WAIT_V(8); PG8_WAIT_L(0); PG8_BAR; PG8_MMA(0, 0, At, B0); PG8_MMA(0, 1, At, B1); PG8_BAR; PG8_SCHED;
            PG8_LDA(At, 1, 1); PG8_STAGE(PG8_SB(1, 0), b3, voffB); PG8_STAGE(PG8_SB(1, 1), b3 + hstep, voffB); PG8_STAGE(PG8_SA(1, 0), a3, voffA);
            PG8_WAIT_V(8); PG8_WAIT_L(0); PG8_BAR; if (!(cur.flags & 1)) { PG8_MMA(1, 0, At, B0); PG8_MMA(1, 1, At, B1); } PG8_BAR; PG8_SCHED;
            } else {
            PG8_LDB(B0, 0, 0); PG8_SCHED; PG8_LDA(At, 0, 0); PG8_STAGE(PG8_SA(1, 1), a1 + hstep, voffA);
            PG8_WAIT_L(8); PG8_BAR; PG8_WAIT_L(0); PG8_MMA(0, 0, At, B0); PG8_BAR; PG8_SCHED;
            PG8_LDB(B1, 0, 1); PG8_STAGE(PG8_SB(0, 0), b2, voffB);
            PG8_BAR; PG8_WAIT_L(0); PG8_MMA(0, 1, At, B1); PG8_BAR;
            PG8_LDA(At, 0, 1); PG8_STAGE(PG8_SA(0, 0), a2, voffA);
            PG8_BAR; PG8_WAIT_L(0); PG8_MMA(1, 0, At, B0); PG8_BAR; PG8_SCHED;
            PG8_STAGE(PG8_SB(0, 1), b2 + hstep, voffB);
            PG8_WAIT_V(6); PG8_BAR; PG8_MMA(1, 1, At, B1); PG8_BAR;
            PG8_LDB(B0, 1, 0); PG8_SCHED; PG8_LDA(At, 1, 0); PG8_STAGE(PG8_SA(0, 1), a2 + hstep, voffA);
            PG8_WAIT_L(8); PG8_BAR; PG8_WAIT_L(0); PG8_MMA(0, 0, At, B0); PG8_BAR; PG8_SCHED;
            PG8_LDB(B1, 1, 1); PG8_STAGE(PG8_SB(1, 0), b3, voffB);
            PG8_BAR; PG8_WAIT_L(0); PG8_MMA(0, 1, At, B1); PG8_BAR;
            PG8_LDA(At, 1, 1); PG8_STAGE(PG8_SA(1, 0), a3, voffA);
            PG8_BAR; PG8_WAIT_L(0); PG8_MMA(1, 0, At, B0); PG8_BAR; PG8_SCHED;
            PG8_STAGE(PG8_SB(1, 1), b3 + hstep, voffB);
            PG8_WAIT_V(6); PG8_BAR; PG8_MMA(1, 1, At, B1); PG8_BAR;
            }
        }
        if constexpr (ALIGN_EPI) { if (wr == 0) PG8_BAR; }
        if constexpr (!Epi::AFTER_DRAIN) { E(acc, cur, wr, wc, fr, fq); S.done(cur); }
        if (!has_next) break;
#pragma unroll
        for (int a = 0; a < 2; ++a)
#pragma unroll
            for (int b = 0; b < 2; ++b)
#pragma unroll
                for (int m = 0; m < 4; ++m)
#pragma unroll
                    for (int n = 0; n < 2; ++n) acc[a][b][m][n] = (f32x4){0.f, 0.f, 0.f, 0.f};
        cur = nxt; cA = nA; cB = nB; ++ui;
        if constexpr (ALIGN_EPI) { if (wr == 1) PG8_BAR; }
    }
    PG8_WAIT_V(0);
    if constexpr (!ALIGN_EPI) { if (wr == 0) PG8_BAR; }
    PG8_BAR;
    if constexpr (Epi::AFTER_DRAIN) { E.fused(acc, cur, wr, wc, fr, fq, lds, wid, lane); S.done(cur); }
#undef PG8_SA
#undef PG8_SB
#undef PG8_STAGE
#undef PG8_LDA
#undef PG8_LDB
#undef PG8_MMA
#undef PG8_WAIT_V
#undef PG8_WAIT_L
#undef PG8_BAR
#undef PG8_SCHED
}
}
#define XB_TMO      128
#define XB_XCNT(j)  (256  + 64 * (j))
#define XB_XSUB(j)  (1280 + 64 * (j))
#define XB_XGEN(j)  (2304 + 64 * (j))
#define XB_TOP      3328
#define XB_TOPGEN   3392
#define XCD_BAR_WORDS 3456
#define XB_SPIN_CAP (1u << 18)
#define LAS __attribute__((address_space(3)))

__device__ __forceinline__ unsigned xb_ld(unsigned* p)              { return __hip_atomic_load(p, __ATOMIC_RELAXED, __HIP_MEMORY_SCOPE_AGENT); }
__device__ __forceinline__ unsigned xb_add(unsigned* p, unsigned v) { return __hip_atomic_fetch_add(p, v, __ATOMIC_RELAXED, __HIP_MEMORY_SCOPE_AGENT); }
__device__ __forceinline__ unsigned xb_xcc_id() { return (unsigned)__builtin_amdgcn_s_getreg((3 << 11) | 20) & 0xFu; }
#define XB_SPIN(cond, bar) do { unsigned _sp = 0; while (cond) { __builtin_amdgcn_s_sleep(1); \
    if ((++_sp & 255u) == 0u) { if (xb_ld(&(bar)[XB_TMO])) break; if (_sp > XB_SPIN_CAP) { atomicAdd(&(bar)[XB_TMO], 1u); break; } } } } while (0)

struct XcdBarrier {
    unsigned* bar; unsigned x; int wave;
    volatile LAS unsigned* st;
};

__device__ __forceinline__ XcdBarrier xcd_barrier_post(unsigned* bar, volatile LAS unsigned* st) {
    XcdBarrier b; b.bar = bar; b.x = xb_xcc_id(); b.st = st;
    if (threadIdx.x == 0) (void)xb_add(&bar[XB_XCNT(b.x)], 1u);
    return b;
}
__device__ __forceinline__ void xcd_barrier_complete(unsigned* bar, unsigned x, unsigned& nloc, unsigned& nx) {
    const unsigned G = gridDim.x * gridDim.y * gridDim.z;
    unsigned sum, cnt, mine, sp = 0u;
    for (;;) {
        sum = 0u; cnt = 0u; mine = 0u;
#pragma unroll
        for (unsigned j = 0; j < 16; ++j) { const unsigned c = xb_ld(&bar[XB_XCNT(j)]); sum += c; cnt += (c > 0u) ? 1u : 0u; mine = (j == x) ? c : mine; }
        if (sum == G) break;
        __builtin_amdgcn_s_sleep(1);
        if ((++sp & 255u) == 0u) { if (xb_ld(&bar[XB_TMO])) break; if (sp > XB_SPIN_CAP) { atomicAdd(&bar[XB_TMO], 1u); break; } }
    }
    nloc = mine > 0u ? mine : 1u; nx = cnt > 0u ? cnt : 1u;
}

__device__ __forceinline__ void xcd_barrier(const XcdBarrier& b) {
    asm volatile("s_waitcnt vmcnt(0)" ::: "memory");
    __syncthreads();
    if (b.wave == 0 && __builtin_amdgcn_mbcnt_hi(~0u, __builtin_amdgcn_mbcnt_lo(~0u, 0u)) == 0u) {
        unsigned* bar = b.bar;
        __builtin_amdgcn_s_waitcnt(0);
        unsigned nloc = b.st[0], nx = b.st[1];
        if (nloc == 0u) { xcd_barrier_complete(bar, b.x, nloc, nx); b.st[0] = nloc; b.st[1] = nx; }
        const unsigned old = xb_add(&bar[XB_XSUB(b.x)], 1u);
        const unsigned gen = old / nloc;
        if (old + 1u == (gen + 1u) * nloc) {
            __builtin_amdgcn_fence(__ATOMIC_RELEASE, "agent");
            asm volatile("s_waitcnt vmcnt(0)" ::: "memory");
            const unsigned og = xb_add(&bar[XB_TOP], 1u);
            const unsigned tg = og / nx;
            if (og + 1u == (tg + 1u) * nx) xb_add(&bar[XB_TOPGEN], 1u);
            else XB_SPIN(xb_ld(&bar[XB_TOPGEN]) == tg, bar);
            __builtin_amdgcn_fence(__ATOMIC_ACQUIRE, "agent");
            xb_add(&bar[XB_XGEN(b.x)], 1u);
            asm volatile("s_waitcnt vmcnt(0)" ::: "memory");
        } else {
            XB_SPIN(xb_ld(&bar[XB_XGEN(b.x)]) == gen, bar);
            __builtin_amdgcn_fence(__ATOMIC_ACQUIRE, "agent");
            asm volatile("s_waitcnt vmcnt(0)" ::: "memory");
        }
    }
    __syncthreads();
}


#define GAS __attribute__((address_space(1)))
using pg8::bf16_t; using pg8::bf16x8; using pg8::f32x4; using pg8::u32x4; using pg8::cvt_pk_bf16;
typedef short s16x4 __attribute__((ext_vector_type(4)));
typedef float f32x16 __attribute__((ext_vector_type(16)));
typedef float f32x2 __attribute__((ext_vector_type(2)));
typedef unsigned u32x2 __attribute__((ext_vector_type(2)));
#define RLX_AGENT __ATOMIC_RELAXED, __HIP_MEMORY_SCOPE_AGENT
#define LDS_WAIT() asm volatile("s_waitcnt lgkmcnt(0)" ::: "memory")
#define VM_WAIT() asm volatile("s_waitcnt vmcnt(0)" ::: "memory")

constexpr int NB = 2, SEQ = 4096, DM = 2048, TOK = NB * SEQ;
constexpr int PLE = 256;
constexpr int DA_H = 8, DA_D = 128, DA_V = 256;
constexpr int GL_H = 4, GL_DK = 256, GL_DV = 512, GL_KW = 1024, GL_VW = 2048, GL_R = 16;
constexpr int NEXP = 32, TOPK = 4, DEXP = 2048;
constexpr int IN_W = 12304, IN_MAIN = 12288;
constexpr int N_INP = IN_MAIN + 2 * DM;
constexpr int CHUNK = 64, NCH = SEQ / CHUNK;
constexpr float RMS_EPS = 1e-6f;
constexpr float LOG2E = 1.4426950408889634f;
constexpr int MAXROWS = 40960;

constexpr size_t MiB = 1u << 20;
constexpr size_t WS_CTL = 0, CTL_ZERO_BYTES = 1 * MiB;
constexpr size_t WS_WTIN = 1 * MiB;
constexpr size_t WS_WTBR = 65 * MiB;
constexpr size_t WS_WTOUT = 81 * MiB, WS_WTPLEG = 89 * MiB;
constexpr size_t WS_WTPLEUP = 97 * MiB;
constexpr size_t WS_WTGU = 98 * MiB;
constexpr size_t WS_WTDN = 610 * MiB;
constexpr size_t WS_H1 = 866 * MiB;
constexpr size_t WS_Q = 898 * MiB, WS_K = 930 * MiB, WS_V = 962 * MiB;
constexpr size_t WS_GQP = 994 * MiB, WS_GQM = 1010 * MiB, WS_GKP = 1026 * MiB, WS_GKM = 1042 * MiB;
constexpr size_t WS_GV = 1058 * MiB, WS_SG = 1090 * MiB;
constexpr size_t WS_GATES = 1122 * MiB;
constexpr size_t WS_BCUM = 1186 * MiB;
constexpr size_t WS_ATTC = 1218 * MiB;
constexpr size_t WS_YDA = 1222 * MiB;
constexpr size_t WS_OGLA = 1254 * MiB;
constexpr size_t WS_YGLA = 1318 * MiB;
constexpr size_t WS_YCAT = 1350 * MiB;
constexpr size_t WS_MIXED = 1414 * MiB;
constexpr size_t WS_X1 = 1446 * MiB;
constexpr size_t WS_H2 = 1510 * MiB;
constexpr size_t WS_ROUTE = 1542 * MiB;
constexpr size_t WS_XS = 1543 * MiB;
constexpr size_t WS_ACT = 1703 * MiB;
constexpr size_t WS_YB = 1863 * MiB;
constexpr size_t WS_X2 = 2023 * MiB;
constexpr size_t WS_H3 = 2087 * MiB;
constexpr size_t WS_PN = 2119 * MiB;
constexpr size_t WS_PB = 2151 * MiB;
constexpr size_t WS_UB = 2155 * MiB;
constexpr size_t WS_H1F8 = 2103 * MiB;
constexpr size_t WS_WTMG8 = 49 * MiB;
constexpr size_t WS_END = 2187 * MiB;
constexpr int CW_BAR = 4096;
constexpr int CW_CNT = 8192;
constexpr int CW_QUEUE = 12288;
constexpr int CW_LAM = 16384;

constexpr int RING_BYTES = 131072;
constexpr int EX_OFF = 131072;
constexpr int MISC_OFF = 139264 + 1024;
constexpr int LDS_BYTES = 160 * 1024;

struct Frame {
    LAS unsigned char* lds;
    int tid, lane, wave, G, vcu;
    unsigned char* ws;
    const float* in[30];
    float* out;
};

__device__ __forceinline__ void refresh(Frame& F) { int l; asm volatile("v_mbcnt_lo_u32_b32 %0, -1, 0\n\tv_mbcnt_hi_u32_b32 %0, -1, %0" : "=v"(l)); F.lane = l; F.tid = F.wave * 64 + l; }
__device__ __forceinline__ float wave_sum(float v) {
#pragma unroll
    for (int o = 1; o < 64; o <<= 1) v += __shfl_xor(v, o);
    return v;
}
__device__ __forceinline__ float bf2f(unsigned short b) { return __uint_as_float(((unsigned)b) << 16); }
__device__ __forceinline__ float bflo(unsigned w) { return __uint_as_float(w << 16); }
__device__ __forceinline__ float bfhi(unsigned w) { return __uint_as_float(w & 0xffff0000u); }
__device__ __forceinline__ float fast_sigmoid(float x) { return 1.0f / (1.0f + __expf(-x)); }
typedef short v4i16_t __attribute__((ext_vector_type(4)));
__device__ __forceinline__ s16x4 lds_tr16(const LAS unsigned char* p) { return __builtin_bit_cast(s16x4, __builtin_amdgcn_ds_read_tr16_b64_v4i16((LAS v4i16_t*)p)); }
__device__ __forceinline__ bf16x8 cat8(const s16x4 a, const s16x4 b) { bf16x8 r; r[0] = a[0]; r[1] = a[1]; r[2] = a[2]; r[3] = a[3]; r[4] = b[0]; r[5] = b[1]; r[6] = b[2]; r[7] = b[3]; return r; }

__device__ __forceinline__ void p0_tr_load(f32x4 (&v)[16], const float* W, int ldw, int kb, int nb, int lane) {
    const int k0 = 64 * kb, n0 = 64 * nb, lk = lane >> 4, ln = (lane & 15) * 4;
#pragma unroll
    for (int i = 0; i < 16; ++i) v[i] = __builtin_nontemporal_load((const f32x4*)(W + (size_t)(k0 + 4 * i + lk) * ldw + n0 + ln));
}
__device__ __forceinline__ void p0_tr_finish(const f32x4 (&v)[16], int Kdst, bf16_t* WT, size_t row_off, LAS float* scr, int kb, int nb, int lane, bool nostore = false) {
    const int k0 = 64 * kb, n0 = 64 * nb, lk = lane >> 4, ln = (lane & 15) * 4;
#pragma unroll
    for (int i = 0; i < 16; ++i) { LAS float* s = scr + (4 * i + lk) * 65 + ln; s[0] = v[i][0]; s[1] = v[i][1]; s[2] = v[i][2]; s[3] = v[i][3]; }
    LDS_WAIT(); asm volatile("" ::: "memory");
    const int c = lane & 7;
#pragma unroll
    for (int j = 0; j < 8; ++j) { const int n = (lane >> 3) + 8 * j; const LAS float* s = scr + (8 * c) * 65 + n;
        u32x4 o; o.x = cvt_pk_bf16(s[0 * 65], s[1 * 65]); o.y = cvt_pk_bf16(s[2 * 65], s[3 * 65]); o.z = cvt_pk_bf16(s[4 * 65], s[5 * 65]); o.w = cvt_pk_bf16(s[6 * 65], s[7 * 65]);
        if (!nostore || o.x == 0x12345678u) __builtin_nontemporal_store(o, (u32x4*)(WT + (row_off + n0 + n) * (size_t)Kdst + k0 + 8 * c)); }
    LDS_WAIT(); asm volatile("" ::: "memory");
}
constexpr float W8_SCALE = 32.0f, W8_INV = 1.0f / 32.0f;
__device__ __forceinline__ unsigned pack_fp8x4(float a, float b, float c, float d) {
    a = fminf(fmaxf(a, -448.f), 448.f); b = fminf(fmaxf(b, -448.f), 448.f); c = fminf(fmaxf(c, -448.f), 448.f); d = fminf(fmaxf(d, -448.f), 448.f);
    int w = 0; w = __builtin_amdgcn_cvt_pk_fp8_f32(a, b, w, false); w = __builtin_amdgcn_cvt_pk_fp8_f32(c, d, w, true); return (unsigned)w;
}
__device__ __forceinline__ void p0_tr_finish8(const f32x4 (&v)[16], int Kdst, unsigned char* WT, size_t row_off, LAS float* scr, int kb, int nb, int lane, bool nostore = false) {
    const int k0 = 64 * kb, n0 = 64 * nb, lk = lane >> 4, ln = (lane & 15) * 4;
#pragma unroll
    for (int i = 0; i < 16; ++i) { LAS float* s = scr + (4 * i + lk) * 65 + ln; s[0] = v[i][0]; s[1] = v[i][1]; s[2] = v[i][2]; s[3] = v[i][3]; }
    LDS_WAIT(); asm volatile("" ::: "memory");
    const int c = lane & 7;
#pragma unroll
    for (int j = 0; j < 8; ++j) { const int n = (lane >> 3) + 8 * j; const LAS float* s = scr + (8 * c) * 65 + n;
        u32x2 o; o.x = pack_fp8x4(s[0 * 65] * W8_SCALE, s[1 * 65] * W8_SCALE, s[2 * 65] * W8_SCALE, s[3 * 65] * W8_SCALE); o.y = pack_fp8x4(s[4 * 65] * W8_SCALE, s[5 * 65] * W8_SCALE, s[6 * 65] * W8_SCALE, s[7 * 65] * W8_SCALE);
        if (!nostore || o.x == 0x12345678u) __builtin_nontemporal_store(o, (u32x2*)(WT + (row_off + n0 + n) * (size_t)Kdst + k0 + 8 * c)); }
    LDS_WAIT(); asm volatile("" ::: "memory");
}
__device__ __forceinline__ void p0_transpose_item8(const float* W, int ldw, int Kdst, unsigned char* WT, size_t row_off, LAS float* scr, int kb, int nb, int lane) {
    f32x4 v[16]; p0_tr_load(v, W, ldw, kb, nb, lane); p0_tr_finish8(v, Kdst, WT, row_off, scr, kb, nb, lane);
}
__device__ __forceinline__ void p0_transpose_item(const float* W, int ldw, int Kdst, bf16_t* WT, size_t row_off, LAS float* scr, int kb, int nb, int lane, bool nostore = false) {
    f32x4 v[16]; p0_tr_load(v, W, ldw, kb, nb, lane); p0_tr_finish(v, Kdst, WT, row_off, scr, kb, nb, lane, nostore);
}

__device__ __forceinline__ float log_sigmoid_f(float z) { return fminf(z, 0.f) - __logf(1.0f + __expf(-fabsf(z))); }

__device__ __forceinline__ void p0_chunk_job(Frame& F, int ci) {
    const float* x = F.in[0]; const float* gmix = F.in[18]; const float* w_in = F.in[2];
    const float* w2 = F.in[10]; const float* gb = F.in[11];
    bf16_t* h1 = (bf16_t*)(F.ws + WS_H1); float* bcum = (float*)(F.ws + WS_BCUM);
    LAS float* glr_s = (LAS float*)(F.lds);
    int lane_ = F.lane; asm volatile("" : "+v"(lane_));
    const int t0 = ci * 64, lane = lane_, w = F.wave;
    {
        const float* pin = F.in[1]; bf16_t* pb = (bf16_t*)(F.ws + WS_PB);
#pragma unroll
        for (int r = 0; r < 8; ++r) { const size_t t = (size_t)(t0 + 8 * w + r); const f32x4 pv = *(const f32x4*)(pin + t * PLE + 4 * lane);
            u32x2 o; o.x = cvt_pk_bf16(pv[0], pv[1]); o.y = cvt_pk_bf16(pv[2], pv[3]); *(u32x2*)(pb + t * PLE + 4 * lane) = o; }
    }
    LAS float* wl = (LAS float*)(F.lds + 4096);
    for (int k = F.tid; k < DM; k += 512) { const float gk = gmix[k]; const int slot = (k & 3) * 512 + (k >> 2);
#pragma unroll
        for (int q = 0; q < 4; ++q) { const f32x4 wq = *(const f32x4*)(w_in + (size_t)k * IN_W + IN_MAIN + 4 * q) * gk; *(LAS f32x4*)(wl + slot * 16 + 4 * (q ^ ((slot >> 2) & 3))) = wq; } }
    LDS_WAIT(); __syncthreads();
    {
        f32x4 g[8];
#pragma unroll
        for (int j = 0; j < 8; ++j) g[j] = *(const f32x4*)(gmix + 4 * (lane + 64 * j));
        const int sw = (lane >> 2) & 3;
#pragma unroll 1
        for (int p = 0; p < 4; ++p) {
            f32x4 xv[2][8]; float rs2[2];
#pragma unroll
            for (int r = 0; r < 2; ++r) { const size_t t = (size_t)(t0 + 8 * w + 2 * p + r);
                const float* xrow = x + t * DM + 4 * lane; asm volatile("" : "+v"(xrow));
#pragma unroll
                for (int j = 0; j < 8; ++j) xv[r][j] = *(const f32x4*)(xrow + 256 * j); }
#pragma unroll
            for (int r = 0; r < 2; ++r) { const size_t t = (size_t)(t0 + 8 * w + 2 * p + r); float ss = 0.f;
#pragma unroll
                for (int j = 0; j < 8; ++j) ss += (xv[r][j][0] * xv[r][j][0] + xv[r][j][1] * xv[r][j][1]) + (xv[r][j][2] * xv[r][j][2] + xv[r][j][3] * xv[r][j][3]);
                ss = wave_sum(ss);
                const float rs = rsqrtf(ss * (1.0f / DM) + RMS_EPS); rs2[r] = rs;
                bf16_t* hrow = h1 + t * DM + 4 * lane; unsigned char* frow = F.ws + WS_H1F8 + t * DM + 4 * lane; asm volatile("" : "+v"(hrow), "+v"(frow));
#pragma unroll
                for (int j = 0; j < 8; ++j) { u32x2 o; o.x = cvt_pk_bf16(xv[r][j][0] * rs * g[j][0], xv[r][j][1] * rs * g[j][1]); o.y = cvt_pk_bf16(xv[r][j][2] * rs * g[j][2], xv[r][j][3] * rs * g[j][3]);
                    *(u32x2*)(hrow + 256 * j) = o;
                    *(unsigned*)(frow + 256 * j) = pack_fp8x4(xv[r][j][0] * rs * g[j][0], xv[r][j][1] * rs * g[j][1], xv[r][j][2] * rs * g[j][2], xv[r][j][3] * rs * g[j][3]); }
            }
            float acc[32];
#pragma unroll
            for (int i = 0; i < 32; ++i) acc[i] = 0.f;
            unsigned wb[8];
#pragma unroll
            for (int q = 0; q < 4; ++q) { unsigned b0 = 4096u + (unsigned)lane * 64u + 16u * (unsigned)(q ^ sw); asm volatile("" : "+v"(b0)); wb[q] = b0; unsigned b1 = b0 + 65536u; asm volatile("" : "+v"(b1)); wb[4 + q] = b1; }
#pragma unroll
            for (int j = 0; j < 8; ++j)
#pragma unroll
                for (int c = 0; c < 4; ++c) {
                    f32x4 wv[4];
#pragma unroll
                    for (int q = 0; q < 4; ++q) wv[q] = *(const LAS f32x4*)((const LAS unsigned char*)F.lds + wb[(c >> 1) * 4 + q] + ((c & 1) * 512 + 64 * j) * 64);
#pragma unroll
                    for (int r = 0; r < 2; ++r) { const float xg = xv[r][j][c];
#pragma unroll
                        for (int q = 0; q < 4; ++q) { acc[r * 16 + 4 * q + 0] += xg * wv[q][0]; acc[r * 16 + 4 * q + 1] += xg * wv[q][1]; acc[r * 16 + 4 * q + 2] += xg * wv[q][2]; acc[r * 16 + 4 * q + 3] += xg * wv[q][3]; } }
                    if (c & 1) asm volatile("" ::: "memory");
                }
#pragma unroll
            for (int n = 16, m = 32; n >= 1; n >>= 1, m >>= 1) {
                const bool up = (lane & m) != 0;
#pragma unroll
                for (int i = 0; i < n; ++i) { const float a = acc[i], b = acc[i + n]; const float send = up ? a : b, keep = up ? b : a; acc[i] = keep + __shfl_xor(send, m); }
            }
            acc[0] += __shfl_xor(acc[0], 1);
            const int idx = lane >> 1;
            if ((lane & 1) == 0) glr_s[(8 * w + 2 * p + (idx >> 4)) * 16 + (idx & 15)] = acc[0] * ((idx >> 4) ? rs2[1] : rs2[0]);
        }
    }
    LDS_WAIT(); __syncthreads();
    {
        const int c0 = F.tid, c1 = F.tid + 512;
        float wa[16], wb[16];
#pragma unroll
        for (int j = 0; j < 16; ++j) { wa[j] = w2[j * GL_KW + c0]; wb[j] = w2[j * GL_KW + c1]; }
        const float ba = gb[c0], bb = gb[c1]; float ra = 0.f, rb = 0.f;
        for (int r = 0; r < 64; ++r) {
            float za = ba, zb = bb;
#pragma unroll
            for (int q = 0; q < 4; ++q) { const f32x4 gv = *(const LAS f32x4*)(glr_s + r * 16 + 4 * q);
                za += gv[0] * wa[4 * q] + gv[1] * wa[4 * q + 1] + gv[2] * wa[4 * q + 2] + gv[3] * wa[4 * q + 3];
                zb += gv[0] * wb[4 * q] + gv[1] * wb[4 * q + 1] + gv[2] * wb[4 * q + 2] + gv[3] * wb[4 * q + 3]; }
            ra += log_sigmoid_f(za) * (1.0f / 16.0f); rb += log_sigmoid_f(zb) * (1.0f / 16.0f);
            bcum[(size_t)(t0 + r) * GL_KW + c0] = ra; bcum[(size_t)(t0 + r) * GL_KW + c1] = rb;
        }
    }
    LDS_WAIT(); __syncthreads();
}

__device__ __forceinline__ void p0_prologue(Frame& F, int rep = 0) {
    if (rep != 1) for (int ci = F.vcu; ci < TOK / CHUNK; ci += F.G) p0_chunk_job(F, ci);
    if (F.vcu == F.G - 1 && F.wave == 0) {
        const float* q1 = F.in[5]; const float* k1 = F.in[6]; const float* q2 = F.in[7]; const float* k2 = F.in[8];
        float s1 = q1[F.lane] * k1[F.lane] + q1[F.lane + 64] * k1[F.lane + 64], s2 = q2[F.lane] * k2[F.lane] + q2[F.lane + 64] * k2[F.lane + 64];
        s1 = wave_sum(s1); s2 = wave_sum(s2);
        if (F.lane == 0) { const float lam = expf(s1) - expf(s2) + 0.2f; ((unsigned*)(F.ws + WS_CTL))[CW_LAM] = __float_as_uint(lam); }
    }
    LAS float* scr = (LAS float*)(F.lds + F.wave * 16640);
    const int nch = TOK / CHUNK, ncv = (F.G > nch) ? F.G - nch : F.G;
    const int gw = ((F.G > nch) ? F.vcu - nch : F.vcu) * 8 + F.wave, NGW = ncv * 8;
    constexpr int I0 = 32 * 192, I1 = 32 * 64, I2 = 32 * 32, I6 = 4 * 32;
    constexpr int NITEMS = I0 + I1 + 4 * I2 + I6;
    struct It { const float* W; unsigned char* WT; int ldw, Kdst, kb, nb, f8; };
    auto decode = [&](int r) -> It {
        if (r < I0) return It{F.in[2], F.ws + WS_WTIN, IN_W, DM, r / 192, r % 192, 0}; r -= I0;
        if (r < I1) return It{F.in[15], F.ws + WS_WTMG8, 2 * DM, DM, r / 64, r % 64, 1}; r -= I1;
        if (r < I2) return It{F.in[13], F.ws + WS_WTBR, DM, 2 * DM, r / 32, r % 32, 0}; r -= I2;
        if (r < I2) return It{F.in[14], F.ws + WS_WTBR + 2 * DM, DM, 2 * DM, r / 32, r % 32, 0}; r -= I2;
        if (r < I2) return It{F.in[17], F.ws + WS_WTOUT, DM, DM, r / 32, r % 32, 0}; r -= I2;
        if (r < I2) return It{F.in[27], F.ws + WS_WTPLEG, DM, DM, r / 32, r % 32, 1}; r -= I2;
        return It{F.in[28], F.ws + WS_WTPLEUP, DM, PLE, r / 32, r % 32, 0};
    };
    for (int it = ((gw >= 0 && rep != 2) ? gw : NITEMS); it < NITEMS; it += 2 * NGW) {
        const int it2 = it + NGW; const bool two = it2 < NITEMS;
        const It a = decode(it), b = decode(two ? it2 : it);
        f32x4 va[16], vb[16];
        p0_tr_load(va, a.W, a.ldw, a.kb, a.nb, F.lane); p0_tr_load(vb, b.W, b.ldw, b.kb, b.nb, F.lane);
        if (a.f8) p0_tr_finish8(va, a.Kdst, a.WT, 0, scr, a.kb, a.nb, F.lane); else p0_tr_finish(va, a.Kdst, (bf16_t*)a.WT, 0, scr, a.kb, a.nb, F.lane);
        if (two) { if (b.f8) p0_tr_finish8(vb, b.Kdst, b.WT, 0, scr, b.kb, b.nb, F.lane); else p0_tr_finish(vb, b.Kdst, (bf16_t*)b.WT, 0, scr, b.kb, b.nb, F.lane); }
    }
    LDS_WAIT(); __syncthreads();
}

constexpr int CV_GU = 32 * 32 * 64, CV_DN = 32 * 32 * 32, CV_NIT = CV_GU + CV_DN;
__device__ __forceinline__ void moe_item(int it, const Frame& F, const float*& W, int& ldw, int& Kdst, bf16_t*& WT, size_t& ro, int& kb, int& nb) {
    if (it < CV_GU) { const int e = it / 2048, q = it % 2048; W = F.in[22] + (size_t)e * DM * 2 * DEXP; ldw = 2 * DEXP; Kdst = DM; WT = (bf16_t*)(F.ws + WS_WTGU); ro = (size_t)e * 2 * DEXP; kb = q / 64; nb = q % 64; }
    else { const int r = it - CV_GU, e = r / 1024, q = r % 1024; W = F.in[24] + (size_t)e * DEXP * DM; ldw = DM; Kdst = DEXP; WT = (bf16_t*)(F.ws + WS_WTDN); ro = (size_t)e * DM; kb = q / 32; nb = q % 32; }
}
__device__ __forceinline__ void small_convert(Frame& F, int rank, int nconv) {
    LAS float* scr = (LAS float*)(F.lds + F.wave * 16640);
    const int gw = rank * 8 + F.wave, NGW = nconv * 8;
    for (int it = gw; it < 4 * 1024 + 128; it += NGW) {
        if (it < 1024) p0_transpose_item(F.in[13], DM, 2 * DM, (bf16_t*)(F.ws + WS_WTBR), 0, scr, it / 32, it % 32, F.lane);
        else if (it < 2048) p0_transpose_item(F.in[14], DM, 2 * DM, (bf16_t*)(F.ws + WS_WTBR) + DM, 0, scr, (it - 1024) / 32, it % 32, F.lane);
        else if (it < 3072) p0_transpose_item(F.in[17], DM, DM, (bf16_t*)(F.ws + WS_WTOUT), 0, scr, (it - 2048) / 32, it % 32, F.lane);
        else if (it < 4096) p0_transpose_item(F.in[27], DM, DM, (bf16_t*)(F.ws + WS_WTPLEG), 0, scr, (it - 3072) / 32, it % 32, F.lane);
        else p0_transpose_item(F.in[28], DM, PLE, (bf16_t*)(F.ws + WS_WTPLEUP), 0, scr, (it - 4096) / 32, it % 32, F.lane);
    }
}
__device__ __forceinline__ void moe_convert(Frame& F, int rank, int nconv, int it_lo, int it_hi, bool nostore = false) {
    LAS float* scr = (LAS float*)(F.lds + F.wave * 16640);
    const int gw = rank * 8 + F.wave, NGW = nconv * 8;
    const int NIT = it_hi;
    f32x4 va[16], vb[16];
    const float* W; int ldw, Kdst, kb, nb; bf16_t* WT; size_t ro;
    int it = it_lo + gw;
    if (it < NIT) { moe_item(it, F, W, ldw, Kdst, WT, ro, kb, nb); p0_tr_load(va, W, ldw, kb, nb, F.lane); }
    for (; it < NIT; it += 2 * NGW) {
        const float* W2; int ldw2, Kdst2, kb2, nb2; bf16_t* WT2; size_t ro2;
        const int it2 = it + NGW;
        if (it2 < NIT) { moe_item(it2, F, W2, ldw2, Kdst2, WT2, ro2, kb2, nb2); p0_tr_load(vb, W2, ldw2, kb2, nb2, F.lane); }
        p0_tr_finish8(va, Kdst, (unsigned char*)WT, ro, scr, kb, nb, F.lane, nostore);
        const int it3 = it2 + NGW;
        if (it3 < NIT) { moe_item(it3, F, W, ldw, Kdst, WT, ro, kb, nb); p0_tr_load(va, W, ldw, kb, nb, F.lane); }
        if (it2 < NIT) p0_tr_finish8(vb, Kdst2, (unsigned char*)WT2, ro2, scr, kb2, nb2, F.lane, nostore);
    }
    LDS_WAIT(); __syncthreads();
}

using pg8::Unit;
__device__ __forceinline__ u32x4 pack8(const f32x4 a, const f32x4 b) { u32x4 w; w.x = cvt_pk_bf16(a[0], a[1]); w.y = cvt_pk_bf16(a[2], a[3]); w.z = cvt_pk_bf16(b[0], b[1]); w.w = cvt_pk_bf16(b[2], b[3]); return w; }
__device__ __forceinline__ void unpack8(const u32x4 w, f32x4& a, f32x4& b) { a[0] = bflo(w.x); a[1] = bfhi(w.x); a[2] = bflo(w.y); a[3] = bfhi(w.y); b[0] = bflo(w.z); b[1] = bfhi(w.z); b[2] = bflo(w.w); b[3] = bfhi(w.w); }
__device__ __forceinline__ f32x4 exp4(const f32x4 v) { f32x4 r; r[0] = __expf(v[0]); r[1] = __expf(v[1]); r[2] = __expf(v[2]); r[3] = __expf(v[3]); return r; }
__device__ __forceinline__ f32x4 sig4(const f32x4 v) { f32x4 r; r[0] = fast_sigmoid(v[0]); r[1] = fast_sigmoid(v[1]); r[2] = fast_sigmoid(v[2]); r[3] = fast_sigmoid(v[3]); return r; }

constexpr float QSCALE = 0.08838834764831845f * LOG2E;

struct EpiInProj {
    static constexpr bool PERM = true, AFTER_DRAIN = false, HAS_MID = false;
    bf16_t *q, *k, *v, *gqp, *gqm, *gkp, *gkm, *gv, *sg, *gates;
    const float *gqn, *gkn, *bcum, *bmerge;
    LAS float* ex;
    __device__ __forceinline__ void operator()(const f32x4 (&acc)[2][2][4][2], const Unit& u, int wr, int wc, int fr, int fq) const {
        const int pn = u.pn, cl = wc * 32 + 8 * fq;
        const size_t row0 = (size_t)u.pm * 256 + wr * 64 + fr;
        if (pn < 16) {
#pragma unroll
            for (int ai = 0; ai < 2; ++ai)
#pragma unroll
                for (int m = 0; m < 4; ++m)
#pragma unroll
                    for (int bj = 0; bj < 2; ++bj) {
                        const f32x4 a = acc[ai][bj][m][0], b = acc[ai][bj][m][1];
                        float s = (a[0] * a[0] + a[1] * a[1]) + (a[2] * a[2] + a[3] * a[3]) + (b[0] * b[0] + b[1] * b[1]) + (b[2] * b[2] + b[3] * b[3]);
                        s += __shfl_xor(s, 16); s += __shfl_xor(s, 32);
                        if (fq == 0) ex[((ai * 128 + wr * 64 + m * 16 + fr) * 2 + bj) * 4 + wc] = s;
                    }
            LDS_WAIT(); __builtin_amdgcn_s_barrier(); asm volatile("" ::: "memory");
            const float* gn = (pn < 8) ? gqn : gkn; const float sc = (pn < 8) ? QSCALE : 1.0f;
            const f32x4 g0 = *(const f32x4*)(gn + cl), g1 = *(const f32x4*)(gn + cl + 4);
            bf16_t* base = ((pn < 8) ? q : k) + (pn & 7) * 256 + cl;
#pragma unroll
            for (int ai = 0; ai < 2; ++ai)
#pragma unroll
                for (int m = 0; m < 4; ++m) {
                    const int rl = ai * 128 + wr * 64 + m * 16 + fr;
#pragma unroll
                    for (int bj = 0; bj < 2; ++bj) {
                        const f32x4 p4 = *(const LAS f32x4*)(ex + (rl * 2 + bj) * 4);
                        const float rs = rsqrtf(((p4[0] + p4[1]) + (p4[2] + p4[3])) * (1.0f / 128.0f) + RMS_EPS) * sc;
                        *(u32x4*)(base + (row0 + ai * 128 + m * 16) * DM + bj * 128) = pack8(acc[ai][bj][m][0] * rs * g0, acc[ai][bj][m][1] * rs * g1);
                    }
                }
            return;
        }
        if (pn < 24 || (pn >= 32 && pn < 48)) {
            bf16_t* base = (pn < 24) ? v + (pn - 16) * 256 : (pn < 40 ? gv + (pn - 32) * 256 : sg + (pn - 40) * 256);
            const bool silu = pn >= 40;
            base += cl;
#pragma unroll
            for (int ai = 0; ai < 2; ++ai)
#pragma unroll
                for (int m = 0; m < 4; ++m)
#pragma unroll
                    for (int bj = 0; bj < 2; ++bj) {
                        f32x4 a = acc[ai][bj][m][0], b = acc[ai][bj][m][1];
                        if (silu) { a = a * sig4(a); b = b * sig4(b); }
                        *(u32x4*)(base + (row0 + ai * 128 + m * 16) * DM + bj * 128) = pack8(a, b);
                    }
            return;
        }
        if (pn < 32) {
            const bool isq = pn < 28; const int cg = ((pn - 24) & 3) * 256 + cl;
            bf16_t* bp = (isq ? gqp : gkp) + cg; bf16_t* bm = (isq ? gqm : gkm) + cg; const float sc = isq ? 0.0625f : 1.0f;
#pragma unroll
            for (int ai = 0; ai < 2; ++ai)
#pragma unroll
                for (int m = 0; m < 4; ++m)
#pragma unroll
                    for (int bj = 0; bj < 2; ++bj) {
                        const size_t r = row0 + ai * 128 + m * 16;
                        const f32x4 b0 = *(const f32x4*)(bcum + r * GL_KW + cg + bj * 128), b1 = *(const f32x4*)(bcum + r * GL_KW + cg + bj * 128 + 4);
                        const f32x4 a = acc[ai][bj][m][0] * sc, b = acc[ai][bj][m][1] * sc;
                        *(u32x4*)(bp + r * GL_KW + bj * 128) = pack8(a * exp4(b0), b * exp4(b1));
                        *(u32x4*)(bm + r * GL_KW + bj * 128) = pack8(a * exp4(-b0), b * exp4(-b1));
                    }
            return;
        }
    }
};
struct EpiGates {
    static constexpr bool PERM = true, AFTER_DRAIN = false, HAS_MID = false;
    bf16_t* gates; const float* bmerge;
    __device__ __forceinline__ void operator()(const f32x4 (&acc)[2][2][4][2], const Unit& u, int wr_, int wc_, int fr_, int fq_) const {
        int fr = fr_, fq = fq_, wr = wr_, wc = wc_; asm volatile("" : "+v"(fr), "+v"(fq), "+v"(wr), "+v"(wc));
        const int cg = u.pn * 256 + wc * 32 + 8 * fq;
        const size_t row0 = (size_t)u.pm * 256 + wr * 64 + fr;
#pragma unroll
        for (int bj = 0; bj < 2; ++bj) {
            const f32x4 bb0 = *(const f32x4*)(bmerge + cg + bj * 128), bb1 = *(const f32x4*)(bmerge + cg + bj * 128 + 4);
#pragma unroll
            for (int ai = 0; ai < 2; ++ai)
#pragma unroll
                for (int m = 0; m < 4; ++m)
                    *(u32x4*)(gates + (row0 + ai * 128 + m * 16) * (2 * DM) + cg + bj * 128) = pack8(sig4(acc[ai][bj][m][0] * W8_INV + bb0), sig4(acc[ai][bj][m][1] * W8_INV + bb1));
        }
    }
};

struct EpiMixed2 {
    static constexpr bool PERM = true, AFTER_DRAIN = false, HAS_MID = true;
    const bf16_t* gates; bf16_t* mixed;
    __device__ __forceinline__ void mid(f32x4 (&acc)[2][2][4][2], const Unit& u, int wr, int wc, int fr_, int fq_) const {
        int fr = fr_, fq = fq_; asm volatile("" : "+v"(fr), "+v"(fq));
        const size_t row0 = (size_t)u.pm * 256 + wr * 64 + fr; const int c0 = u.pn * 256 + wc * 32 + 8 * fq;
#pragma unroll
        for (int ai = 0; ai < 2; ++ai)
#pragma unroll
            for (int m = 0; m < 4; ++m)
#pragma unroll
                for (int bj = 0; bj < 2; ++bj) {
                    const size_t r = row0 + ai * 128 + m * 16; const int c = c0 + bj * 128;
                    f32x4 da, db, ga, gb; unpack8(*(const u32x4*)(gates + r * (2 * DM) + c), da, db); unpack8(*(const u32x4*)(gates + r * (2 * DM) + DM + c), ga, gb);
#pragma unroll
                    for (int j = 0; j < 4; ++j) { acc[ai][bj][m][0][j] *= da[j] * __builtin_amdgcn_rcpf(fmaxf(ga[j], 1e-30f)); acc[ai][bj][m][1][j] *= db[j] * __builtin_amdgcn_rcpf(fmaxf(gb[j], 1e-30f)); }
                    asm volatile("" ::: "memory");
                }
    }
    __device__ __forceinline__ void operator()(const f32x4 (&acc)[2][2][4][2], const Unit& u, int wr, int wc, int fr, int fq) const {
        const size_t row0 = (size_t)u.pm * 256 + wr * 64 + fr; const int c0 = u.pn * 256 + wc * 32 + 8 * fq;
#pragma unroll
        for (int ai = 0; ai < 2; ++ai)
#pragma unroll
            for (int m = 0; m < 4; ++m)
#pragma unroll
                for (int bj = 0; bj < 2; ++bj) {
                    const size_t r = row0 + ai * 128 + m * 16; const int c = c0 + bj * 128;
                    f32x4 ga, gb; unpack8(*(const u32x4*)(gates + r * (2 * DM) + DM + c), ga, gb);
#pragma unroll
                    for (int j = 0; j < 4; ++j) { ga[j] = fmaxf(ga[j], 1e-30f); gb[j] = fmaxf(gb[j], 1e-30f); }
                    *(u32x4*)(mixed + r * DM + c) = pack8(acc[ai][bj][m][0] * ga, acc[ai][bj][m][1] * gb);
                }
    }
};
struct EpiX1 {
    static constexpr bool PERM = false, AFTER_DRAIN = false, HAS_MID = false;
    const float* x; float* x1;
    __device__ __forceinline__ void operator()(const f32x4 (&acc)[2][2][4][2], const Unit& u, int wr, int wc, int fr, int fq) const {
        const size_t row0 = (size_t)u.pm * 256 + wr * 64 + fr; const int c0 = u.pn * 256 + wc * 32 + 4 * fq;
#pragma unroll
        for (int ai = 0; ai < 2; ++ai)
#pragma unroll
            for (int m = 0; m < 4; ++m)
#pragma unroll
                for (int bj = 0; bj < 2; ++bj)
#pragma unroll
                    for (int n = 0; n < 2; ++n) { const size_t o = (row0 + ai * 128 + m * 16) * DM + c0 + bj * 128 + n * 16;
                        *(f32x4*)(x1 + o) = *(const f32x4*)(x + o) + acc[ai][bj][m][n]; if (n) asm volatile("" ::: "memory"); }
    }
};
struct EpiOut {
    static constexpr bool PERM = false, AFTER_DRAIN = false, HAS_MID = false;
    const float* x2; const bf16_t* pnorm; float* out; float sc;
    __device__ __forceinline__ void operator()(const f32x4 (&acc)[2][2][4][2], const Unit& u, int wr, int wc, int fr_, int fq_) const {
        int fr = fr_, fq = fq_; asm volatile("" : "+v"(fr), "+v"(fq));
        const size_t row0 = (size_t)u.pm * 256 + wr * 64 + fr; const int c0 = u.pn * 256 + wc * 32 + 4 * fq;
#pragma unroll
        for (int ai = 0; ai < 2; ++ai)
#pragma unroll
            for (int m = 0; m < 4; ++m)
#pragma unroll
                for (int bj = 0; bj < 2; ++bj)
#pragma unroll
                    for (int n = 0; n < 2; ++n) { const size_t o = (row0 + ai * 128 + m * 16) * DM + c0 + bj * 128 + n * 16;
                        const u32x2 pw = *(const u32x2*)(pnorm + o); f32x4 pv; pv[0] = bflo(pw.x); pv[1] = bfhi(pw.x); pv[2] = bflo(pw.y); pv[3] = bfhi(pw.y);
                        *(f32x4*)(out + o) = *(const f32x4*)(x2 + o) + pv * sig4(acc[ai][bj][m][n] * sc); asm volatile("" ::: "memory"); }
    }
};
struct EpiGU {
    static constexpr bool PERM = true, AFTER_DRAIN = false, HAS_MID = false;
    const float* bgu; bf16_t* act;
    __device__ __forceinline__ void operator()(const f32x4 (&acc)[2][2][4][2], const Unit& u, int wr, int wc, int fr, int fq) const {
        const size_t row0 = (size_t)u.pm * 256 + wr * 64 + fr; const int e = u.pn >> 4, n16 = u.pn & 15, cl = wc * 32 + 8 * fq;
#pragma unroll
        for (int bj = 0; bj < 2; ++bj) {
            const float* bp = bgu + (size_t)e * (2 * DEXP) + n16 * 256 + bj * 128 + cl;
            const f32x4 b0 = *(const f32x4*)bp, b1 = *(const f32x4*)(bp + 4);
#pragma unroll
            for (int ai = 0; ai < 2; ++ai)
#pragma unroll
                for (int m = 0; m < 4; ++m) {
                    const f32x4 a = acc[ai][bj][m][0] + b0, b = acc[ai][bj][m][1] + b1;
                    float o[4];
#pragma unroll
                    for (int p = 0; p < 4; ++p) { const float gt = fminf(p < 2 ? a[2 * p] : b[2 * p - 4], 7.0f); const float up = fminf(fmaxf(p < 2 ? a[2 * p + 1] : b[2 * p - 3], -7.0f), 7.0f);
                        o[p] = (up + 1.0f) * gt * fast_sigmoid(1.702f * gt); }
                    u32x2 w; w.x = cvt_pk_bf16(o[0], o[1]); w.y = cvt_pk_bf16(o[2], o[3]);
                    *(u32x2*)(act + (row0 + ai * 128 + m * 16) * DEXP + n16 * 128 + bj * 64 + (cl >> 1)) = w;
                }
        }
    }
};
struct EpiGU8 {
    static constexpr bool PERM = true, AFTER_DRAIN = false, HAS_MID = false;
    const float* bgu; unsigned char* act;
    __device__ __forceinline__ void operator()(const f32x4 (&acc)[2][2][4][2], const Unit& u, int wr, int wc, int fr, int fq) const {
        const size_t row0 = (size_t)u.pm * 256 + wr * 64 + fr; const int e = u.pn >> 4, n16 = u.pn & 15, cl = wc * 32 + 8 * fq;
#pragma unroll
        for (int bj = 0; bj < 2; ++bj) {
            const float* bp = bgu + (size_t)e * (2 * DEXP) + n16 * 256 + bj * 128 + cl;
            const f32x4 b0 = *(const f32x4*)bp, b1 = *(const f32x4*)(bp + 4);
#pragma unroll
            for (int ai = 0; ai < 2; ++ai)
#pragma unroll
                for (int m = 0; m < 4; ++m) {
                    const f32x4 a = acc[ai][bj][m][0] * W8_INV + b0, b = acc[ai][bj][m][1] * W8_INV + b1;
                    float o[4];
#pragma unroll
                    for (int p = 0; p < 4; ++p) { const float gt = fminf(p < 2 ? a[2 * p] : b[2 * p - 4], 7.0f); const float up = fminf(fmaxf(p < 2 ? a[2 * p + 1] : b[2 * p - 3], -7.0f), 7.0f);
                        o[p] = (up + 1.0f) * gt * fast_sigmoid(1.702f * gt); }
                    *(unsigned*)(act + (row0 + ai * 128 + m * 16) * DEXP + n16 * 128 + bj * 64 + (cl >> 1)) = pack_fp8x4(o[0], o[1], o[2], o[3]);
                }
        }
    }
};
struct EpiDN8 {
    static constexpr bool PERM = true, AFTER_DRAIN = false, HAS_MID = false;
    const float* bdn; bf16_t* yb;
    __device__ __forceinline__ void operator()(const f32x4 (&acc)[2][2][4][2], const Unit& u, int wr, int wc, int fr, int fq) const {
        const size_t row0 = (size_t)u.pm * 256 + wr * 64 + fr; const int e = u.pn >> 3, n8 = u.pn & 7, cl = wc * 32 + 8 * fq;
#pragma unroll
        for (int bj = 0; bj < 2; ++bj) {
            const int c = n8 * 256 + bj * 128 + cl;
            const f32x4 b0 = *(const f32x4*)(bdn + (size_t)e * DM + c), b1 = *(const f32x4*)(bdn + (size_t)e * DM + c + 4);
#pragma unroll
            for (int ai = 0; ai < 2; ++ai)
#pragma unroll
                for (int m = 0; m < 4; ++m)
                    *(u32x4*)(yb + (row0 + ai * 128 + m * 16) * DM + c) = pack8(acc[ai][bj][m][0] * W8_INV + b0, acc[ai][bj][m][1] * W8_INV + b1);
        }
    }
};
struct EpiDN {
    static constexpr bool PERM = true, AFTER_DRAIN = false, HAS_MID = false;
    const float* bdn; bf16_t* yb;
    __device__ __forceinline__ void operator()(const f32x4 (&acc)[2][2][4][2], const Unit& u, int wr, int wc, int fr, int fq) const {
        const size_t row0 = (size_t)u.pm * 256 + wr * 64 + fr; const int e = u.pn >> 3, n8 = u.pn & 7, cl = wc * 32 + 8 * fq;
#pragma unroll
        for (int bj = 0; bj < 2; ++bj) {
            const int c = n8 * 256 + bj * 128 + cl;
            const f32x4 b0 = *(const f32x4*)(bdn + (size_t)e * DM + c), b1 = *(const f32x4*)(bdn + (size_t)e * DM + c + 4);
#pragma unroll
            for (int ai = 0; ai < 2; ++ai)
#pragma unroll
                for (int m = 0; m < 4; ++m)
                    *(u32x4*)(yb + (row0 + ai * 128 + m * 16) * DM + c) = pack8(acc[ai][bj][m][0] + b0, acc[ai][bj][m][1] + b1);
        }
    }
};

struct GroupedOrder {
    const LAS int* mtoff;
    int nN, lo, hi, r, step;
    __device__ __forceinline__ void init(const LAS int* mt, int nN_, int G, int c) {
        mtoff = mt; nN = nN_; const int U = mt[32] * nN_;
        if ((G & 7) == 0) { const int per = (U + 7) >> 3, xcd = c & 7; lo = xcd * per; hi = (lo + per < U) ? lo + per : U; r = c >> 3; step = G >> 3; }
        else { lo = 0; hi = U; r = c; step = G; }
    }
    __device__ __forceinline__ bool next(int i, Unit& u) const {
        const int L = lo + i * step + r; if (L >= hi) return false;
        const int ln = (int)__builtin_amdgcn_mbcnt_hi(~0u, __builtin_amdgcn_mbcnt_lo(~0u, 0u)) & 31;
        const unsigned long long bal = __ballot(mtoff[ln] * nN <= L);
        const int e = __builtin_popcount((unsigned)bal) - 1;
        const int mt = mtoff[e + 1] - mtoff[e], rem = L - mtoff[e] * nN, n = rem / mt, m = rem - n * mt;
        u.pm = __builtin_amdgcn_readfirstlane(mtoff[e] + m); u.pn = __builtin_amdgcn_readfirstlane(e * nN + n); u.flags = __builtin_amdgcn_readfirstlane((mtoff[34 + e] - 256 * m <= 128) ? 1 : 0); return true;
    }
    __device__ __forceinline__ void a_ready(const Unit&) const {}
    __device__ __forceinline__ void done(const Unit&) const {}
};

__device__ __forceinline__ bf16x8 pk8(const float a0, const float a1, const float a2, const float a3, const float a4, const float a5, const float a6, const float a7) {
    u32x4 w; w.x = cvt_pk_bf16(a0, a1); w.y = cvt_pk_bf16(a2, a3); w.z = cvt_pk_bf16(a4, a5); w.w = cvt_pk_bf16(a6, a7); return __builtin_bit_cast(bf16x8, w); }
constexpr int ATT_STAGE = 65536, ATT_K1 = 16384, ATT_V = 32768;
constexpr float ATT_THR = 8.0f;

struct AttnOffs { unsigned k, v; };
__device__ __forceinline__ AttnOffs attn_offs(int lane, int w) {
    AttnOffs o;
    { const int key = 4 * w + (lane >> 4), ch = (lane & 15) ^ (key & 7); o.k = (unsigned)(key * DM + ch * 8) * 2u; }
    { const int key = 2 * w + (lane >> 5), ch = (lane & 31) ^ ((key & 3) << 2); o.v = (unsigned)(key * DM + ch * 8) * 2u; }
    return o;
}
__device__ __forceinline__ void attn_issue_tile(const Frame& F, const AttnOffs& ao, const char* kg, const char* vg, int stage) {
    const int w = F.wave;
#pragma unroll
    for (int c = 0; c < 2; ++c)
#pragma unroll
        for (int i = 0; i < 2; ++i)
            __builtin_amdgcn_global_load_lds((const unsigned*)(kg + c * 256 + i * (32 * DM * 2) + ao.k), (LAS unsigned*)(F.lds + stage * ATT_STAGE + c * ATT_K1 + (w + 8 * i) * 1024), 16, 0, 0);
#pragma unroll
    for (int i = 0; i < 4; ++i)
        __builtin_amdgcn_global_load_lds((const unsigned*)(vg + i * (16 * DM * 2) + ao.v), (LAS unsigned*)(F.lds + stage * ATT_STAGE + ATT_V + (w + 8 * i) * 1024), 16, 0, 0);
}

__device__ __forceinline__ void attn_unit(const Frame& F, int b, int h, int qb, float lam) {
    const bf16_t* Qg = (const bf16_t*)(F.ws + WS_Q); const bf16_t* Kg = (const bf16_t*)(F.ws + WS_K); const bf16_t* Vg = (const bf16_t*)(F.ws + WS_V);
    bf16_t* Y = (bf16_t*)(F.ws + WS_YCAT);
    int lane; asm volatile("v_mbcnt_lo_u32_b32 %0, -1, 0\n\tv_mbcnt_hi_u32_b32 %0, -1, %0" : "=v"(lane));
    const int w = F.wave, c = w >> 2, r0 = (w & 3) * 32, hi = lane >> 5, ql = lane & 31;
    const int NT = 2 * qb + 2, jlast = 2 * qb + (r0 >> 6);
    const size_t tok0 = (size_t)b * SEQ;
    const char* kbase = (const char*)(Kg + tok0 * DM + h * 256); const char* vbase = (const char*)(Vg + tok0 * DM + h * 256);
    const AttnOffs ao = attn_offs(lane, w);
    bf16x8 qf[8];
    { const char* qbase = (const char*)(Qg + (tok0 + qb * 128 + r0) * DM + h * 256 + c * 128); const unsigned qo = (unsigned)(ql * DM + 8 * hi) * 2u;
#pragma unroll
      for (int st = 0; st < 8; ++st) qf[st] = *(const bf16x8*)(qbase + qo + 32 * st); }
    attn_issue_tile(F, ao, kbase, vbase, 0);
    f32x16 o[8];
#pragma unroll
    for (int d = 0; d < 8; ++d)
#pragma unroll
        for (int r = 0; r < 16; ++r) o[d][r] = 0.f;
    float m_run = -1e30f, l_run = 0.f;
    const float slope = exp2f(-(float)(h + 1)) * LOG2E;
    const float tpos = (float)(qb * 128 + r0 + ql);
    const int kx = (ql & 7) << 4;
    const int koff = ql * 256;
    const int g1 = (lane >> 4) & 1, qq = (lane & 15) >> 2, pp = lane & 3;
    const int voff = (4 * hi + qq) * 512 + 32 * g1 + 16 * (pp >> 1) + 8 * (pp & 1);
    VM_WAIT(); __builtin_amdgcn_s_barrier(); asm volatile("" ::: "memory");
#define ATT_TR(dst, addr, off) asm volatile("ds_read_b64_tr_b16 %0, %1 offset:%2" : "=v"(dst) : "v"(addr), "n"(off))
#define ATT_VLOAD4(buf, A, dd, kh_) do { ATT_TR(buf[0], A, ((dd) >> 2) * 256 + (2 * (kh_)) * 8192); ATT_TR(buf[1], A, ((dd) >> 2) * 256 + (2 * (kh_)) * 8192 + 4096); \
        ATT_TR(buf[2], A, ((dd) >> 2) * 256 + (2 * (kh_) + 1) * 8192); ATT_TR(buf[3], A, ((dd) >> 2) * 256 + (2 * (kh_) + 1) * 8192 + 4096); } while (0)
#define ATT_VLOAD(buf, dd, kh_) do { if (((dd) & 3) == 0) ATT_VLOAD4(buf, va0, dd, kh_); else if (((dd) & 3) == 1) ATT_VLOAD4(buf, va1, dd, kh_); else if (((dd) & 3) == 2) ATT_VLOAD4(buf, va2, dd, kh_); else ATT_VLOAD4(buf, va3, dd, kh_); } while (0)
#define ATT_TILE(j, st_) do { \
        const int jj_ = (j); \
        if (jj_ + 1 < NT) attn_issue_tile(F, ao, kbase + (size_t)(jj_ + 1) * 64 * DM * 2, vbase + (size_t)(jj_ + 1) * 64 * DM * 2, st_ ^ 1); \
        if (jj_ <= jlast) { \
            const LAS unsigned char* Ks = F.lds + st_ * ATT_STAGE + c * ATT_K1; \
            const unsigned vbase = (unsigned)(size_t)(F.lds + st_ * ATT_STAGE + ATT_V) + (unsigned)voff; \
            const unsigned va0 = vbase + ((0 ^ qq) << 6), va1 = vbase + ((1 ^ qq) << 6), va2 = vbase + ((2 ^ qq) << 6), va3 = vbase + ((3 ^ qq) << 6); \
_Pragma("unroll") \
            for (int kh = 0; kh < 2; ++kh) {                            \
                f32x16 p0; \
_Pragma("unroll") \
                for (int r = 0; r < 16; ++r) p0[r] = 0.f; \
bf16x8 kf[4], kg_[4]; \
_Pragma("unroll") \
                for (int st = 0; st < 4; ++st) { const int co = ((2 * st + hi) << 4) ^ kx; kf[st] = *(const LAS bf16x8*)(Ks + kh * 8192 + koff + co); } \
                __builtin_amdgcn_sched_barrier(0); \
_Pragma("unroll") \
                for (int st = 0; st < 4; ++st) { const int co = ((2 * (st + 4) + hi) << 4) ^ kx; kg_[st] = *(const LAS bf16x8*)(Ks + kh * 8192 + koff + co); } \
_Pragma("unroll") \
                for (int st = 0; st < 4; ++st) p0 = __builtin_amdgcn_mfma_f32_32x32x16_bf16(kf[st], qf[st], p0, 0, 0, 0); \
                __builtin_amdgcn_sched_barrier(0); \
_Pragma("unroll") \
                for (int st = 0; st < 4; ++st) p0 = __builtin_amdgcn_mfma_f32_32x32x16_bf16(kg_[st], qf[st + 4], p0, 0, 0, 0); \
                __builtin_amdgcn_sched_barrier(0); \
                 \
                const float dq = tpos - (float)(64 * jj_ + 32 * kh + 4 * hi); \
                float mx = -1e30f; \
_Pragma("unroll") \
                for (int r = 0; r < 16; ++r) { const float cr = (float)((r & 3) + 8 * (r >> 2)); \
                    p0[r] = fmaf(-slope, fabsf(dq - cr), p0[r]); mx = fmaxf(mx, p0[r]); } \
                { auto rr_ = __builtin_amdgcn_permlane32_swap(__float_as_uint(mx), __float_as_uint(mx), false, false); mx = fmaxf(__uint_as_float(rr_[0]), __uint_as_float(rr_[1])); } \
                if (!__all(mx - m_run <= ATT_THR)) { \
                    const float mn = fmaxf(m_run, mx), al = __builtin_amdgcn_exp2f(m_run - mn); m_run = mn; l_run *= al; \
_Pragma("unroll") \
                    for (int d = 0; d < 8; ++d) \
_Pragma("unroll") \
                        for (int r = 0; r < 16; ++r) o[d][r] *= al; \
                } \
                float ps = 0.f; \
_Pragma("unroll") \
                for (int r = 0; r < 16; ++r) { p0[r] = __builtin_amdgcn_exp2f(p0[r] - m_run); ps += p0[r]; } \
                l_run += ps; \
                bf16x8 pf[2]; \
                pf[0] = pk8(p0[0], p0[1], p0[2], p0[3], p0[4], p0[5], p0[6], p0[7]); pf[1] = pk8(p0[8], p0[9], p0[10], p0[11], p0[12], p0[13], p0[14], p0[15]); \
                __builtin_amdgcn_sched_barrier(0); \
{ u32x2 vb[4][4]; \
                  ATT_VLOAD(vb[0], 0, kh); ATT_VLOAD(vb[1], 1, kh); ATT_VLOAD(vb[2], 2, kh); \
_Pragma("unroll") \
                  for (int d = 0; d < 8; ++d) { \
                    if (d < 5) { ATT_VLOAD(vb[(d + 3) & 3], d + 3, kh); asm volatile("s_waitcnt lgkmcnt(12)" ::: "memory"); } \
                    else if (d == 5) asm volatile("s_waitcnt lgkmcnt(8)" ::: "memory"); \
                    else if (d == 6) asm volatile("s_waitcnt lgkmcnt(4)" ::: "memory"); \
                    else asm volatile("s_waitcnt lgkmcnt(0)" ::: "memory"); \
                    __builtin_amdgcn_sched_barrier(0); \
                    { u32x4 w0, w1; w0.x = vb[d & 3][0].x; w0.y = vb[d & 3][0].y; w0.z = vb[d & 3][1].x; w0.w = vb[d & 3][1].y; w1.x = vb[d & 3][2].x; w1.y = vb[d & 3][2].y; w1.z = vb[d & 3][3].x; w1.w = vb[d & 3][3].y; \
                      o[d] = __builtin_amdgcn_mfma_f32_32x32x16_bf16(__builtin_bit_cast(bf16x8, w0), pf[0], o[d], 0, 0, 0); \
                      o[d] = __builtin_amdgcn_mfma_f32_32x32x16_bf16(__builtin_bit_cast(bf16x8, w1), pf[1], o[d], 0, 0, 0); } \
                    __builtin_amdgcn_sched_barrier(0); \
                  } } \
            } \
        } \
        VM_WAIT(); LDS_WAIT(); __builtin_amdgcn_s_barrier(); asm volatile("" ::: "memory"); \
    } while (0)
    for (int j = 0; j < NT; j += 2) { ATT_TILE(j, 0); ATT_TILE(j + 1, 1); }
#undef ATT_TILE
#undef ATT_VLOAD
#undef ATT_VLOAD4
#undef ATT_TR
    const float linv = 1.0f / (l_run + __shfl_xor(l_run, 32));
    LAS float* X = (LAS float*)F.lds + (size_t)(w & 3) * 128 * 64 + lane;
    if (c == 1) {
#pragma unroll
        for (int d = 0; d < 8; ++d)
#pragma unroll
            for (int r = 0; r < 16; ++r) X[(d * 16 + r) * 64] = o[d][r] * linv;
    }
    LDS_WAIT(); __builtin_amdgcn_s_barrier(); asm volatile("" ::: "memory");
    if (c == 0) {
        float ss = 0.f;
#pragma unroll
        for (int d = 0; d < 8; ++d) {
#pragma unroll
            for (int r = 0; r < 16; ++r) { const float v = o[d][r] * linv - lam * X[(d * 16 + r) * 64]; o[d][r] = v; ss += v * v; }
            asm volatile("" ::: "memory"); }
        ss += __shfl_xor(ss, 32);
        const float rs = rsqrtf(ss * (1.0f / 256.0f) + RMS_EPS) * 0.8f;
        const float* sg = F.in[9];
        bf16_t* yp = (bf16_t*)((char*)(Y + (tok0 + qb * 128 + r0) * (2 * DM) + h * 256) + (unsigned)(ql * (2 * DM) + 4 * hi) * 2u);
#pragma unroll
        for (int d = 0; d < 8; ++d) {
            asm volatile("" ::: "memory");
#pragma unroll
            for (int r4 = 0; r4 < 4; ++r4) { const int dv = 32 * d + 8 * r4; const f32x4 g = *(const f32x4*)(sg + dv + 4 * hi);
                u32x2 wv; wv.x = cvt_pk_bf16(o[d][4 * r4] * rs * g[0], o[d][4 * r4 + 1] * rs * g[1]); wv.y = cvt_pk_bf16(o[d][4 * r4 + 2] * rs * g[2], o[d][4 * r4 + 3] * rs * g[3]);
                *(u32x2*)(yp + dv) = wv; }
        }
    }
    LDS_WAIT(); __builtin_amdgcn_s_barrier(); asm volatile("" ::: "memory");
}

__device__ __forceinline__ void gla_scores_phase(const Frame& F) {
    const bf16_t* qp = (const bf16_t*)(F.ws + WS_GQP); const bf16_t* qm = (const bf16_t*)(F.ws + WS_GQM);
    const bf16_t* kp = (const bf16_t*)(F.ws + WS_GKP); const bf16_t* km = (const bf16_t*)(F.ws + WS_GKM);
    bf16_t* attc = (bf16_t*)(F.ws + WS_ATTC);
    LAS float* tmp = (LAS float*)F.lds;
    const int lane = F.lane, w = F.wave, which = w >> 2, mi = (w >> 1) & 1, si = w & 1, hi = lane >> 5, l31 = lane & 31;
    for (int unit = blockIdx.x; unit < NB * GL_H * NCH; unit += F.G) {
        const int b = unit >> 8, h = (unit >> 6) & 3, ch = unit & 63;
        const size_t t0 = (size_t)b * SEQ + ch * 64;
        const bf16_t* A = (which ? qm : qp) + (t0 + 32 * mi + l31) * GL_KW + h * 256 + 8 * hi;
        const bf16_t* Bm = (which ? kp : km) + (t0 + 32 * si + l31) * GL_KW + h * 256 + 8 * hi;
        f32x16 acc;
#pragma unroll
        for (int r = 0; r < 16; ++r) acc[r] = 0.f;
#pragma unroll
        for (int st = 0; st < 16; ++st) acc = __builtin_amdgcn_mfma_f32_32x32x16_bf16(*(const bf16x8*)(A + 16 * st), *(const bf16x8*)(Bm + 16 * st), acc, 0, 0, 0);
        const int s = 32 * si + l31;
#pragma unroll
        for (int r = 0; r < 16; ++r) { const int t = 32 * mi + (r & 3) + 8 * (r >> 2) + 4 * hi; const bool keep = which ? (s > t) : (s <= t); acc[r] = keep ? acc[r] : 0.f; }
        if (which) {
#pragma unroll
            for (int r = 0; r < 16; ++r) { const int t = 32 * mi + (r & 3) + 8 * (r >> 2) + 4 * hi; tmp[t * 64 + s] = acc[r]; }
        }
        LDS_WAIT(); __syncthreads();
        if (!which) {
#pragma unroll
            for (int r = 0; r < 16; ++r) { const int t = 32 * mi + (r & 3) + 8 * (r >> 2) + 4 * hi; const float v = acc[r] + tmp[t * 64 + s];
                attc[((size_t)unit * 64 + t) * 64 + s] = (bf16_t)(cvt_pk_bf16(v, 0.f) & 0xffffu); }
        }
        LDS_WAIT(); __syncthreads();
    }
}

constexpr int GL_KST = 544, GL_AST = 144, GL_VST = 272;
constexpr int GL_KM = 0, GL_QP = 64 * GL_KST, GL_AT = 2 * 64 * GL_KST, GL_VV = GL_AT + 64 * GL_AST, GL_DEC = GL_VV + 64 * GL_VST;
__device__ __forceinline__ void gla_scan_unit(const Frame& F, int g) {
    const int b = g >> 4, h = (g >> 2) & 3, vg = g & 3;
    const bf16_t* qp = (const bf16_t*)(F.ws + WS_GQP); const bf16_t* km = (const bf16_t*)(F.ws + WS_GKM);
    const bf16_t* gv = (const bf16_t*)(F.ws + WS_GV); const bf16_t* attc = (const bf16_t*)(F.ws + WS_ATTC);
    const float* bcum = (const float*)(F.ws + WS_BCUM); float* og = (float*)(F.ws + WS_OGLA);
    const int tid = F.tid, lane = F.lane, w = F.wave, gq = lane >> 4, li = lane & 15, q4 = li >> 2, p4 = li & 3;
    f32x4 S[16];
#pragma unroll
    for (int i = 0; i < 16; ++i) S[i] = (f32x4){0.f, 0.f, 0.f, 0.f};
    u32x4 rk[4], rq[4], ra, rv[2]; float rdec = 0.f;
    const size_t tb0 = (size_t)b * SEQ;
#define GLA_LOAD(c) do { const size_t t0_ = tb0 + (size_t)(c) * 64; \
        _Pragma("unroll") for (int i = 0; i < 4; ++i) { const int idx = tid + 512 * i, row = idx >> 5, cc = idx & 31; \
            rk[i] = *(const u32x4*)(km + (t0_ + row) * GL_KW + h * 256 + cc * 8); rq[i] = *(const u32x4*)(qp + (t0_ + row) * GL_KW + h * 256 + cc * 8); } \
        ra = *(const u32x4*)(attc + ((size_t)((b * GL_H + h) * NCH + (c)) * 64 + (tid >> 3)) * 64 + (tid & 7) * 8); \
        _Pragma("unroll") for (int i = 0; i < 2; ++i) { const int idx = tid + 512 * i, row = idx >> 4, cc = idx & 15; \
            rv[i] = *(const u32x4*)(gv + (t0_ + row) * GL_VW + h * 512 + vg * 128 + cc * 8); } \
        if (tid < 256) rdec = bcum[(t0_ + 63) * GL_KW + h * 256 + tid]; } while (0)
    GLA_LOAD(0);
    for (int c = 0; c < NCH; ++c) {
        __syncthreads();
#pragma unroll
        for (int i = 0; i < 4; ++i) { const int idx = tid + 512 * i, row = idx >> 5, cc = idx & 31;
            *(LAS u32x4*)(F.lds + GL_KM + row * GL_KST + cc * 16) = rk[i]; *(LAS u32x4*)(F.lds + GL_QP + row * GL_KST + cc * 16) = rq[i]; }
        *(LAS u32x4*)(F.lds + GL_AT + (tid >> 3) * GL_AST + (tid & 7) * 16) = ra;
#pragma unroll
        for (int i = 0; i < 2; ++i) { const int idx = tid + 512 * i, row = idx >> 4, cc = idx & 15; *(LAS u32x4*)(F.lds + GL_VV + row * GL_VST + cc * 16) = rv[i]; }
        if (tid < 256) *(LAS float*)(F.lds + GL_DEC + tid * 4) = __expf(rdec);
        LDS_WAIT(); __syncthreads();
        if (c + 1 < NCH) GLA_LOAD(c + 1);
        const size_t t0 = tb0 + (size_t)c * 64;
        bf16x8 bv[2];
#pragma unroll
        for (int st = 0; st < 2; ++st) { const LAS unsigned char* p = F.lds + GL_VV + (32 * st + 8 * gq + q4) * GL_VST + (16 * w + 4 * p4) * 2;
            bv[st] = cat8(lds_tr16(p), lds_tr16(p + 4 * GL_VST)); }
        bf16x8 af[2][4];
#pragma unroll
        for (int st = 0; st < 2; ++st)
#pragma unroll
            for (int tb = 0; tb < 4; ++tb) af[st][tb] = *(const LAS bf16x8*)(F.lds + GL_AT + (16 * tb + li) * GL_AST + (32 * st + 8 * gq) * 2);
        f32x4 o[4];
#pragma unroll
        for (int tb = 0; tb < 4; ++tb) o[tb] = (f32x4){0.f, 0.f, 0.f, 0.f};
        u32x4 qa[2][4];
#define GLA_LOADQ(buf, ks_) do { _Pragma("unroll") for (int tb = 0; tb < 4; ++tb) { const LAS unsigned char* p = F.lds + GL_QP + (16 * tb + li) * GL_KST + (32 * (ks_) + 4 * gq) * 2; \
            const u32x2 a0 = *(const LAS u32x2*)p, a1 = *(const LAS u32x2*)(p + 32); buf[tb].x = a0.x; buf[tb].y = a0.y; buf[tb].z = a1.x; buf[tb].w = a1.y; } } while (0)
        GLA_LOADQ(qa[0], 0);
#pragma unroll
        for (int ks = 0; ks < 8; ++ks) {
            if (ks < 7) GLA_LOADQ(qa[(ks + 1) & 1], ks + 1);
            __builtin_amdgcn_sched_barrier(0);
            const bf16x8 sb = pk8(S[2 * ks][0], S[2 * ks][1], S[2 * ks][2], S[2 * ks][3], S[2 * ks + 1][0], S[2 * ks + 1][1], S[2 * ks + 1][2], S[2 * ks + 1][3]);
#pragma unroll
            for (int tb = 0; tb < 4; ++tb) o[tb] = __builtin_amdgcn_mfma_f32_16x16x32_bf16(__builtin_bit_cast(bf16x8, qa[ks & 1][tb]), sb, o[tb], 0, 0, 0);
            __builtin_amdgcn_sched_barrier(0);
        }
#undef GLA_LOADQ
#pragma unroll
        for (int st = 0; st < 2; ++st)
#pragma unroll
            for (int tb = 0; tb < 4; ++tb) o[tb] = __builtin_amdgcn_mfma_f32_16x16x32_bf16(af[st][tb], bv[st], o[tb], 0, 0, 0);
        bf16x8 ak[2][2];
#define GLA_LOADK(buf, kb_) do { _Pragma("unroll") for (int st = 0; st < 2; ++st) { const LAS unsigned char* p = F.lds + GL_KM + (32 * st + 8 * gq + q4) * GL_KST + (16 * (kb_) + 4 * p4) * 2; \
            buf[st] = cat8(lds_tr16(p), lds_tr16(p + 4 * GL_KST)); } } while (0)
        GLA_LOADK(ak[0], 0);
#pragma unroll
        for (int kb = 0; kb < 16; ++kb) {
            if (kb < 15) GLA_LOADK(ak[(kb + 1) & 1], kb + 1);
            const f32x4 d = *(const LAS f32x4*)(F.lds + GL_DEC + (16 * kb + 4 * gq) * 4);
            __builtin_amdgcn_sched_barrier(0);
            S[kb] = __builtin_amdgcn_mfma_f32_16x16x32_bf16(ak[kb & 1][0], bv[0], S[kb], 0, 0, 0);
            S[kb] = __builtin_amdgcn_mfma_f32_16x16x32_bf16(ak[kb & 1][1], bv[1], S[kb], 0, 0, 0);
            S[kb] = S[kb] * d;
            __builtin_amdgcn_sched_barrier(0);
        }
#undef GLA_LOADK
#pragma unroll
        for (int tb = 0; tb < 4; ++tb)
#pragma unroll
            for (int r = 0; r < 4; ++r) og[(t0 + 16 * tb + 4 * gq + r) * GL_VW + h * 512 + vg * 128 + 16 * w + li] = o[tb][r];
    }
#undef GLA_LOAD
    __syncthreads();
}

__device__ __forceinline__ void gla_out_phase(const Frame& F) {
    const float* og = (const float*)(F.ws + WS_OGLA); const bf16_t* sg = (const bf16_t*)(F.ws + WS_SG); bf16_t* yg = (bf16_t*)(F.ws + WS_YCAT) + DM;
    const float* gn = F.in[12];
    const int gw = blockIdx.x * 8 + F.wave, NGW = F.G * 8, lane = F.lane;
    const f32x4 g0 = *(const f32x4*)(gn + 8 * lane), g1 = *(const f32x4*)(gn + 8 * lane + 4);
    for (int rw = gw; rw < TOK * GL_H; rw += NGW) {
        const size_t off = (size_t)rw * 512 + 8 * lane;
        const f32x4 a = *(const f32x4*)(og + off), b = *(const f32x4*)(og + off + 4);
        float ss = (a[0] * a[0] + a[1] * a[1]) + (a[2] * a[2] + a[3] * a[3]) + (b[0] * b[0] + b[1] * b[1]) + (b[2] * b[2] + b[3] * b[3]);
        ss = wave_sum(ss);
        const float rs = rsqrtf(ss * (1.0f / 512.0f) + RMS_EPS);
        f32x4 sa, sb; unpack8(*(const u32x4*)(sg + off), sa, sb);
        *(u32x4*)(yg + (size_t)(rw >> 2) * (2 * DM) + (rw & 3) * 512 + 8 * lane) = pack8(a * rs * g0 * sa, b * rs * g1 * sb);
    }
}

__device__ __forceinline__ void route_phase(const Frame& F, int rep) {
    const float* x1 = (const float*)(F.ws + WS_X1); const float* gf = F.in[19]; const float* wr = F.in[20]; const float* rb = F.in[21];
    bf16_t* h2 = (bf16_t*)(F.ws + WS_H2);
    int* topi = (int*)(F.ws + WS_ROUTE + rep * 524288); float* gate = (float*)(F.ws + WS_ROUTE + 131072 + rep * 524288); int* posn = (int*)(F.ws + WS_ROUTE + 262144 + rep * 524288);
    unsigned* cnt = (unsigned*)(F.ws + WS_CTL) + CW_CNT + rep * 2048;
    const int lane = F.lane, gw = blockIdx.x * 8 + F.wave, NGW = F.G * 8, e = lane & 31, hf = lane >> 5;
    LAS float* wsh = (LAS float*)(F.lds);
    for (int base = blockIdx.x * 8; base < TOK / 4; base += NGW) {
        const int gp = base + F.wave;
        float lg[4];
        f32x4 xv[4][8];
#pragma unroll
        for (int i = 0; i < 4; ++i) { const float* xrow = x1 + (size_t)(4 * gp + i) * DM + 4 * lane;
#pragma unroll
            for (int j = 0; j < 8; ++j) xv[i][j] = *(const f32x4*)(xrow + 256 * j); }
#pragma unroll
        for (int i = 0; i < 4; ++i) { float ss = 0.f;
#pragma unroll
            for (int j = 0; j < 8; ++j) ss += (xv[i][j][0] * xv[i][j][0] + xv[i][j][1] * xv[i][j][1]) + (xv[i][j][2] * xv[i][j][2] + xv[i][j][3] * xv[i][j][3]);
            ss = wave_sum(ss);
            const float rs = rsqrtf(ss * (1.0f / DM) + RMS_EPS);
            unsigned char* hrow = (unsigned char*)h2 + (size_t)(4 * gp + i) * DM + 4 * lane; const float* gfl = gf + 4 * lane; asm volatile("" : "+v"(hrow), "+v"(gfl));
#pragma unroll
            for (int j = 0; j < 8; ++j) { const f32x4 g = *(const f32x4*)(gfl + 256 * j); const f32x4 hv = xv[i][j] * rs * g; xv[i][j] = hv;
                *(unsigned*)(hrow + 256 * j) = pack_fp8x4(hv[0], hv[1], hv[2], hv[3]); }
        }
        f32x4 acc[2][2];
#pragma unroll
        for (int tg = 0; tg < 2; ++tg)
#pragma unroll
            for (int eg = 0; eg < 2; ++eg) acc[tg][eg] = (f32x4){0.f, 0.f, 0.f, 0.f};
        LAS float* hsm = (LAS float*)(F.lds + 65536);
        f32x4 wreg[8];
        { const float* wb = wr + 4 * F.tid; asm volatile("" : "+v"(wb));
#pragma unroll
        for (int m = 0; m < 8; ++m) wreg[m] = *(const f32x4*)(wb + 2048 * m); }
#pragma unroll
        for (int wd = 0; wd < 4; ++wd) {
            __syncthreads();
#pragma unroll
            for (int m = 0; m < 8; ++m) *(LAS f32x4*)(wsh + 4 * (F.tid + 512 * m)) = wreg[m];
            if (wd < 3) { const float* wb = wr + (size_t)(512 * (wd + 1)) * NEXP + 4 * F.tid; asm volatile("" : "+v"(wb));
#pragma unroll
                for (int m = 0; m < 8; ++m) wreg[m] = *(const f32x4*)(wb + 2048 * m); }
#pragma unroll
            for (int i = 0; i < 4; ++i)
#pragma unroll
                for (int jj = 0; jj < 2; ++jj) *(LAS f32x4*)(hsm + (4 * F.wave + i) * 516 + 4 * (lane + 64 * jj)) = xv[i][2 * wd + jj];
            LDS_WAIT(); __syncthreads();
            const LAS float* ap = hsm + (lane & 15) * 516 + 64 * F.wave + (lane >> 4);
            const LAS float* bp = wsh + (64 * F.wave + (lane >> 4)) * NEXP + (lane & 15);
#pragma unroll 4
            for (int ks = 0; ks < 16; ++ks) {
                const float a0 = ap[4 * ks], a1 = ap[16 * 516 + 4 * ks], b0 = bp[4 * ks * NEXP], b1 = bp[4 * ks * NEXP + 16];
                acc[0][0] = __builtin_amdgcn_mfma_f32_16x16x4f32(a0, b0, acc[0][0], 0, 0, 0); acc[0][1] = __builtin_amdgcn_mfma_f32_16x16x4f32(a0, b1, acc[0][1], 0, 0, 0);
                acc[1][0] = __builtin_amdgcn_mfma_f32_16x16x4f32(a1, b0, acc[1][0], 0, 0, 0); acc[1][1] = __builtin_amdgcn_mfma_f32_16x16x4f32(a1, b1, acc[1][1], 0, 0, 0);
            }
        }
        __syncthreads();
#pragma unroll
        for (int tg = 0; tg < 2; ++tg)
#pragma unroll
            for (int eg = 0; eg < 2; ++eg)
#pragma unroll
                for (int r = 0; r < 4; ++r) wsh[F.wave * 1024 + (16 * tg + 4 * (lane >> 4) + r) * 32 + 16 * eg + (lane & 15)] = acc[tg][eg][r];
        LDS_WAIT(); __syncthreads();
#pragma unroll
        for (int i = 0; i < 4; ++i) { float sum = 0.f;
#pragma unroll
            for (int w8 = 0; w8 < 8; ++w8) sum += wsh[w8 * 1024 + (4 * F.wave + i) * 32 + e];
            lg[i] = sum; }
        LAS unsigned* lc = (LAS unsigned*)(F.lds + 133120);
        if (F.tid < 32) lc[F.tid] = 0u;
        LDS_WAIT(); __syncthreads();
        int lr[2][4];
#pragma unroll
        for (int rd = 0; rd < 2; ++rd) {
            const size_t t = (size_t)(4 * gp + 2 * hf + rd);
            float v = (hf ? lg[2 + rd] : lg[rd]) + rb[e];
            float selv[4]; int sele[4];
#pragma unroll
            for (int k = 0; k < TOPK; ++k) {
                float mx = v;
#pragma unroll
                for (int o = 1; o < 32; o <<= 1) mx = fmaxf(mx, __shfl_xor(mx, o));
                int idx = (v == mx) ? e : 64;
#pragma unroll
                for (int o = 1; o < 32; o <<= 1) idx = min(idx, __shfl_xor(idx, o));
                selv[k] = mx; sele[k] = idx;
                if (e == idx) v = -__builtin_inff();
            }
            const float e1 = __expf(selv[1] - selv[0]), e2 = __expf(selv[2] - selv[0]), e3 = __expf(selv[3] - selv[0]);
            const float inv = 1.0f / (1.0f + e1 + e2 + e3);
            const float gk[4] = {inv, e1 * inv, e2 * inv, e3 * inv};
#pragma unroll
            for (int k = 0; k < TOPK; ++k)
                if (e == sele[k]) { lr[rd][k] = (int)__hip_atomic_fetch_add(lc + e, 1u, __ATOMIC_RELAXED, __HIP_MEMORY_SCOPE_WORKGROUP); topi[t * 4 + k] = e; gate[t * 4 + k] = gk[k]; }
                else lr[rd][k] = -1;
        }
        LDS_WAIT(); __syncthreads();
        if (F.tid < 32) { const unsigned n = lc[F.tid]; lc[32 + F.tid] = n ? __hip_atomic_fetch_add(cnt + 64 * F.tid, n, RLX_AGENT) : 0u; }
        LDS_WAIT(); __syncthreads();
        const int rbase = (int)lc[32 + e];
#pragma unroll
        for (int rd = 0; rd < 2; ++rd)
#pragma unroll
            for (int k = 0; k < TOPK; ++k) if (lr[rd][k] >= 0) posn[(size_t)(4 * gp + 2 * hf + rd) * 4 + k] = rbase + lr[rd][k];
    }
}

__device__ __forceinline__ void build_mtoff(const Frame& F, LAS int* mt) {
    const unsigned* cnt = (const unsigned*)(F.ws + WS_CTL) + CW_CNT;
    if (F.wave == 0) {
        const int e = F.lane & 31;
        const unsigned c = __hip_atomic_load(cnt + 64 * e, RLX_AGENT);
        const int nt_ = (int)((c + 255u) >> 8); int incl = nt_;
#pragma unroll
        for (int o = 1; o < 32; o <<= 1) { const int v = __shfl_up(incl, o, 32); if (e >= o) incl += v; }
        if (F.lane < 32) { mt[e] = incl - nt_; mt[34 + e] = (int)c; if (e == 31) mt[NEXP] = incl; }
    }
    LDS_WAIT(); __syncthreads();
}

__device__ __forceinline__ void scatter_phase(const Frame& F, const LAS int* mt) {
    const bf16_t* h2 = (const bf16_t*)(F.ws + WS_H2); bf16_t* xs = (bf16_t*)(F.ws + WS_XS);
    const int* topi = (const int*)(F.ws + WS_ROUTE); const int* posn = (const int*)(F.ws + WS_ROUTE + 262144); int* rowof = (int*)(F.ws + WS_ROUTE + 393216);
    const int lane = F.lane, gw = blockIdx.x * 8 + F.wave, NGW = F.G * 8;
    for (int pi = gw; pi < TOK * TOPK; pi += NGW) {
        const int e = topi[pi], dest = 256 * mt[e] + posn[pi], t = pi >> 2;
        if (lane == 0) rowof[pi] = dest;
#pragma unroll
        for (int j = 0; j < 2; ++j) *(u32x4*)((unsigned char*)xs + (size_t)dest * DM + 16 * (lane + 64 * j)) = *(const u32x4*)((const unsigned char*)h2 + (size_t)t * DM + 16 * (lane + 64 * j));
    }
}

__device__ __forceinline__ void combine_phase(const Frame& F) {
    const float* x1 = (const float*)(F.ws + WS_X1); const bf16_t* yb = (const bf16_t*)(F.ws + WS_YB); float* x2 = (float*)(F.ws + WS_X2);
    bf16_t* h3 = (bf16_t*)(F.ws + WS_H3); const bf16_t* ub = (const bf16_t*)(F.ws + WS_UB); bf16_t* pnb = (bf16_t*)(F.ws + WS_PN);
    const float* gate = (const float*)(F.ws + WS_ROUTE + 131072); const int* rowof = (const int*)(F.ws + WS_ROUTE + 393216);
    const float* gp = F.in[26]; const float* gpost = F.in[29];
    const int lane = F.lane, gw = blockIdx.x * 8 + F.wave, NGW = F.G * 8;
    for (int t = gw; t < TOK; t += NGW) {
        f32x4 xa[4], xb[4];
#pragma unroll
        for (int j = 0; j < 4; ++j) { xa[j] = *(const f32x4*)(x1 + (size_t)t * DM + 8 * (lane + 64 * j)); xb[j] = *(const f32x4*)(x1 + (size_t)t * DM + 8 * (lane + 64 * j) + 4); }
#pragma unroll
        for (int k = 0; k < TOPK; ++k) { const float g = gate[t * 4 + k]; const size_t r = (size_t)rowof[t * 4 + k];
#pragma unroll
            for (int j = 0; j < 4; ++j) { f32x4 ya, ybv; unpack8(*(const u32x4*)(yb + r * DM + 8 * (lane + 64 * j)), ya, ybv); xa[j] += g * ya; xb[j] += g * ybv; } }
        float ss = 0.f;
#pragma unroll
        for (int j = 0; j < 4; ++j) { *(f32x4*)(x2 + (size_t)t * DM + 8 * (lane + 64 * j)) = xa[j]; *(f32x4*)(x2 + (size_t)t * DM + 8 * (lane + 64 * j) + 4) = xb[j];
            ss += (xa[j][0] * xa[j][0] + xa[j][1] * xa[j][1]) + (xa[j][2] * xa[j][2] + xa[j][3] * xa[j][3]) + (xb[j][0] * xb[j][0] + xb[j][1] * xb[j][1]) + (xb[j][2] * xb[j][2] + xb[j][3] * xb[j][3]); }
        ss = wave_sum(ss);
        const float rs = rsqrtf(ss * (1.0f / DM) + RMS_EPS);
#pragma unroll
        for (int j = 0; j < 4; ++j) { const f32x4 g0 = *(const f32x4*)(gp + 8 * (lane + 64 * j)), g1 = *(const f32x4*)(gp + 8 * (lane + 64 * j) + 4);
            const f32x4 ha_ = xa[j] * rs * g0, hb_ = xb[j] * rs * g1; u32x2 w8; w8.x = pack_fp8x4(ha_[0], ha_[1], ha_[2], ha_[3]); w8.y = pack_fp8x4(hb_[0], hb_[1], hb_[2], hb_[3]);
            *(u32x2*)((unsigned char*)h3 + (size_t)t * DM + 8 * (lane + 64 * j)) = w8; }
        f32x4 ua[4], uc[4]; float su = 0.f;
#pragma unroll
        for (int j = 0; j < 4; ++j) { unpack8(*(const u32x4*)(ub + (size_t)t * DM + 8 * (lane + 64 * j)), ua[j], uc[j]);
            su += (ua[j][0] * ua[j][0] + ua[j][1] * ua[j][1]) + (ua[j][2] * ua[j][2] + ua[j][3] * ua[j][3]) + (uc[j][0] * uc[j][0] + uc[j][1] * uc[j][1]) + (uc[j][2] * uc[j][2] + uc[j][3] * uc[j][3]); }
        su = wave_sum(su);
        const float ru = rsqrtf(su * (1.0f / DM) + RMS_EPS);
#pragma unroll
        for (int j = 0; j < 4; ++j) { const f32x4 g0 = *(const f32x4*)(gpost + 8 * (lane + 64 * j)), g1 = *(const f32x4*)(gpost + 8 * (lane + 64 * j) + 4);
            *(u32x4*)(pnb + (size_t)t * DM + 8 * (lane + 64 * j)) = pack8(ua[j] * ru * g0, uc[j] * ru * g1); }
    }
}

struct EpiPlain {
    static constexpr bool PERM = true, AFTER_DRAIN = false, HAS_MID = false;
    bf16_t* O;
    __device__ __forceinline__ void operator()(const f32x4 (&acc)[2][2][4][2], const Unit& u, int wr, int wc, int fr, int fq) const {
        const size_t row0 = (size_t)u.pm * 256 + wr * 64 + fr; const int c0 = u.pn * 256 + wc * 32 + 8 * fq;
#pragma unroll
        for (int ai = 0; ai < 2; ++ai)
#pragma unroll
            for (int m = 0; m < 4; ++m)
#pragma unroll
                for (int bj = 0; bj < 2; ++bj) *(u32x4*)(O + (row0 + ai * 128 + m * 16) * DM + c0 + bj * 128) = pack8(acc[ai][bj][m][0], acc[ai][bj][m][1]);
    }
};

#ifndef NCONV
#define NCONV 112
#endif
#ifndef NC1
#define NC1 0
#endif
constexpr int MOE_NIT = CV_NIT, MOE_SPLIT = NC1 ? (MOE_NIT * 27 / 100) / (NC1 * 8 + (NC1 == 0)) * (NC1 * 8) : 0;
__device__ __forceinline__ void attn_gla_phase(Frame& F, int rep) {
    volatile LAS unsigned* misc = (volatile LAS unsigned*)(F.lds + MISC_OFF);
    unsigned* ctl = (unsigned*)(F.ws + WS_CTL);
    const bool do_gla = (rep == 0 || rep == 1 || rep == 2 || rep == 6), do_att = (rep == 0 || rep == 1 || rep == 3 || rep == 6), do_conv = (rep == 0 || rep == 4 || rep == 5 || rep == 6);
    if ((int)blockIdx.x < NB * GL_H * 4) { if (do_gla) gla_scan_unit(F, (int)blockIdx.x); }
    else if ((int)blockIdx.x < NB * GL_H * 4 + NCONV) { if (do_conv) moe_convert(F, (int)blockIdx.x - NB * GL_H * 4, NCONV, MOE_SPLIT, MOE_NIT, rep == 5); }
    const float lam = __uint_as_float((unsigned)__builtin_amdgcn_readfirstlane((int)__hip_atomic_load(ctl + CW_LAM, RLX_AGENT)));
    if (do_att) for (;;) {
        if (F.tid == 0) misc[4] = __hip_atomic_fetch_add(ctl + CW_QUEUE + 64 * rep, 1u, RLX_AGENT);
        LDS_WAIT(); __syncthreads();
        const unsigned unit = misc[4];
        if (unit >= (unsigned)(NB * DA_H * (SEQ / 128))) break;
        const int qb = 31 - (int)(unit >> 4), bh = (int)(unit & 15);
        attn_unit(F, bh >> 3, bh & 7, qb, lam);
    }
    __syncthreads();
}

constexpr int NPHASE = 14;
struct Args { const float* in[30]; float* out; unsigned char* ws; int ph_lo, ph_hi, rep, pad; };
__global__ void __launch_bounds__(512, 2) mk_fwd(Args args) {
    extern __shared__ __attribute__((aligned(16))) unsigned char lds_raw[];
    Frame F;
    F.lds = (LAS unsigned char*)lds_raw;
    F.wave = __builtin_amdgcn_readfirstlane((int)threadIdx.x >> 6); refresh(F);
    F.G = gridDim.x; { const int bx = blockIdx.x; F.vcu = (F.G % 8 == 0) ? (bx % 8) * (F.G / 8) + bx / 8 : bx; }
    F.ws = args.ws; F.out = args.out;
#pragma unroll
    for (int i = 0; i < 30; ++i) F.in[i] = args.in[i];
    volatile LAS unsigned* misc = (volatile LAS unsigned*)(F.lds + MISC_OFF);
    if (F.tid < 64) misc[F.tid] = 0u;
    __syncthreads();
    unsigned* ctl = (unsigned*)(F.ws + WS_CTL);
    const int lo = args.ph_lo, hi = args.ph_hi;
    const bool multi = (hi - lo) > 1;
    XcdBarrier bar; bar.bar = ctl + CW_BAR; bar.x = 0; bar.st = nullptr; bar.wave = 0;
    if (multi) bar = xcd_barrier_post(ctl + CW_BAR, misc + 8);
    bar.wave = F.wave;
#ifndef PH_MASK
#define PH_MASK 0xFFFF
#endif
#define IN(k) (((PH_MASK >> (k)) & 1) && lo <= (k) && (k) < hi)
#define SEAM(k) do { if (IN(k) && IN((k) + 1)) xcd_barrier(bar); } while (0)
#ifndef REP_MASK
#define REP_MASK 0
#endif
#define NREP(k) ((((REP_MASK) >> (k)) & 1) ? 2 : 1)
#define REPSEAM(k) do { if (rep + 1 < NREP(k)) xcd_barrier(bar); } while (0)
    LAS int* mt = (LAS int*)(F.lds + MISC_OFF + 64);
    LAS unsigned char* ring = F.lds;

    if (IN(0)) { refresh(F); p0_prologue(F, args.rep); } SEAM(0);
    if (IN(1)) { refresh(F);
        const int ncomp = F.G - NC1;
        if ((int)blockIdx.x < ncomp) {
        pg8::Gemm g{(const bf16_t*)(F.ws + WS_H1), (const bf16_t*)(F.ws + WS_WTIN), TOK, IN_MAIN, DM, F.tid}; pg8::StaticOrder S; S.init(TOK, IN_MAIN, ncomp, (int)blockIdx.x);
        EpiInProj E{(bf16_t*)(F.ws + WS_Q), (bf16_t*)(F.ws + WS_K), (bf16_t*)(F.ws + WS_V), (bf16_t*)(F.ws + WS_GQP), (bf16_t*)(F.ws + WS_GQM), (bf16_t*)(F.ws + WS_GKP), (bf16_t*)(F.ws + WS_GKM),
                    (bf16_t*)(F.ws + WS_GV), (bf16_t*)(F.ws + WS_SG), (bf16_t*)(F.ws + WS_GATES), F.in[3], F.in[4], (const float*)(F.ws + WS_BCUM), F.in[16], (LAS float*)(F.lds + EX_OFF)};
        pg8::gemm_phase<EpiInProj, pg8::StaticOrder, true, true>(ring, g, S, E);
        refresh(F);
        { pg8::Gemm g2{(const bf16_t*)(F.ws + WS_H1F8), (const bf16_t*)(F.ws + WS_WTMG8), TOK, 2 * DM, DM / 2, F.tid}; pg8::StaticOrder S2; S2.init(TOK, 2 * DM, ncomp, (int)blockIdx.x);
          EpiGates E2{(bf16_t*)(F.ws + WS_GATES), F.in[16]};
          pg8::gemm_phase<EpiGates, pg8::StaticOrder, true, true, 2>(ring, g2, S2, E2); }
        }
#if NC1 > 0
        else if (args.rep == 0) moe_convert(F, (int)blockIdx.x - ncomp, NC1, 0, MOE_SPLIT);
#endif
    } SEAM(1);
    if (IN(2)) { refresh(F); gla_scores_phase(F); } SEAM(2);
    if (IN(3)) { refresh(F); attn_gla_phase(F, args.rep); } SEAM(3);
    if (IN(4)) { refresh(F); gla_out_phase(F); } SEAM(4);
    if (IN(5)) { refresh(F);
        pg8::Gemm g{(const bf16_t*)(F.ws + WS_YCAT), (const bf16_t*)(F.ws + WS_WTBR), TOK, DM, 2 * DM, F.tid}; pg8::StaticOrder S; S.init(TOK, DM, F.G, (int)blockIdx.x);
        EpiMixed2 E{(const bf16_t*)(F.ws + WS_GATES), (bf16_t*)(F.ws + WS_MIXED)};
        pg8::gemm_phase<EpiMixed2, pg8::StaticOrder, true, true>(ring, g, S, E);
    } SEAM(5);
    if (IN(6)) { refresh(F);
#ifndef NO_X1
        { pg8::Gemm g{(const bf16_t*)(F.ws + WS_MIXED), (const bf16_t*)(F.ws + WS_WTOUT), TOK, DM, DM, F.tid}; pg8::StaticOrder S; S.init(TOK, DM, F.G, (int)blockIdx.x);
          EpiX1 E{F.in[0], (float*)(F.ws + WS_X1)};
          pg8::gemm_phase<EpiX1, pg8::StaticOrder, true, true>(ring, g, S, E); }
#endif
#ifndef NO_PLEUP
        { int kple = PLE; asm volatile("" : "+s"(kple));
          pg8::Gemm g{(const bf16_t*)(F.ws + WS_PB), (const bf16_t*)(F.ws + WS_WTPLEUP), TOK, DM, kple, F.tid}; pg8::StaticOrder S; S.init(TOK, DM, F.G, (int)blockIdx.x);
          EpiPlain E{(bf16_t*)(F.ws + WS_UB)};
          pg8::gemm_phase<EpiPlain, pg8::StaticOrder, true, true>(ring, g, S, E); }
#endif
    } SEAM(6);
    if (IN(7)) { refresh(F); route_phase(F, args.rep); } SEAM(7);
    if (IN(8)) { refresh(F); build_mtoff(F, mt); scatter_phase(F, mt); } SEAM(8);
    if (IN(9)) { refresh(F);
        build_mtoff(F, mt);
        pg8::Gemm g{(const bf16_t*)(F.ws + WS_XS), (const bf16_t*)(F.ws + WS_WTGU), MAXROWS, 2 * DEXP, DM / 2, F.tid}; GroupedOrder S; S.init(mt, 16, F.G, (int)blockIdx.x);
        EpiGU8 E{F.in[23], (unsigned char*)(F.ws + WS_ACT)};
        pg8::gemm_phase<EpiGU8, GroupedOrder, true, true, 2>(ring, g, S, E);
    } SEAM(9);
    if (IN(10)) { refresh(F);
        build_mtoff(F, mt);
        pg8::Gemm g{(const bf16_t*)(F.ws + WS_ACT), (const bf16_t*)(F.ws + WS_WTDN), MAXROWS, DM, DEXP / 2, F.tid}; GroupedOrder S; S.init(mt, 8, F.G, (int)blockIdx.x);
        EpiDN8 E{F.in[25], (bf16_t*)(F.ws + WS_YB)};
        pg8::gemm_phase<EpiDN8, GroupedOrder, true, true, 2>(ring, g, S, E);
    } SEAM(10);
    if (IN(11)) { refresh(F); combine_phase(F); } SEAM(11);
    if (IN(12)) { refresh(F);
        pg8::Gemm g{(const bf16_t*)(F.ws + WS_H3), (const bf16_t*)(F.ws + WS_WTPLEG), TOK, DM, DM / 2, F.tid}; pg8::StaticOrder S; S.init(TOK, DM, F.G, (int)blockIdx.x);
        EpiOut E{(const float*)(F.ws + WS_X2), (const bf16_t*)(F.ws + WS_PN), F.out, W8_INV};
        pg8::gemm_phase<EpiOut, pg8::StaticOrder, true, true, 2>(ring, g, S, E);
    }
#undef IN
#undef SEAM
}

#ifndef MK_LAUNCHES
#define MK_LAUNCHES 1
#endif
extern "C" void kernel_launch(void* const* d_in, const int* in_sizes, int n_in, void* d_out, int out_size, void* d_ws, size_t ws_size, hipStream_t stream) {
    static int grid = 0;
    if (grid == 0) {
        if (n_in != 30 || out_size != TOK * DM || ws_size < WS_END) { fprintf(stderr, "kernel_launch: unexpected shapes (n_in %d out %d ws %zu)\n", n_in, out_size, ws_size); grid = -1; return; }
        int dev = 0, cus = 0, per_cu = 0;
        if (hipGetDevice(&dev) != hipSuccess || hipDeviceGetAttribute(&cus, hipDeviceAttributeMultiprocessorCount, dev) != hipSuccess) { grid = -1; return; }
        if (hipFuncSetAttribute((const void*)mk_fwd, hipFuncAttributeMaxDynamicSharedMemorySize, LDS_BYTES) != hipSuccess) { fprintf(stderr, "kernel_launch: hipFuncSetAttribute failed\n"); grid = -1; return; }
        if (hipOccupancyMaxActiveBlocksPerMultiprocessor(&per_cu, (const void*)mk_fwd, 512, LDS_BYTES) != hipSuccess || per_cu < 1) { fprintf(stderr, "kernel_launch: occupancy query says %d\n", per_cu); (void)hipGetLastError(); per_cu = 1; }
        grid = cus;
    }
    if (grid < 0) return;
    (void)hipMemsetAsync((char*)d_ws + WS_CTL, 0, CTL_ZERO_BYTES, stream);
    Args a{};
    for (int i = 0; i < 30; ++i) a.in[i] = (const float*)d_in[i];
    a.out = (float*)d_out; a.ws = (unsigned char*)d_ws;
#if MK_LAUNCHES == 1
    a.ph_lo = 0; a.ph_hi = NPHASE;
    hipLaunchKernelGGL(mk_fwd, dim3(grid), dim3(512), LDS_BYTES, stream, a);
#else
    for (int p = 0; p < 13; ++p) for (int rep = 0; rep < NREP(p); ++rep) { a.ph_lo = p; a.ph_hi = p + 1; a.rep = rep;
#ifdef PROBE3_MODE
        if (p == 3 && rep == 1) a.rep = PROBE3_MODE;
#endif
#ifdef PROBE0_MODE
        if (p == 0 && rep == 1) a.rep = PROBE0_MODE;
#endif
        hipLaunchKernelGGL(mk_fwd, dim3(grid), dim3(512), LDS_BYTES, stream, a); }
#endif
}
```

```cpp
#include <hip/hip_runtime.h>
#define MK_LAUNCHES 1
#include <cstdio>
#include <cstdint>
namespace pg8 {
#define PG8_LAS __attribute__((address_space(3)))
typedef unsigned short bf16_t;
typedef short bf16x8 __attribute__((ext_vector_type(8)));
typedef float f32x4 __attribute__((ext_vector_type(4)));
typedef unsigned u32x4 __attribute__((ext_vector_type(4)));
typedef long i64x2_t __attribute__((ext_vector_type(2)));
typedef short bf16x16_t __attribute__((ext_vector_type(16)));
typedef int i32x8_t __attribute__((ext_vector_type(8)));
constexpr int BM = 256, BK = 64, HALF = 128, HTB = HALF * BK * 2  , STAGE_BYTES = 8 * HTB, NXCD = 8, WGM = 4;

__host__ __device__ __forceinline__ int lds_byte(int r, int c) { const int st = (r >> 4) * 2 + (c >> 5), rr = r & 15, cc = c & 31, ob = rr * 64 + cc * 2; return st * 1024 + (ob ^ (((ob >> 9) & 1) << 5)); }
__host__ __device__ __forceinline__ void stage_rc(int b, int& R, int& C) { const int st = b / 1024, sb = b % 1024, swz = sb ^ (((sb >> 9) & 1) << 5); R = (st >> 1) * 16 + swz / 64; C = (st & 1) * 32 + (swz % 64) / 2; }
__host__ __device__ __forceinline__ int perm32(int rho) { const int n = rho >> 4, i = rho & 15; return 8 * (i >> 2) + 4 * n + (i & 3); }

struct Unit { int pm, pn, flags; };
struct Gemm { const bf16_t* A; const bf16_t* Bt; int M, N, K, tid; };

struct StaticOrder {
    int nM, nN, nwg, G, c;
    __host__ __device__ void init(int M, int N, int G_, int c_) { nM = M / BM; nN = N / BM; nwg = nM * nN; G = G_; c = c_; }
    __host__ __device__ bool next(int i, Unit& u) const {
        const long L = (long)i * G + c; if (L >= nwg) return false;
        int wgid = (int)L; { const int q = nwg / NXCD, r = nwg % NXCD, xcd = wgid % NXCD, off = wgid / NXCD; wgid = (xcd < r ? xcd * (q + 1) : r * (q + 1) + (xcd - r) * q) + off; }
        const int nig = WGM * nN, gid = wgid / nig, fm = gid * WGM, gsz = (nM - fm) < WGM ? (nM - fm) : WGM;
        u.pm = fm + ((wgid % nig) % gsz); u.pn = (wgid % nig) / gsz; u.flags = 0; return true;
    }
    __device__ __forceinline__ void a_ready(const Unit&) const {}
    __device__ __forceinline__ void done(const Unit&) const {}
};

__device__ __forceinline__ unsigned cvt_pk_bf16(float lo, float hi) { unsigned r; asm volatile("v_cvt_pk_bf16_f32 %0, %1, %2" : "=v"(r) : "v"(lo), "v"(hi)); return r; }
template <class Epi, class Sched, bool ALIGN_EPI = false, bool SP2 = false, int FP8 = 0  >
__device__ __forceinline__ void gemm_phase(PG8_LAS unsigned char* lds, const Gemm g, const Sched& S, const Epi& E) {
    const int tid = g.tid, wid = __builtin_amdgcn_readfirstlane(tid >> 6), lane = tid & 63, wr = wid >> 2, wc = wid & 3, fr = lane & 15, fq = lane >> 4;
    const int K = g.K, nt = K / BK;
    unsigned voffA[2], voffB[2];
#pragma unroll
    for (int i = 0; i < 2; ++i) { int R, C; stage_rc(tid * 16 + i * 8192, R, C); const int Rb = Epi::PERM ? ((R & ~31) + perm32(R & 31)) : R;
        voffA[i] = (unsigned)(R * K + C) * 2u; voffB[i] = (unsigned)(Rb * K + C) * 2u; }
    const size_t kstep = (size_t)(BK * 2);
    const size_t hstep = (size_t)HALF * K * 2;
    const size_t tstep = 2 * hstep;
    const unsigned ldsw = (unsigned)wid * 1024u;
    const int aoff = lds_byte(wr * 64 + fr, fq * 8), boff = lds_byte(wc * 32 + fr, fq * 8);
#define PG8_SA(b, h) (((b) * 2 + (h)) * HTB)
#define PG8_SB(b, h) ((4 + (b) * 2 + (h)) * HTB)
#define PG8_STAGE(bufoff, gbase, voff) do { _Pragma("unroll") for (int _i = 0; _i < 2; ++_i) { unsigned vo_ = (voff)[_i]; asm volatile("" : "+v"(vo_));   \
        __builtin_amdgcn_global_load_lds((const unsigned*)((const char*)(gbase) + vo_), (PG8_LAS unsigned*)(lds + (bufoff) + ldsw + _i * 8192), 16, 0, 0); } } while (0)
#define PG8_LDA(dst, b, h) do { _Pragma("unroll") for (int m = 0; m < 4; ++m) _Pragma("unroll") for (int k = 0; k < 2; ++k) dst[m][k] = *(const PG8_LAS bf16x8*)(lds + PG8_SA(b, h) + aoff + m * 2048 + k * 1024); } while (0)
#define PG8_LDB(dst, b, h) do { _Pragma("unroll") for (int n = 0; n < 2; ++n) _Pragma("unroll") for (int k = 0; k < 2; ++k) dst[n][k] = *(const PG8_LAS bf16x8*)(lds + PG8_SB(b, h) + boff + n * 2048 + k * 1024); } while (0)
#define PG8_MMA(ai, bj, At, Bt) do { __builtin_amdgcn_s_setprio(1); \
        if constexpr (FP8 == 2) { _Pragma("unroll") for (int m = 0; m < 4; ++m) _Pragma("unroll") for (int n = 0; n < 2; ++n) { \
            const bf16x16_t b16_ = __builtin_shufflevector(Bt[n][0], Bt[n][1], 0, 1, 2, 3, 4, 5, 6, 7, 8, 9, 10, 11, 12, 13, 14, 15), a16_ = __builtin_shufflevector(At[m][0], At[m][1], 0, 1, 2, 3, 4, 5, 6, 7, 8, 9, 10, 11, 12, 13, 14, 15); \
            acc[ai][bj][m][n] = __builtin_amdgcn_mfma_scale_f32_16x16x128_f8f6f4(__builtin_bit_cast(i32x8_t, b16_), __builtin_bit_cast(i32x8_t, a16_), acc[ai][bj][m][n], 0, 0, 0, 0, 0, 0); } } \
        else { _Pragma("unroll") for (int m = 0; m < 4; ++m) _Pragma("unroll") for (int n = 0; n < 2; ++n) _Pragma("unroll") for (int k = 0; k < 2; ++k) { \
        if constexpr (FP8 == 1) { const i64x2_t b2_ = __builtin_bit_cast(i64x2_t, Bt[n][k]), a2_ = __builtin_bit_cast(i64x2_t, At[m][k]); \
            acc[ai][bj][m][n] = __builtin_amdgcn_mfma_f32_16x16x32_fp8_fp8(b2_[0], a2_[0], acc[ai][bj][m][n], 0, 0, 0); \
            acc[ai][bj][m][n] = __builtin_amdgcn_mfma_f32_16x16x32_fp8_fp8(b2_[1], a2_[1], acc[ai][bj][m][n], 0, 0, 0); } \
        else acc[ai][bj][m][n] = __builtin_amdgcn_mfma_f32_16x16x32_bf16(Bt[n][k], At[m][k], acc[ai][bj][m][n], 0, 0, 0); } } __builtin_amdgcn_s_setprio(0); } while (0)
#define PG8_WAIT_V(n) asm volatile("s_waitcnt vmcnt(" #n ")" ::: "memory")
#define PG8_WAIT_L(n) asm volatile("s_waitcnt lgkmcnt(" #n ")" ::: "memory")
#define PG8_BAR __builtin_amdgcn_s_barrier()
#define PG8_SCHED __builtin_amdgcn_sched_barrier(0)
    Unit cur, nxt; int ui = 0;
    if (!S.next(0, cur)) return;
    f32x4 acc[2][2][4][2];
#pragma unroll
    for (int a = 0; a < 2; ++a)
#pragma unroll
        for (int b = 0; b < 2; ++b)
#pragma unroll
            for (int m = 0; m < 4; ++m)
#pragma unroll
                for (int n = 0; n < 2; ++n) acc[a][b][m][n] = (f32x4){0.f, 0.f, 0.f, 0.f};
    bf16x8 At[4][2], B0[2][2], B1[2][2];
    const char* cA = (const char*)g.A + (size_t)cur.pm * tstep; const char* cB = (const char*)g.Bt + (size_t)cur.pn * tstep;
    S.a_ready(cur);
    if constexpr (SP2) {
        PG8_STAGE(PG8_SB(0, 0), cB, voffB); PG8_STAGE(PG8_SB(0, 1), cB + hstep, voffB); PG8_STAGE(PG8_SA(0, 0), cA, voffA); PG8_STAGE(PG8_SA(0, 1), cA + hstep, voffA);
        if (wr == 1) PG8_BAR;
        PG8_WAIT_V(2); PG8_BAR;
        PG8_STAGE(PG8_SB(1, 0), cB + kstep, voffB); PG8_STAGE(PG8_SA(1, 0), cA + kstep, voffA); PG8_STAGE(PG8_SB(1, 1), cB + hstep + kstep, voffB);
        PG8_WAIT_V(6); PG8_BAR;
    } else {
        PG8_STAGE(PG8_SB(0, 0), cB, voffB); PG8_STAGE(PG8_SA(0, 0), cA, voffA); PG8_STAGE(PG8_SB(0, 1), cB + hstep, voffB); PG8_STAGE(PG8_SA(0, 1), cA + hstep, voffA);
        if (wr == 1) PG8_BAR;
        PG8_WAIT_V(4); PG8_BAR;
        PG8_STAGE(PG8_SB(1, 0), cB + kstep, voffB); PG8_STAGE(PG8_SA(1, 0), cA + kstep, voffA); PG8_STAGE(PG8_SB(1, 1), cB + hstep + kstep, voffB);
        PG8_WAIT_V(6); PG8_BAR;
    }
    for (;;) {
        const bool has_next = S.next(ui + 1, nxt);
        const char* nA = has_next ? (const char*)g.A + (size_t)nxt.pm * tstep : cA; const char* nB = has_next ? (const char*)g.Bt + (size_t)nxt.pn * tstep : cB;
        for (int t = 0; t < nt; t += 2) {
            const bool last = (t == nt - 2);
            const char* a1 = cA + (size_t)(t + 1) * kstep;
            const char* a2 = last ? nA : cA + (size_t)(t + 2) * kstep; const char* b2 = last ? nB : cB + (size_t)(t + 2) * kstep;
            const char* a3 = a2 + kstep; const char* b3 = b2 + kstep;
            if (last && has_next) S.a_ready(nxt);
            if constexpr (Epi::HAS_MID) { if (t == nt / 2) E.mid(acc, cur, wr, wc, fr, fq); }
            if constexpr (SP2) {
            PG8_LDB(B0, 0, 0); PG8_LDB(B1, 0, 1); PG8_SCHED; PG8_LDA(At, 0, 0); PG8_STAGE(PG8_SA(1, 1), a1 + hstep, voffA);
            PG8_WAIT_V(8); PG8_WAIT_L(0); PG8_BAR; PG8_MMA(0, 0, At, B0); PG8_MMA(0, 1, At, B1); PG8_BAR; PG8_SCHED;
            PG8_LDA(At, 0, 1); PG8_STAGE(PG8_SB(0, 0), b2, voffB); PG8_STAGE(PG8_SB(0, 1), b2 + hstep, voffB); PG8_STAGE(PG8_SA(0, 0), a2, voffA);
            PG8_WAIT_V(8); PG8_WAIT_L(0); PG8_BAR; if (!(cur.flags & 1)) { PG8_MMA(1, 0, At, B0); PG8_MMA(1, 1, At, B1); } PG8_BAR; PG8_SCHED;
            PG8_LDB(B0, 1, 0); PG8_LDB(B1, 1, 1); PG8_SCHED; PG8_LDA(At, 1, 0); PG8_STAGE(PG8_SA(0, 1), a2 + hstep, voffA);
            PG8_WAIT_V(8); PG8_WAIT_L(0); PG8_BAR; PG8_MMA(0, 0, At, B0); PG8_MMA(0, 1, At, B1); PG8_BAR; PG8_SCHED;
            PG8_LDA(At, 1, 1); PG8_STAGE(PG8_SB(1, 0), b3, voffB); PG8_STAGE(PG8_SB(1, 1), b3 + hstep, voffB); PG8_STAGE(PG8_SA(1, 0), a3, voffA);
            PG8_WAIT_V(8); PG8_WAIT_L(0); PG8_BAR; if (!(cur.flags & 1)) { PG8_MMA(1, 0, At, B0); PG8_MMA(1, 1, At, B1); } PG8_BAR; PG8_SCHED;
            } else {
            PG8_LDB(B0, 0, 0); PG8_SCHED; PG8_LDA(At, 0, 0); PG8_STAGE(PG8_SA(1, 1), a1 + hstep, voffA);
            PG8_WAIT_L(8); PG8_BAR; PG8_WAIT_L(0); PG8_MMA(0, 0, At, B0); PG8_BAR; PG8_SCHED;
            PG8_LDB(B1, 0, 1); PG8_STAGE(PG8_SB(0, 0), b2, voffB);
            PG8_BAR; PG8_WAIT_L(0); PG8_MMA(0, 1, At, B1); PG8_BAR;
            PG8_LDA(At, 0, 1); PG8_STAGE(PG8_SA(0, 0), a2, voffA);
            PG8_BAR; PG8_WAIT_L(0); PG8_MMA(1, 0, At, B0); PG8_BAR; PG8_SCHED;
            PG8_STAGE(PG8_SB(0, 1), b2 + hstep, voffB);
            PG8_WAIT_V(6); PG8_BAR; PG8_MMA(1, 1, At, B1); PG8_BAR;
            PG8_LDB(B0, 1, 0); PG8_SCHED; PG8_LDA(At, 1, 0); PG8_STAGE(PG8_SA(0, 1), a2 + hstep, voffA);
            PG8_WAIT_L(8); PG8_BAR; PG8_WAIT_L(0); PG8_MMA(0, 0, At, B0); PG8_BAR; PG8_SCHED;
            PG8_LDB(B1, 1, 1); PG8_STAGE(PG8_SB(1, 0), b3, voffB);
            PG8_BAR; PG8_WAIT_L(0); PG8_MMA(0, 1, At, B1); PG8_BAR;
            PG8_LDA(At, 1, 1); PG8_STAGE(PG8_SA(1, 0), a3, voffA);
            PG8_BAR; PG8_WAIT_L(0); PG8_MMA(1, 0, At, B0); PG8_BAR; PG8_SCHED;
            PG8_STAGE(PG8_SB(1, 1), b3 + hstep, voffB);
            PG8_WAIT_V(6); PG8_BAR; PG8_MMA(1, 1, At, B1); PG8_BAR;
            }
        }
        if constexpr (ALIGN_EPI) { if (wr == 0) PG8_BAR; }
        if constexpr (!Epi::AFTER_DRAIN) { E(acc, cur, wr, wc, fr, fq); S.done(cur); }
        if (!has_next) break;
#pragma unroll
        for (int a = 0; a < 2; ++a)
#pragma unroll
            for (int b = 0; b < 2; ++b)
#pragma unroll
                for (int m = 0; m < 4; ++m)
#pragma unroll
                    for (int n = 0; n < 2; ++n) acc[a][b][m][n] = (f32x4){0.f, 0.f, 0.f, 0.f};
        cur = nxt; cA = nA; cB = nB; ++ui;
        if constexpr (ALIGN_EPI) { if (wr == 1) PG8_BAR; }
    }
    PG8_WAIT_V(0);
    if constexpr (!ALIGN_EPI) { if (wr == 0) PG8_BAR; }
    PG8_BAR;
    if constexpr (Epi::AFTER_DRAIN) { E.fused(acc, cur, wr, wc, fr, fq, lds, wid, lane); S.done(cur); }
#undef PG8_SA
#undef PG8_SB
#undef PG8_STAGE
#undef PG8_LDA
#undef PG8_LDB
#undef PG8_MMA
#undef PG8_WAIT_V
#undef PG8_WAIT_L
#undef PG8_BAR
#undef PG8_SCHED
}
}
#define XB_TMO      128
#define XB_XCNT(j)  (256  + 64 * (j))
#define XB_XSUB(j)  (1280 + 64 * (j))
#define XB_XGEN(j)  (2304 + 64 * (j))
#define XB_TOP      3328
#define XB_TOPGEN   3392
#define XCD_BAR_WORDS 3456
#define XB_SPIN_CAP (1u << 18)
#define LAS __attribute__((address_space(3)))

__device__ __forceinline__ unsigned xb_ld(unsigned* p)              { return __hip_atomic_load(p, __ATOMIC_RELAXED, __HIP_MEMORY_SCOPE_AGENT); }
__device__ __forceinline__ unsigned xb_add(unsigned* p, unsigned v) { return __hip_atomic_fetch_add(p, v, __ATOMIC_RELAXED, __HIP_MEMORY_SCOPE_AGENT); }
__device__ __forceinline__ unsigned xb_xcc_id() { return (unsigned)__builtin_amdgcn_s_getreg((3 << 11) | 20) & 0xFu; }
#define XB_SPIN(cond, bar) do { unsigned _sp = 0; while (cond) { __builtin_amdgcn_s_sleep(1); \
    if ((++_sp & 255u) == 0u) { if (xb_ld(&(bar)[XB_TMO])) break; if (_sp > XB_SPIN_CAP) { atomicAdd(&(bar)[XB_TMO], 1u); break; } } } } while (0)

struct XcdBarrier {
    unsigned* bar; unsigned x; int wave;
    volatile LAS unsigned* st;
};

__device__ __forceinline__ XcdBarrier xcd_barrier_post(unsigned* bar, volatile LAS unsigned* st) {
    XcdBarrier b; b.bar = bar; b.x = xb_xcc_id(); b.st = st;
    if (threadIdx.x == 0) (void)xb_add(&bar[XB_XCNT(b.x)], 1u);
    return b;
}
__device__ __forceinline__ void xcd_barrier_complete(unsigned* bar, unsigned x, unsigned& nloc, unsigned& nx) {
    const unsigned G = gridDim.x * gridDim.y * gridDim.z;
    unsigned sum, cnt, mine, sp = 0u;
    for (;;) {
        sum = 0u; cnt = 0u; mine = 0u;
#pragma unroll
        for (unsigned j = 0; j < 16; ++j) { const unsigned c = xb_ld(&bar[XB_XCNT(j)]); sum += c; cnt += (c > 0u) ? 1u : 0u; mine = (j == x) ? c : mine; }
        if (sum == G) break;
        __builtin_amdgcn_s_sleep(1);
        if ((++sp & 255u) == 0u) { if (xb_ld(&bar[XB_TMO])) break; if (sp > XB_SPIN_CAP) { atomicAdd(&bar[XB_TMO], 1u); break; } }
    }
    nloc = mine > 0u ? mine : 1u; nx = cnt > 0u ? cnt : 1u;
}

__device__ __forceinline__ void xcd_barrier(const XcdBarrier& b) {
    asm volatile("s_waitcnt vmcnt(0)" ::: "memory");
    __syncthreads();
    if (b.wave == 0 && __builtin_amdgcn_mbcnt_hi(~0u, __builtin_amdgcn_mbcnt_lo(~0u, 0u)) == 0u) {
        unsigned* bar = b.bar;
        __builtin_amdgcn_s_waitcnt(0);
        unsigned nloc = b.st[0], nx = b.st[1];
        if (nloc == 0u) { xcd_barrier_complete(bar, b.x, nloc, nx); b.st[0] = nloc; b.st[1] = nx; }
        const unsigned old = xb_add(&bar[XB_XSUB(b.x)], 1u);
        const unsigned gen = old / nloc;
        if (old + 1u == (gen + 1u) * nloc) {
            __builtin_amdgcn_fence(__ATOMIC_RELEASE, "agent");
            asm volatile("s_waitcnt vmcnt(0)" ::: "memory");
            const unsigned og = xb_add(&bar[XB_TOP], 1u);
            const unsigned tg = og / nx;
            if (og + 1u == (tg + 1u) * nx) xb_add(&bar[XB_TOPGEN], 1u);
            else XB_SPIN(xb_ld(&bar[XB_TOPGEN]) == tg, bar);
            __builtin_amdgcn_fence(__ATOMIC_ACQUIRE, "agent");
            xb_add(&bar[XB_XGEN(b.x)], 1u);
            asm volatile("s_waitcnt vmcnt(0)" ::: "memory");
        } else {
            XB_SPIN(xb_ld(&bar[XB_XGEN(b.x)]) == gen, bar);
            __builtin_amdgcn_fence(__ATOMIC_ACQUIRE, "agent");
            asm volatile("s_waitcnt vmcnt(0)" ::: "memory");
        }
    }
    __syncthreads();
}


#define GAS __attribute__((address_space(1)))
using pg8::bf16_t; using pg8::bf16x8; using pg8::f32x4; using pg8::u32x4; using pg8::cvt_pk_bf16;
typedef short s16x4 __attribute__((ext_vector_type(4)));
typedef float f32x16 __attribute__((ext_vector_type(16)));
typedef float f32x2 __attribute__((ext_vector_type(2)));
typedef unsigned u32x2 __attribute__((ext_vector_type(2)));
#define RLX_AGENT __ATOMIC_RELAXED, __HIP_MEMORY_SCOPE_AGENT
#define LDS_WAIT() asm volatile("s_waitcnt lgkmcnt(0)" ::: "memory")
#define VM_WAIT() asm volatile("s_waitcnt vmcnt(0)" ::: "memory")

constexpr int NB = 2, SEQ = 4096, DM = 2048, TOK = NB * SEQ;
constexpr int PLE = 256;
constexpr int DA_H = 8, DA_D = 128, DA_V = 256;
constexpr int GL_H = 4, GL_DK = 256, GL_DV = 512, GL_KW = 1024, GL_VW = 2048, GL_R = 16;
constexpr int NEXP = 32, TOPK = 4, DEXP = 2048;
constexpr int IN_W = 12304, IN_MAIN = 12288;
constexpr int N_INP = IN_MAIN + 2 * DM;
constexpr int CHUNK = 64, NCH = SEQ / CHUNK;
constexpr float RMS_EPS = 1e-6f;
constexpr float LOG2E = 1.4426950408889634f;
constexpr int MAXROWS = 40960;

constexpr size_t MiB = 1u << 20;
constexpr size_t WS_CTL = 0, CTL_ZERO_BYTES = 1 * MiB;
constexpr size_t WS_WTIN = 1 * MiB;
constexpr size_t WS_WTBR = 65 * MiB;
constexpr size_t WS_WTOUT = 81 * MiB, WS_WTPLEG = 89 * MiB;
constexpr size_t WS_WTPLEUP = 97 * MiB;
constexpr size_t WS_WTGU = 98 * MiB;
constexpr size_t WS_WTDN = 610 * MiB;
constexpr size_t WS_H1 = 866 * MiB;
constexpr size_t WS_Q = 898 * MiB, WS_K = 930 * MiB, WS_V = 962 * MiB;
constexpr size_t WS_GQP = 994 * MiB, WS_GQM = 1010 * MiB, WS_GKP = 1026 * MiB, WS_GKM = 1042 * MiB;
constexpr size_t WS_GV = 1058 * MiB, WS_SG = 1090 * MiB;
constexpr size_t WS_GATES = 1122 * MiB;
constexpr size_t WS_BCUM = 1186 * MiB;
constexpr size_t WS_ATTC = 1218 * MiB;
constexpr size_t WS_YDA = 1222 * MiB;
constexpr size_t WS_OGLA = 1254 * MiB;
constexpr size_t WS_YGLA = 1318 * MiB;
constexpr size_t WS_YCAT = 1350 * MiB;
constexpr size_t WS_MIXED = 1414 * MiB;
constexpr size_t WS_X1 = 1446 * MiB;
constexpr size_t WS_H2 = 1510 * MiB;
constexpr size_t WS_ROUTE = 1542 * MiB;
constexpr size_t WS_XS = 1543 * MiB;
constexpr size_t WS_ACT = 1703 * MiB;
constexpr size_t WS_YB = 1863 * MiB;
constexpr size_t WS_X2 = 2023 * MiB;
constexpr size_t WS_H3 = 2087 * MiB;
constexpr size_t WS_PN = 2119 * MiB;
constexpr size_t WS_PB = 2151 * MiB;
constexpr size_t WS_UB = 2155 * MiB;
constexpr size_t WS_H1F8 = 2103 * MiB;
constexpr size_t WS_WTMG8 = 49 * MiB;
constexpr size_t WS_END = 2187 * MiB;
constexpr int CW_BAR = 4096;
constexpr int CW_CNT = 8192;
constexpr int CW_QUEUE = 12288;
constexpr int CW_LAM = 16384;

constexpr int RING_BYTES = 131072;
constexpr int EX_OFF = 131072;
constexpr int MISC_OFF = 139264 + 1024;
constexpr int LDS_BYTES = 160 * 1024;

struct Frame {
    LAS unsigned char* lds;
    int tid, lane, wave, G, vcu;
    unsigned char* ws;
    const float* in[30];
    float* out;
};

__device__ __forceinline__ void refresh(Frame& F) { int l; asm volatile("v_mbcnt_lo_u32_b32 %0, -1, 0\n\tv_mbcnt_hi_u32_b32 %0, -1, %0" : "=v"(l)); F.lane = l; F.tid = F.wave * 64 + l; }
__device__ __forceinline__ float wave_sum(float v) {
#pragma unroll
    for (int o = 1; o < 64; o <<= 1) v += __shfl_xor(v, o);
    return v;
}
__device__ __forceinline__ float bf2f(unsigned short b) { return __uint_as_float(((unsigned)b) << 16); }
__device__ __forceinline__ float bflo(unsigned w) { return __uint_as_float(w << 16); }
__device__ __forceinline__ float bfhi(unsigned w) { return __uint_as_float(w & 0xffff0000u); }
__device__ __forceinline__ float fast_sigmoid(float x) { return 1.0f / (1.0f + __expf(-x)); }
typedef short v4i16_t __attribute__((ext_vector_type(4)));
__device__ __forceinline__ s16x4 lds_tr16(const LAS unsigned char* p) { return __builtin_bit_cast(s16x4, __builtin_amdgcn_ds_read_tr16_b64_v4i16((LAS v4i16_t*)p)); }
__device__ __forceinline__ bf16x8 cat8(const s16x4 a, const s16x4 b) { bf16x8 r; r[0] = a[0]; r[1] = a[1]; r[2] = a[2]; r[3] = a[3]; r[4] = b[0]; r[5] = b[1]; r[6] = b[2]; r[7] = b[3]; return r; }

__device__ __forceinline__ void p0_tr_load(f32x4 (&v)[16], const float* W, int ldw, int kb, int nb, int lane) {
    const int k0 = 64 * kb, n0 = 64 * nb, lk = lane >> 4, ln = (lane & 15) * 4;
#pragma unroll
    for (int i = 0; i < 16; ++i) v[i] = __builtin_nontemporal_load((const f32x4*)(W + (size_t)(k0 + 4 * i + lk) * ldw + n0 + ln));
}
__device__ __forceinline__ void p0_tr_finish(const f32x4 (&v)[16], int Kdst, bf16_t* WT, size_t row_off, LAS float* scr, int kb, int nb, int lane, bool nostore = false) {
    const int k0 = 64 * kb, n0 = 64 * nb, lk = lane >> 4, ln = (lane & 15) * 4;
#pragma unroll
    for (int i = 0; i < 16; ++i) { LAS float* s = scr + (4 * i + lk) * 65 + ln; s[0] = v[i][0]; s[1] = v[i][1]; s[2] = v[i][2]; s[3] = v[i][3]; }
    LDS_WAIT(); asm volatile("" ::: "memory");
    const int c = lane & 7;
#pragma unroll
    for (int j = 0; j < 8; ++j) { const int n = (lane >> 3) + 8 * j; const LAS float* s = scr + (8 * c) * 65 + n;
        u32x4 o; o.x = cvt_pk_bf16(s[0 * 65], s[1 * 65]); o.y = cvt_pk_bf16(s[2 * 65], s[3 * 65]); o.z = cvt_pk_bf16(s[4 * 65], s[5 * 65]); o.w = cvt_pk_bf16(s[6 * 65], s[7 * 65]);
        if (!nostore || o.x == 0x12345678u) __builtin_nontemporal_store(o, (u32x4*)(WT + (row_off + n0 + n) * (size_t)Kdst + k0 + 8 * c)); }
    LDS_WAIT(); asm volatile("" ::: "memory");
}
constexpr float U8_SCALE = 16.0f, U8_INV = 0.0625f;
constexpr float Y8_SCALE = 8.0f, Y8_INV = 0.125f;
constexpr float W8_SCALE = 32.0f, W8_INV = 1.0f / 32.0f;
__device__ __forceinline__ unsigned pack_fp8x4(float a, float b, float c, float d) {
    a = fminf(fmaxf(a, -448.f), 448.f); b = fminf(fmaxf(b, -448.f), 448.f); c = fminf(fmaxf(c, -448.f), 448.f); d = fminf(fmaxf(d, -448.f), 448.f);
    int w = 0; w = __builtin_amdgcn_cvt_pk_fp8_f32(a, b, w, false); w = __builtin_amdgcn_cvt_pk_fp8_f32(c, d, w, true); return (unsigned)w;
}
__device__ __forceinline__ void p0_tr_finish8(const f32x4 (&v)[16], int Kdst, unsigned char* WT, size_t row_off, LAS float* scr, int kb, int nb, int lane, bool nostore = false) {
    const int k0 = 64 * kb, n0 = 64 * nb, lk = lane >> 4, ln = (lane & 15) * 4;
#pragma unroll
    for (int i = 0; i < 16; ++i) { LAS float* s = scr + (4 * i + lk) * 65 + ln; s[0] = v[i][0]; s[1] = v[i][1]; s[2] = v[i][2]; s[3] = v[i][3]; }
    LDS_WAIT(); asm volatile("" ::: "memory");
    const int c = lane & 7;
#pragma unroll
    for (int j = 0; j < 8; ++j) { const int n = (lane >> 3) + 8 * j; const LAS float* s = scr + (8 * c) * 65 + n;
        u32x2 o; o.x = pack_fp8x4(s[0 * 65] * W8_SCALE, s[1 * 65] * W8_SCALE, s[2 * 65] * W8_SCALE, s[3 * 65] * W8_SCALE); o.y = pack_fp8x4(s[4 * 65] * W8_SCALE, s[5 * 65] * W8_SCALE, s[6 * 65] * W8_SCALE, s[7 * 65] * W8_SCALE);
        if (!nostore || o.x == 0x12345678u) __builtin_nontemporal_store(o, (u32x2*)(WT + (row_off + n0 + n) * (size_t)Kdst + k0 + 8 * c)); }
    LDS_WAIT(); asm volatile("" ::: "memory");
}
__device__ __forceinline__ void p0_transpose_item8(const float* W, int ldw, int Kdst, unsigned char* WT, size_t row_off, LAS float* scr, int kb, int nb, int lane) {
    f32x4 v[16]; p0_tr_load(v, W, ldw, kb, nb, lane); p0_tr_finish8(v, Kdst, WT, row_off, scr, kb, nb, lane);
}
__device__ __forceinline__ void p0_transpose_item(const float* W, int ldw, int Kdst, bf16_t* WT, size_t row_off, LAS float* scr, int kb, int nb, int lane, bool nostore = false) {
    f32x4 v[16]; p0_tr_load(v, W, ldw, kb, nb, lane); p0_tr_finish(v, Kdst, WT, row_off, scr, kb, nb, lane, nostore);
}

__device__ __forceinline__ float log_sigmoid_f(float z) { return fminf(z, 0.f) - __logf(1.0f + __expf(-fabsf(z))); }

__device__ __forceinline__ void p0_chunk_job(Frame& F, int ci) {
    const float* x = F.in[0]; const float* gmix = F.in[18]; const float* w_in = F.in[2];
    const float* w2 = F.in[10]; const float* gb = F.in[11];
    bf16_t* h1 = (bf16_t*)(F.ws + WS_H1); float* bcum = (float*)(F.ws + WS_BCUM);
    LAS float* glr_s = (LAS float*)(F.lds);
    int lane_ = F.lane; asm volatile("" : "+v"(lane_));
    const int t0 = ci * 64, lane = lane_, w = F.wave;
    {
        const float* pin = F.in[1]; bf16_t* pb = (bf16_t*)(F.ws + WS_PB);
#pragma unroll
        for (int r = 0; r < 8; ++r) { const size_t t = (size_t)(t0 + 8 * w + r); const f32x4 pv = *(const f32x4*)(pin + t * PLE + 4 * lane);
            u32x2 o; o.x = cvt_pk_bf16(pv[0], pv[1]); o.y = cvt_pk_bf16(pv[2], pv[3]); *(u32x2*)(pb + t * PLE + 4 * lane) = o; }
    }
    LAS float* wl = (LAS float*)(F.lds + 4096);
    for (int k = F.tid; k < DM; k += 512) { const float gk = gmix[k]; const int slot = (k & 3) * 512 + (k >> 2);
#pragma unroll
        for (int q = 0; q < 4; ++q) { const f32x4 wq = *(const f32x4*)(w_in + (size_t)k * IN_W + IN_MAIN + 4 * q) * gk; *(LAS f32x4*)(wl + slot * 16 + 4 * (q ^ ((slot >> 2) & 3))) = wq; } }
    LDS_WAIT(); __syncthreads();
    {
        f32x4 g[8];
#pragma unroll
        for (int j = 0; j < 8; ++j) g[j] = *(const f32x4*)(gmix + 4 * (lane + 64 * j));
        const int sw = (lane >> 2) & 3;
#pragma unroll 1
        for (int p = 0; p < 4; ++p) {
            f32x4 xv[2][8]; float rs2[2];
#pragma unroll
            for (int r = 0; r < 2; ++r) { const size_t t = (size_t)(t0 + 8 * w + 2 * p + r);
                const float* xrow = x + t * DM + 4 * lane; asm volatile("" : "+v"(xrow));
#pragma unroll
                for (int j = 0; j < 8; ++j) xv[r][j] = *(const f32x4*)(xrow + 256 * j); }
#pragma unroll
            for (int r = 0; r < 2; ++r) { const size_t t = (size_t)(t0 + 8 * w + 2 * p + r); float ss = 0.f;
#pragma unroll
                for (int j = 0; j < 8; ++j) ss += (xv[r][j][0] * xv[r][j][0] + xv[r][j][1] * xv[r][j][1]) + (xv[r][j][2] * xv[r][j][2] + xv[r][j][3] * xv[r][j][3]);
                ss = wave_sum(ss);
                const float rs = rsqrtf(ss * (1.0f / DM) + RMS_EPS); rs2[r] = rs;
                bf16_t* hrow = h1 + t * DM + 4 * lane; unsigned char* frow = F.ws + WS_H1F8 + t * DM + 4 * lane; asm volatile("" : "+v"(hrow), "+v"(frow));
#pragma unroll
                for (int j = 0; j < 8; ++j) { u32x2 o; o.x = cvt_pk_bf16(xv[r][j][0] * rs * g[j][0], xv[r][j][1] * rs * g[j][1]); o.y = cvt_pk_bf16(xv[r][j][2] * rs * g[j][2], xv[r][j][3] * rs * g[j][3]);
                    *(u32x2*)(hrow + 256 * j) = o;
                    *(unsigned*)(frow + 256 * j) = pack_fp8x4(xv[r][j][0] * rs * g[j][0], xv[r][j][1] * rs * g[j][1], xv[r][j][2] * rs * g[j][2], xv[r][j][3] * rs * g[j][3]); }
            }
            float acc[32];
#pragma unroll
            for (int i = 0; i < 32; ++i) acc[i] = 0.f;
            unsigned wb[8];
#pragma unroll
            for (int q = 0; q < 4; ++q) { unsigned b0 = 4096u + (unsigned)lane * 64u + 16u * (unsigned)(q ^ sw); asm volatile("" : "+v"(b0)); wb[q] = b0; unsigned b1 = b0 + 65536u; asm volatile("" : "+v"(b1)); wb[4 + q] = b1; }
#pragma unroll
            for (int j = 0; j < 8; ++j)
#pragma unroll
                for (int c = 0; c < 4; ++c) {
                    f32x4 wv[4];
#pragma unroll
                    for (int q = 0; q < 4; ++q) wv[q] = *(const LAS f32x4*)((const LAS unsigned char*)F.lds + wb[(c >> 1) * 4 + q] + ((c & 1) * 512 + 64 * j) * 64);
#pragma unroll
                    for (int r = 0; r < 2; ++r) { const float xg = xv[r][j][c];
#pragma unroll
                        for (int q = 0; q < 4; ++q) { acc[r * 16 + 4 * q + 0] += xg * wv[q][0]; acc[r * 16 + 4 * q + 1] += xg * wv[q][1]; acc[r * 16 + 4 * q + 2] += xg * wv[q][2]; acc[r * 16 + 4 * q + 3] += xg * wv[q][3]; } }
                    if (c & 1) asm volatile("" ::: "memory");
                }
#pragma unroll
            for (int n = 16, m = 32; n >= 1; n >>= 1, m >>= 1) {
                const bool up = (lane & m) != 0;
#pragma unroll
                for (int i = 0; i < n; ++i) { const float a = acc[i], b = acc[i + n]; const float send = up ? a : b, keep = up ? b : a; acc[i] = keep + __shfl_xor(send, m); }
            }
            acc[0] += __shfl_xor(acc[0], 1);
            const int idx = lane >> 1;
            if ((lane & 1) == 0) glr_s[(8 * w + 2 * p + (idx >> 4)) * 16 + (idx & 15)] = acc[0] * ((idx >> 4) ? rs2[1] : rs2[0]);
        }
    }
    LDS_WAIT(); __syncthreads();
    {
        const int c0 = F.tid, c1 = F.tid + 512;
        float wa[16], wb[16];
#pragma unroll
        for (int j = 0; j < 16; ++j) { wa[j] = w2[j * GL_KW + c0]; wb[j] = w2[j * GL_KW + c1]; }
        const float ba = gb[c0], bb = gb[c1]; float ra = 0.f, rb = 0.f;
        for (int r = 0; r < 64; ++r) {
            float za = ba, zb = bb;
#pragma unroll
            for (int q = 0; q < 4; ++q) { const f32x4 gv = *(const LAS f32x4*)(glr_s + r * 16 + 4 * q);
                za += gv[0] * wa[4 * q] + gv[1] * wa[4 * q + 1] + gv[2] * wa[4 * q + 2] + gv[3] * wa[4 * q + 3];
                zb += gv[0] * wb[4 * q] + gv[1] * wb[4 * q + 1] + gv[2] * wb[4 * q + 2] + gv[3] * wb[4 * q + 3]; }
            ra += log_sigmoid_f(za) * (1.0f / 16.0f); rb += log_sigmoid_f(zb) * (1.0f / 16.0f);
            bcum[(size_t)(t0 + r) * GL_KW + c0] = ra; bcum[(size_t)(t0 + r) * GL_KW + c1] = rb;
        }
    }
    LDS_WAIT(); __syncthreads();
}

__device__ __forceinline__ void p0_prologue(Frame& F, int rep = 0) {
    if (rep != 1) for (int ci = F.vcu; ci < TOK / CHUNK; ci += F.G) p0_chunk_job(F, ci);
    if (F.vcu == F.G - 1 && F.wave == 0) {
        const float* q1 = F.in[5]; const float* k1 = F.in[6]; const float* q2 = F.in[7]; const float* k2 = F.in[8];
        float s1 = q1[F.lane] * k1[F.lane] + q1[F.lane + 64] * k1[F.lane + 64], s2 = q2[F.lane] * k2[F.lane] + q2[F.lane + 64] * k2[F.lane + 64];
        s1 = wave_sum(s1); s2 = wave_sum(s2);
        if (F.lane == 0) { const float lam = expf(s1) - expf(s2) + 0.2f; ((unsigned*)(F.ws + WS_CTL))[CW_LAM] = __float_as_uint(lam); }
    }
    LAS float* scr = (LAS float*)(F.lds + F.wave * 16640);
    const int nch = TOK / CHUNK, ncv = (F.G > nch) ? F.G - nch : F.G;
    const int gw = ((F.G > nch) ? F.vcu - nch : F.vcu) * 8 + F.wave, NGW = ncv * 8;
    constexpr int I0 = 32 * 192, I1 = 32 * 64, I2 = 32 * 32, I6 = 4 * 32;
    constexpr int NITEMS = I0 + I1 + 4 * I2 + I6;
    struct It { const float* W; unsigned char* WT; int ldw, Kdst, kb, nb, f8; };
    auto decode = [&](int r) -> It {
        if (r < I0) return It{F.in[2], F.ws + WS_WTIN, IN_W, DM, r / 192, r % 192, 0}; r -= I0;
        if (r < I1) return It{F.in[15], F.ws + WS_WTMG8, 2 * DM, DM, r / 64, r % 64, 1}; r -= I1;
        if (r < I2) return It{F.in[13], F.ws + WS_WTBR, DM, 2 * DM, r / 32, r % 32, 0}; r -= I2;
        if (r < I2) return It{F.in[14], F.ws + WS_WTBR + 2 * DM, DM, 2 * DM, r / 32, r % 32, 0}; r -= I2;
        if (r < I2) return It{F.in[17], F.ws + WS_WTOUT, DM, DM, r / 32, r % 32, 0}; r -= I2;
        if (r < I2) return It{F.in[27], F.ws + WS_WTPLEG, DM, DM, r / 32, r % 32, 1}; r -= I2;
        return It{F.in[28], F.ws + WS_WTPLEUP, DM, PLE, r / 32, r % 32, 0};
    };
    for (int it = ((gw >= 0 && rep != 2) ? gw : NITEMS); it < NITEMS; it += 2 * NGW) {
        const int it2 = it + NGW; const bool two = it2 < NITEMS;
        const It a = decode(it), b = decode(two ? it2 : it);
        f32x4 va[16], vb[16];
        p0_tr_load(va, a.W, a.ldw, a.kb, a.nb, F.lane); p0_tr_load(vb, b.W, b.ldw, b.kb, b.nb, F.lane);
        if (a.f8) p0_tr_finish8(va, a.Kdst, a.WT, 0, scr, a.kb, a.nb, F.lane); else p0_tr_finish(va, a.Kdst, (bf16_t*)a.WT, 0, scr, a.kb, a.nb, F.lane);
        if (two) { if (b.f8) p0_tr_finish8(vb, b.Kdst, b.WT, 0, scr, b.kb, b.nb, F.lane); else p0_tr_finish(vb, b.Kdst, (bf16_t*)b.WT, 0, scr, b.kb, b.nb, F.lane); }
    }
    LDS_WAIT(); __syncthreads();
}

constexpr int CV_GU = 32 * 32 * 64, CV_DN = 32 * 32 * 32, CV_NIT = CV_GU + CV_DN;
__device__ __forceinline__ void moe_item(int it, const Frame& F, const float*& W, int& ldw, int& Kdst, bf16_t*& WT, size_t& ro, int& kb, int& nb) {
    if (it < CV_GU) { const int e = it / 2048, q = it % 2048; W = F.in[22] + (size_t)e * DM * 2 * DEXP; ldw = 2 * DEXP; Kdst = DM; WT = (bf16_t*)(F.ws + WS_WTGU); ro = (size_t)e * 2 * DEXP; kb = q / 64; nb = q % 64; }
    else { const int r = it - CV_GU, e = r / 1024, q = r % 1024; W = F.in[24] + (size_t)e * DEXP * DM; ldw = DM; Kdst = DEXP; WT = (bf16_t*)(F.ws + WS_WTDN); ro = (size_t)e * DM; kb = q / 32; nb = q % 32; }
}
__device__ __forceinline__ void small_convert(Frame& F, int rank, int nconv) {
    LAS float* scr = (LAS float*)(F.lds + F.wave * 16640);
    const int gw = rank * 8 + F.wave, NGW = nconv * 8;
    for (int it = gw; it < 4 * 1024 + 128; it += NGW) {
        if (it < 1024) p0_transpose_item(F.in[13], DM, 2 * DM, (bf16_t*)(F.ws + WS_WTBR), 0, scr, it / 32, it % 32, F.lane);
        else if (it < 2048) p0_transpose_item(F.in[14], DM, 2 * DM, (bf16_t*)(F.ws + WS_WTBR) + DM, 0, scr, (it - 1024) / 32, it % 32, F.lane);
        else if (it < 3072) p0_transpose_item(F.in[17], DM, DM, (bf16_t*)(F.ws + WS_WTOUT), 0, scr, (it - 2048) / 32, it % 32, F.lane);
        else if (it < 4096) p0_transpose_item(F.in[27], DM, DM, (bf16_t*)(F.ws + WS_WTPLEG), 0, scr, (it - 3072) / 32, it % 32, F.lane);
        else p0_transpose_item(F.in[28], DM, PLE, (bf16_t*)(F.ws + WS_WTPLEUP), 0, scr, (it - 4096) / 32, it % 32, F.lane);
    }
}
__device__ __forceinline__ void moe_convert(Frame& F, int rank, int nconv, int it_lo, int it_hi, bool nostore = false) {
    LAS float* scr = (LAS float*)(F.lds + F.wave * 16640);
    const int gw = rank * 8 + F.wave, NGW = nconv * 8;
    const int NIT = it_hi;
    f32x4 va[16], vb[16];
    const float* W; int ldw, Kdst, kb, nb; bf16_t* WT; size_t ro;
    int it = it_lo + gw;
    if (it < NIT) { moe_item(it, F, W, ldw, Kdst, WT, ro, kb, nb); p0_tr_load(va, W, ldw, kb, nb, F.lane); }
    for (; it < NIT; it += 2 * NGW) {
        const float* W2; int ldw2, Kdst2, kb2, nb2; bf16_t* WT2; size_t ro2;
        const int it2 = it + NGW;
        if (it2 < NIT) { moe_item(it2, F, W2, ldw2, Kdst2, WT2, ro2, kb2, nb2); p0_tr_load(vb, W2, ldw2, kb2, nb2, F.lane); }
        p0_tr_finish8(va, Kdst, (unsigned char*)WT, ro, scr, kb, nb, F.lane, nostore);
        const int it3 = it2 + NGW;
        if (it3 < NIT) { moe_item(it3, F, W, ldw, Kdst, WT, ro, kb, nb); p0_tr_load(va, W, ldw, kb, nb, F.lane); }
        if (it2 < NIT) p0_tr_finish8(vb, Kdst2, (unsigned char*)WT2, ro2, scr, kb2, nb2, F.lane, nostore);
    }
    LDS_WAIT(); __syncthreads();
}

using pg8::Unit;
__device__ __forceinline__ u32x4 pack8(const f32x4 a, const f32x4 b) { u32x4 w; w.x = cvt_pk_bf16(a[0], a[1]); w.y = cvt_pk_bf16(a[2], a[3]); w.z = cvt_pk_bf16(b[0], b[1]); w.w = cvt_pk_bf16(b[2], b[3]); return w; }
__device__ __forceinline__ void unpack8(const u32x4 w, f32x4& a, f32x4& b) { a[0] = bflo(w.x); a[1] = bfhi(w.x); a[2] = bflo(w.y); a[3] = bfhi(w.y); b[0] = bflo(w.z); b[1] = bfhi(w.z); b[2] = bflo(w.w); b[3] = bfhi(w.w); }
__device__ __forceinline__ f32x4 exp4(const f32x4 v) { f32x4 r; r[0] = __expf(v[0]); r[1] = __expf(v[1]); r[2] = __expf(v[2]); r[3] = __expf(v[3]); return r; }
__device__ __forceinline__ f32x4 sig4(const f32x4 v) { f32x4 r; r[0] = fast_sigmoid(v[0]); r[1] = fast_sigmoid(v[1]); r[2] = fast_sigmoid(v[2]); r[3] = fast_sigmoid(v[3]); return r; }

constexpr float QSCALE = 0.08838834764831845f * LOG2E;

struct EpiInProj {
    static constexpr bool PERM = true, AFTER_DRAIN = false, HAS_MID = false;
    bf16_t *q, *k, *v, *gqp, *gqm, *gkp, *gkm, *gv, *sg, *gates;
    const float *gqn, *gkn, *bcum, *bmerge;
    LAS float* ex;
    __device__ __forceinline__ void operator()(const f32x4 (&acc)[2][2][4][2], const Unit& u, int wr, int wc, int fr, int fq) const {
        const int pn = u.pn, cl = wc * 32 + 8 * fq;
        const size_t row0 = (size_t)u.pm * 256 + wr * 64 + fr;
        if (pn < 16) {
#pragma unroll
            for (int ai = 0; ai < 2; ++ai)
#pragma unroll
                for (int m = 0; m < 4; ++m)
#pragma unroll
                    for (int bj = 0; bj < 2; ++bj) {
                        const f32x4 a = acc[ai][bj][m][0], b = acc[ai][bj][m][1];
                        float s = (a[0] * a[0] + a[1] * a[1]) + (a[2] * a[2] + a[3] * a[3]) + (b[0] * b[0] + b[1] * b[1]) + (b[2] * b[2] + b[3] * b[3]);
                        s += __shfl_xor(s, 16); s += __shfl_xor(s, 32);
                        if (fq == 0) ex[((ai * 128 + wr * 64 + m * 16 + fr) * 2 + bj) * 4 + wc] = s;
                    }
            LDS_WAIT(); __builtin_amdgcn_s_barrier(); asm volatile("" ::: "memory");
            const float* gn = (pn < 8) ? gqn : gkn; const float sc = (pn < 8) ? QSCALE : 1.0f;
            const f32x4 g0 = *(const f32x4*)(gn + cl), g1 = *(const f32x4*)(gn + cl + 4);
            bf16_t* base = ((pn < 8) ? q : k) + (pn & 7) * 256 + cl;
#pragma unroll
            for (int ai = 0; ai < 2; ++ai)
#pragma unroll
                for (int m = 0; m < 4; ++m) {
                    const int rl = ai * 128 + wr * 64 + m * 16 + fr;
#pragma unroll
                    for (int bj = 0; bj < 2; ++bj) {
                        const f32x4 p4 = *(const LAS f32x4*)(ex + (rl * 2 + bj) * 4);
                        const float rs = rsqrtf(((p4[0] + p4[1]) + (p4[2] + p4[3])) * (1.0f / 128.0f) + RMS_EPS) * sc;
                        *(u32x4*)(base + (row0 + ai * 128 + m * 16) * DM + bj * 128) = pack8(acc[ai][bj][m][0] * rs * g0, acc[ai][bj][m][1] * rs * g1);
                    }
                }
            return;
        }
        if (pn < 24 || (pn >= 32 && pn < 48)) {
            bf16_t* base = (pn < 24) ? v + (pn - 16) * 256 : (pn < 40 ? gv + (pn - 32) * 256 : sg + (pn - 40) * 256);
            const bool silu = pn >= 40;
            base += cl;
#pragma unroll
            for (int ai = 0; ai < 2; ++ai)
#pragma unroll
                for (int m = 0; m < 4; ++m)
#pragma unroll
                    for (int bj = 0; bj < 2; ++bj) {
                        f32x4 a = acc[ai][bj][m][0], b = acc[ai][bj][m][1];
                        if (silu) { a = a * sig4(a); b = b * sig4(b); }
                        *(u32x4*)(base + (row0 + ai * 128 + m * 16) * DM + bj * 128) = pack8(a, b);
                    }
            return;
        }
        if (pn < 32) {
            const bool isq = pn < 28; const int cg = ((pn - 24) & 3) * 256 + cl;
            bf16_t* bp = (isq ? gqp : gkp) + cg; bf16_t* bm = (isq ? gqm : gkm) + cg; const float sc = isq ? 0.0625f : 1.0f;
#pragma unroll
            for (int ai = 0; ai < 2; ++ai)
#pragma unroll
                for (int m = 0; m < 4; ++m)
#pragma unroll
                    for (int bj = 0; bj < 2; ++bj) {
                        const size_t r = row0 + ai * 128 + m * 16;
                        const f32x4 b0 = *(const f32x4*)(bcum + r * GL_KW + cg + bj * 128), b1 = *(const f32x4*)(bcum + r * GL_KW + cg + bj * 128 + 4);
                        const f32x4 a = acc[ai][bj][m][0] * sc, b = acc[ai][bj][m][1] * sc;
                        *(u32x4*)(bp + r * GL_KW + bj * 128) = pack8(a * exp4(b0), b * exp4(b1));
                        *(u32x4*)(bm + r * GL_KW + bj * 128) = pack8(a * exp4(-b0), b * exp4(-b1));
                    }
            return;
        }
    }
};
struct EpiGates {
    static constexpr bool PERM = true, AFTER_DRAIN = false, HAS_MID = false;
    bf16_t* gates; const float* bmerge;
    __device__ __forceinline__ void operator()(const f32x4 (&acc)[2][2][4][2], const Unit& u, int wr_, int wc_, int fr_, int fq_) const {
        int fr = fr_, fq = fq_, wr = wr_, wc = wc_; asm volatile("" : "+v"(fr), "+v"(fq), "+v"(wr), "+v"(wc));
        const int cg = u.pn * 256 + wc * 32 + 8 * fq;
        const size_t row0 = (size_t)u.pm * 256 + wr * 64 + fr;
#pragma unroll
        for (int bj = 0; bj < 2; ++bj) {
            const f32x4 bb0 = *(const f32x4*)(bmerge + cg + bj * 128), bb1 = *(const f32x4*)(bmerge + cg + bj * 128 + 4);
#pragma unroll
            for (int ai = 0; ai < 2; ++ai)
#pragma unroll
                for (int m = 0; m < 4; ++m)
                    *(u32x4*)(gates + (row0 + ai * 128 + m * 16) * (2 * DM) + cg + bj * 128) = pack8(sig4(acc[ai][bj][m][0] * W8_INV + bb0), sig4(acc[ai][bj][m][1] * W8_INV + bb1));
        }
    }
};

struct EpiMixed2 {
    static constexpr bool PERM = true, AFTER_DRAIN = false, HAS_MID = true;
    const bf16_t* gates; bf16_t* mixed;
    __device__ __forceinline__ void mid(f32x4 (&acc)[2][2][4][2], const Unit& u, int wr, int wc, int fr_, int fq_) const {
        int fr = fr_, fq = fq_; asm volatile("" : "+v"(fr), "+v"(fq));
        const size_t row0 = (size_t)u.pm * 256 + wr * 64 + fr; const int c0 = u.pn * 256 + wc * 32 + 8 * fq;
#pragma unroll
        for (int ai = 0; ai < 2; ++ai)
#pragma unroll
            for (int m = 0; m < 4; ++m)
#pragma unroll
                for (int bj = 0; bj < 2; ++bj) {
                    const size_t r = row0 + ai * 128 + m * 16; const int c = c0 + bj * 128;
                    f32x4 da, db, ga, gb; unpack8(*(const u32x4*)(gates + r * (2 * DM) + c), da, db); unpack8(*(const u32x4*)(gates + r * (2 * DM) + DM + c), ga, gb);
#pragma unroll
                    for (int j = 0; j < 4; ++j) { acc[ai][bj][m][0][j] *= da[j] * __builtin_amdgcn_rcpf(fmaxf(ga[j], 1e-30f)); acc[ai][bj][m][1][j] *= db[j] * __builtin_amdgcn_rcpf(fmaxf(gb[j], 1e-30f)); }
                    asm volatile("" ::: "memory");
                }
    }
    __device__ __forceinline__ void operator()(const f32x4 (&acc)[2][2][4][2], const Unit& u, int wr, int wc, int fr, int fq) const {
        const size_t row0 = (size_t)u.pm * 256 + wr * 64 + fr; const int c0 = u.pn * 256 + wc * 32 + 8 * fq;
#pragma unroll
        for (int ai = 0; ai < 2; ++ai)
#pragma unroll
            for (int m = 0; m < 4; ++m)
#pragma unroll
                for (int bj = 0; bj < 2; ++bj) {
                    const size_t r = row0 + ai * 128 + m * 16; const int c = c0 + bj * 128;
                    f32x4 ga, gb; unpack8(*(const u32x4*)(gates + r * (2 * DM) + DM + c), ga, gb);
#pragma unroll
                    for (int j = 0; j < 4; ++j) { ga[j] = fmaxf(ga[j], 1e-30f); gb[j] = fmaxf(gb[j], 1e-30f); }
                    *(u32x4*)(mixed + r * DM + c) = pack8(acc[ai][bj][m][0] * ga, acc[ai][bj][m][1] * gb);
                }
    }
};
struct EpiX1 {
    static constexpr bool PERM = false, AFTER_DRAIN = false, HAS_MID = false;
    const float* x; float* x1;
    __device__ __forceinline__ void operator()(const f32x4 (&acc)[2][2][4][2], const Unit& u, int wr, int wc, int fr, int fq) const {
        const size_t row0 = (size_t)u.pm * 256 + wr * 64 + fr; const int c0 = u.pn * 256 + wc * 32 + 4 * fq;
#pragma unroll
        for (int ai = 0; ai < 2; ++ai)
#pragma unroll
            for (int m = 0; m < 4; ++m)
#pragma unroll
                for (int bj = 0; bj < 2; ++bj)
#pragma unroll
                    for (int n = 0; n < 2; ++n) { const size_t o = (row0 + ai * 128 + m * 16) * DM + c0 + bj * 128 + n * 16;
                        *(f32x4*)(x1 + o) = *(const f32x4*)(x + o) + acc[ai][bj][m][n]; if (n) asm volatile("" ::: "memory"); }
    }
};
struct EpiOut {
    static constexpr bool PERM = false, AFTER_DRAIN = false, HAS_MID = false;
    const bf16_t* x2; const bf16_t* pnorm; float* out; float sc;
    __device__ __forceinline__ void operator()(const f32x4 (&acc)[2][2][4][2], const Unit& u, int wr, int wc, int fr_, int fq_) const {
        int fr = fr_, fq = fq_; asm volatile("" : "+v"(fr), "+v"(fq));
        const size_t row0 = (size_t)u.pm * 256 + wr * 64 + fr; const int c0 = u.pn * 256 + wc * 32 + 4 * fq;
#pragma unroll
        for (int ai = 0; ai < 2; ++ai)
#pragma unroll
            for (int m = 0; m < 4; ++m)
#pragma unroll
                for (int bj = 0; bj < 2; ++bj)
#pragma unroll
                    for (int n = 0; n < 2; ++n) { const size_t o = (row0 + ai * 128 + m * 16) * DM + c0 + bj * 128 + n * 16;
                        const unsigned pw = *(const unsigned*)((const unsigned char*)pnorm + o); const f32x2 q0 = __builtin_amdgcn_cvt_pk_f32_fp8((int)pw, false), q1 = __builtin_amdgcn_cvt_pk_f32_fp8((int)pw, true);
                        const f32x4 pv = {q0[0], q0[1], q1[0], q1[1]};
                        const u32x2 xw = *(const u32x2*)(x2 + o); f32x4 xv; xv[0] = bflo(xw.x); xv[1] = bfhi(xw.x); xv[2] = bflo(xw.y); xv[3] = bfhi(xw.y);
                        *(f32x4*)(out + o) = xv + pv * sig4(acc[ai][bj][m][n] * sc); asm volatile("" ::: "memory"); }
    }
};
struct EpiGU {
    static constexpr bool PERM = true, AFTER_DRAIN = false, HAS_MID = false;
    const float* bgu; bf16_t* act;
    __device__ __forceinline__ void operator()(const f32x4 (&acc)[2][2][4][2], const Unit& u, int wr, int wc, int fr, int fq) const {
        const size_t row0 = (size_t)u.pm * 256 + wr * 64 + fr; const int e = u.pn >> 4, n16 = u.pn & 15, cl = wc * 32 + 8 * fq;
#pragma unroll
        for (int bj = 0; bj < 2; ++bj) {
            const float* bp = bgu + (size_t)e * (2 * DEXP) + n16 * 256 + bj * 128 + cl;
            const f32x4 b0 = *(const f32x4*)bp, b1 = *(const f32x4*)(bp + 4);
#pragma unroll
            for (int ai = 0; ai < 2; ++ai)
#pragma unroll
                for (int m = 0; m < 4; ++m) {
                    const f32x4 a = acc[ai][bj][m][0] + b0, b = acc[ai][bj][m][1] + b1;
                    float o[4];
#pragma unroll
                    for (int p = 0; p < 4; ++p) { const float gt = fminf(p < 2 ? a[2 * p] : b[2 * p - 4], 7.0f); const float up = fminf(fmaxf(p < 2 ? a[2 * p + 1] : b[2 * p - 3], -7.0f), 7.0f);
                        o[p] = (up + 1.0f) * gt * fast_sigmoid(1.702f * gt); }
                    u32x2 w; w.x = cvt_pk_bf16(o[0], o[1]); w.y = cvt_pk_bf16(o[2], o[3]);
                    *(u32x2*)(act + (row0 + ai * 128 + m * 16) * DEXP + n16 * 128 + bj * 64 + (cl >> 1)) = w;
                }
        }
    }
};
struct EpiGU8 {
    static constexpr bool PERM = true, AFTER_DRAIN = false, HAS_MID = false;
    const float* bgu; unsigned char* act;
    __device__ __forceinline__ void operator()(const f32x4 (&acc)[2][2][4][2], const Unit& u, int wr, int wc, int fr, int fq) const {
        const size_t row0 = (size_t)u.pm * 256 + wr * 64 + fr; const int e = u.pn >> 4, n16 = u.pn & 15, cl = wc * 32 + 8 * fq;
#pragma unroll
        for (int bj = 0; bj < 2; ++bj) {
            const float* bp = bgu + (size_t)e * (2 * DEXP) + n16 * 256 + bj * 128 + cl;
            const f32x4 b0 = *(const f32x4*)bp, b1 = *(const f32x4*)(bp + 4);
#pragma unroll
            for (int ai = 0; ai < 2; ++ai)
#pragma unroll
                for (int m = 0; m < 4; ++m) {
                    const f32x4 a = acc[ai][bj][m][0] * W8_INV + b0, b = acc[ai][bj][m][1] * W8_INV + b1;
                    float o[4];
#pragma unroll
                    for (int p = 0; p < 4; ++p) { const float gt = fminf(p < 2 ? a[2 * p] : b[2 * p - 4], 7.0f); const float up = fminf(fmaxf(p < 2 ? a[2 * p + 1] : b[2 * p - 3], -7.0f), 7.0f);
                        o[p] = (up + 1.0f) * gt * fast_sigmoid(1.702f * gt); }
                    *(unsigned*)(act + (row0 + ai * 128 + m * 16) * DEXP + n16 * 128 + bj * 64 + (cl >> 1)) = pack_fp8x4(o[0], o[1], o[2], o[3]);
                }
        }
    }
};
struct EpiDN8 {
    static constexpr bool PERM = true, AFTER_DRAIN = false, HAS_MID = false;
    const float* bdn; bf16_t* yb;
    __device__ __forceinline__ void operator()(const f32x4 (&acc)[2][2][4][2], const Unit& u, int wr, int wc, int fr, int fq) const {
        const size_t row0 = (size_t)u.pm * 256 + wr * 64 + fr; const int e = u.pn >> 3, n8 = u.pn & 7, cl = wc * 32 + 8 * fq;
#pragma unroll
        for (int bj = 0; bj < 2; ++bj) {
            const int c = n8 * 256 + bj * 128 + cl;
            const f32x4 b0 = *(const f32x4*)(bdn + (size_t)e * DM + c), b1 = *(const f32x4*)(bdn + (size_t)e * DM + c + 4);
#pragma unroll
            for (int ai = 0; ai < 2; ++ai)
#pragma unroll
                for (int m = 0; m < 4; ++m)
                { const f32x4 y0 = (acc[ai][bj][m][0] * W8_INV + b0) * Y8_SCALE, y1 = (acc[ai][bj][m][1] * W8_INV + b1) * Y8_SCALE;
                  u32x2 w8; w8.x = pack_fp8x4(y0[0], y0[1], y0[2], y0[3]); w8.y = pack_fp8x4(y1[0], y1[1], y1[2], y1[3]);
                  *(u32x2*)((unsigned char*)yb + (row0 + ai * 128 + m * 16) * DM + c) = w8; }
        }
    }
};
struct EpiDN {
    static constexpr bool PERM = true, AFTER_DRAIN = false, HAS_MID = false;
    const float* bdn; bf16_t* yb;
    __device__ __forceinline__ void operator()(const f32x4 (&acc)[2][2][4][2], const Unit& u, int wr, int wc, int fr, int fq) const {
        const size_t row0 = (size_t)u.pm * 256 + wr * 64 + fr; const int e = u.pn >> 3, n8 = u.pn & 7, cl = wc * 32 + 8 * fq;
#pragma unroll
        for (int bj = 0; bj < 2; ++bj) {
            const int c = n8 * 256 + bj * 128 + cl;
            const f32x4 b0 = *(const f32x4*)(bdn + (size_t)e * DM + c), b1 = *(const f32x4*)(bdn + (size_t)e * DM + c + 4);
#pragma unroll
            for (int ai = 0; ai < 2; ++ai)
#pragma unroll
                for (int m = 0; m < 4; ++m)
                    *(u32x4*)(yb + (row0 + ai * 128 + m * 16) * DM + c) = pack8(acc[ai][bj][m][0] + b0, acc[ai][bj][m][1] + b1);
        }
    }
};

struct GroupedOrder {
    const LAS int* mtoff;
    int nN, lo, hi, r, step;
    __device__ __forceinline__ void init(const LAS int* mt, int nN_, int G, int c) {
        mtoff = mt; nN = nN_; const int U = mt[32] * nN_;
        if ((G & 7) == 0) { const int per = (U + 7) >> 3, xcd = c & 7; lo = xcd * per; hi = (lo + per < U) ? lo + per : U; r = c >> 3; step = G >> 3; }
        else { lo = 0; hi = U; r = c; step = G; }
    }
    __device__ __forceinline__ bool next(int i, Unit& u) const {
        const int L = lo + i * step + r; if (L >= hi) return false;
        const int ln = (int)__builtin_amdgcn_mbcnt_hi(~0u, __builtin_amdgcn_mbcnt_lo(~0u, 0u)) & 31;
        const unsigned long long bal = __ballot(mtoff[ln] * nN <= L);
        const int e = __builtin_popcount((unsigned)bal) - 1;
        const int mt = mtoff[e + 1] - mtoff[e], rem = L - mtoff[e] * nN, n = rem / mt, m = rem - n * mt;
        u.pm = __builtin_amdgcn_readfirstlane(mtoff[e] + m); u.pn = __builtin_amdgcn_readfirstlane(e * nN + n); u.flags = __builtin_amdgcn_readfirstlane((mtoff[34 + e] - 256 * m <= 128) ? 1 : 0); return true;
    }
    __device__ __forceinline__ void a_ready(const Unit&) const {}
    __device__ __forceinline__ void done(const Unit&) const {}
};

__device__ __forceinline__ bf16x8 pk8(const float a0, const float a1, const float a2, const float a3, const float a4, const float a5, const float a6, const float a7) {
    u32x4 w; w.x = cvt_pk_bf16(a0, a1); w.y = cvt_pk_bf16(a2, a3); w.z = cvt_pk_bf16(a4, a5); w.w = cvt_pk_bf16(a6, a7); return __builtin_bit_cast(bf16x8, w); }
constexpr int ATT_STAGE = 65536, ATT_K1 = 16384, ATT_V = 32768;
constexpr float ATT_THR = 8.0f;

struct AttnOffs { unsigned k, v; };
__device__ __forceinline__ AttnOffs attn_offs(int lane, int w) {
    AttnOffs o;
    { const int key = 4 * w + (lane >> 4), ch = (lane & 15) ^ (key & 7); o.k = (unsigned)(key * DM + ch * 8) * 2u; }
    { const int key = 2 * w + (lane >> 5), ch = (lane & 31) ^ ((key & 3) << 2); o.v = (unsigned)(key * DM + ch * 8) * 2u; }
    return o;
}
__device__ __forceinline__ void attn_issue_tile(const Frame& F, const AttnOffs& ao, const char* kg, const char* vg, int stage) {
    const int w = F.wave;
    unsigned ok = ao.k, ov = ao.v; asm volatile("" : "+v"(ok), "+v"(ov));
#pragma unroll
    for (int c = 0; c < 2; ++c)
#pragma unroll
        for (int i = 0; i < 2; ++i) {
            const char* kp = kg + c * 256 + i * (32 * DM * 2); asm volatile("" : "+s"(kp));
            __builtin_amdgcn_global_load_lds((const unsigned*)(kp + ok), (LAS unsigned*)(F.lds + stage * ATT_STAGE + c * ATT_K1 + (w + 8 * i) * 1024), 16, 0, 0); }
#pragma unroll
    for (int i = 0; i < 4; ++i) {
        const char* vp = vg + i * (16 * DM * 2); asm volatile("" : "+s"(vp));
        __builtin_amdgcn_global_load_lds((const unsigned*)(vp + ov), (LAS unsigned*)(F.lds + stage * ATT_STAGE + ATT_V + (w + 8 * i) * 1024), 16, 0, 0); }
}

__device__ __forceinline__ void attn_unit(const Frame& F, int b, int h, int qb, float lam) {
    const bf16_t* Qg = (const bf16_t*)(F.ws + WS_Q); const bf16_t* Kg = (const bf16_t*)(F.ws + WS_K); const bf16_t* Vg = (const bf16_t*)(F.ws + WS_V);
    bf16_t* Y = (bf16_t*)(F.ws + WS_YCAT);
    int lane; asm volatile("v_mbcnt_lo_u32_b32 %0, -1, 0\n\tv_mbcnt_hi_u32_b32 %0, -1, %0" : "=v"(lane));
    const int w = F.wave, c = w >> 2, r0 = (w & 3) * 32, hi = lane >> 5, ql = lane & 31;
    const int NT = 2 * qb + 2, jlast = 2 * qb + (r0 >> 6);
    const size_t tok0 = (size_t)b * SEQ;
    const char* kbase = (const char*)(Kg + tok0 * DM + h * 256); const char* vbase = (const char*)(Vg + tok0 * DM + h * 256);
    const AttnOffs ao = attn_offs(lane, w);
    bf16x8 qf[8];
    { const char* qbase = (const char*)(Qg + (tok0 + qb * 128 + r0) * DM + h * 256 + c * 128); const unsigned qo = (unsigned)(ql * DM + 8 * hi) * 2u;
#pragma unroll
      for (int st = 0; st < 8; ++st) qf[st] = *(const bf16x8*)(qbase + qo + 32 * st); }
    attn_issue_tile(F, ao, kbase, vbase, 0);
    f32x16 o[8];
#pragma unroll
    for (int d = 0; d < 8; ++d)
#pragma unroll
        for (int r = 0; r < 16; ++r) o[d][r] = 0.f;
    float m_run = -1e30f, l_run = 0.f;
    const float slope = exp2f(-(float)(h + 1)) * LOG2E;
    const float tpos = (float)(qb * 128 + r0 + ql);
    const int kx = (ql & 7) << 4;
    const int koff = ql * 256;
    const int g1 = (lane >> 4) & 1, qq = (lane & 15) >> 2, pp = lane & 3;
    const int voff = (4 * hi + qq) * 512 + 32 * g1 + 16 * (pp >> 1) + 8 * (pp & 1);
    VM_WAIT(); __builtin_amdgcn_s_barrier(); asm volatile("" ::: "memory");
#define ATT_TR(dst, addr, off) asm volatile("ds_read_b64_tr_b16 %0, %1 offset:%2" : "=v"(dst) : "v"(addr), "n"(off))
#define ATT_VLOAD4(buf, A, dd, kh_) do { ATT_TR(buf[0], A, ((dd) >> 2) * 256 + (2 * (kh_)) * 8192); ATT_TR(buf[1], A, ((dd) >> 2) * 256 + (2 * (kh_)) * 8192 + 4096); \
        ATT_TR(buf[2], A, ((dd) >> 2) * 256 + (2 * (kh_) + 1) * 8192); ATT_TR(buf[3], A, ((dd) >> 2) * 256 + (2 * (kh_) + 1) * 8192 + 4096); } while (0)
#define ATT_VLOAD(buf, dd, kh_) do { if (((dd) & 3) == 0) ATT_VLOAD4(buf, va0, dd, kh_); else if (((dd) & 3) == 1) ATT_VLOAD4(buf, va1, dd, kh_); else if (((dd) & 3) == 2) ATT_VLOAD4(buf, va2, dd, kh_); else ATT_VLOAD4(buf, va3, dd, kh_); } while (0)
#define ATT_TILE(j, st_) do { \
        const int jj_ = (j); \
        if (jj_ + 1 < NT) attn_issue_tile(F, ao, kbase + (size_t)(jj_ + 1) * 64 * DM * 2, vbase + (size_t)(jj_ + 1) * 64 * DM * 2, st_ ^ 1); \
        if (jj_ <= jlast) { \
            const LAS unsigned char* Ks = F.lds + st_ * ATT_STAGE + c * ATT_K1; \
            const unsigned vbase = (unsigned)(size_t)(F.lds + st_ * ATT_STAGE + ATT_V) + (unsigned)voff; \
            const unsigned va0 = vbase + ((0 ^ qq) << 6), va1 = vbase + ((1 ^ qq) << 6), va2 = vbase + ((2 ^ qq) << 6), va3 = vbase + ((3 ^ qq) << 6); \
_Pragma("unroll") \
            for (int kh = 0; kh < 2; ++kh) {                            \
                f32x16 p0; \
_Pragma("unroll") \
                for (int r = 0; r < 16; ++r) p0[r] = 0.f; \
bf16x8 kf[4], kg_[4]; \
_Pragma("unroll") \
                for (int st = 0; st < 4; ++st) { const int co = ((2 * st + hi) << 4) ^ kx; kf[st] = *(const LAS bf16x8*)(Ks + kh * 8192 + koff + co); } \
                __builtin_amdgcn_sched_barrier(0); \
_Pragma("unroll") \
                for (int st = 0; st < 4; ++st) { const int co = ((2 * (st + 4) + hi) << 4) ^ kx; kg_[st] = *(const LAS bf16x8*)(Ks + kh * 8192 + koff + co); } \
_Pragma("unroll") \
                for (int st = 0; st < 4; ++st) p0 = __builtin_amdgcn_mfma_f32_32x32x16_bf16(kf[st], qf[st], p0, 0, 0, 0); \
                __builtin_amdgcn_sched_barrier(0); \
_Pragma("unroll") \
                for (int st = 0; st < 4; ++st) p0 = __builtin_amdgcn_mfma_f32_32x32x16_bf16(kg_[st], qf[st + 4], p0, 0, 0, 0); \
                __builtin_amdgcn_sched_barrier(0); \
                 \
                const float dq = tpos - (float)(64 * jj_ + 32 * kh + 4 * hi); \
                float mx = -1e30f; \
_Pragma("unroll") \
                for (int r = 0; r < 16; ++r) { const float cr = (float)((r & 3) + 8 * (r >> 2)); \
                    p0[r] = fmaf(-slope, fabsf(dq - cr), p0[r]); mx = fmaxf(mx, p0[r]); } \
                { auto rr_ = __builtin_amdgcn_permlane32_swap(__float_as_uint(mx), __float_as_uint(mx), false, false); mx = fmaxf(__uint_as_float(rr_[0]), __uint_as_float(rr_[1])); } \
                if (!__all(mx - m_run <= ATT_THR)) { \
                    const float mn = fmaxf(m_run, mx), al = __builtin_amdgcn_exp2f(m_run - mn); m_run = mn; l_run *= al; \
_Pragma("unroll") \
                    for (int d = 0; d < 8; ++d) \
_Pragma("unroll") \
                        for (int r = 0; r < 16; ++r) o[d][r] *= al; \
                } \
                float ps = 0.f; \
_Pragma("unroll") \
                for (int r = 0; r < 16; ++r) { p0[r] = __builtin_amdgcn_exp2f(p0[r] - m_run); ps += p0[r]; } \
                l_run += ps; \
                bf16x8 pf[2]; \
                pf[0] = pk8(p0[0], p0[1], p0[2], p0[3], p0[4], p0[5], p0[6], p0[7]); pf[1] = pk8(p0[8], p0[9], p0[10], p0[11], p0[12], p0[13], p0[14], p0[15]); \
                __builtin_amdgcn_sched_barrier(0); \
{ u32x2 vb[4][4]; \
                  ATT_VLOAD(vb[0], 0, kh); ATT_VLOAD(vb[1], 1, kh); ATT_VLOAD(vb[2], 2, kh); \
_Pragma("unroll") \
                  for (int d = 0; d < 8; ++d) { \
                    if (d < 5) { ATT_VLOAD(vb[(d + 3) & 3], d + 3, kh); asm volatile("s_waitcnt lgkmcnt(12)" ::: "memory"); } \
                    else if (d == 5) asm volatile("s_waitcnt lgkmcnt(8)" ::: "memory"); \
                    else if (d == 6) asm volatile("s_waitcnt lgkmcnt(4)" ::: "memory"); \
                    else asm volatile("s_waitcnt lgkmcnt(0)" ::: "memory"); \
                    __builtin_amdgcn_sched_barrier(0); \
                    { u32x4 w0, w1; w0.x = vb[d & 3][0].x; w0.y = vb[d & 3][0].y; w0.z = vb[d & 3][1].x; w0.w = vb[d & 3][1].y; w1.x = vb[d & 3][2].x; w1.y = vb[d & 3][2].y; w1.z = vb[d & 3][3].x; w1.w = vb[d & 3][3].y; \
                      o[d] = __builtin_amdgcn_mfma_f32_32x32x16_bf16(__builtin_bit_cast(bf16x8, w0), pf[0], o[d], 0, 0, 0); \
                      o[d] = __builtin_amdgcn_mfma_f32_32x32x16_bf16(__builtin_bit_cast(bf16x8, w1), pf[1], o[d], 0, 0, 0); } \
                    __builtin_amdgcn_sched_barrier(0); \
                  } } \
            } \
        } \
        VM_WAIT(); LDS_WAIT(); __builtin_amdgcn_s_barrier(); asm volatile("" ::: "memory"); \
    } while (0)
    for (int j = 0; j < NT; j += 2) { ATT_TILE(j, 0); ATT_TILE(j + 1, 1); }
#undef ATT_TILE
#undef ATT_VLOAD
#undef ATT_VLOAD4
#undef ATT_TR
    const float linv = 1.0f / (l_run + __shfl_xor(l_run, 32));
    LAS float* X = (LAS float*)F.lds + (size_t)(w & 3) * 128 * 64 + lane;
    if (c == 1) {
#pragma unroll
        for (int d = 0; d < 8; ++d)
#pragma unroll
            for (int r = 0; r < 16; ++r) X[(d * 16 + r) * 64] = o[d][r] * linv;
    }
    LDS_WAIT(); __builtin_amdgcn_s_barrier(); asm volatile("" ::: "memory");
    if (c == 0) {
        float ss = 0.f;
#pragma unroll
        for (int d = 0; d < 8; ++d) {
#pragma unroll
            for (int r = 0; r < 16; ++r) { const float v = o[d][r] * linv - lam * X[(d * 16 + r) * 64]; o[d][r] = v; ss += v * v; }
            asm volatile("" ::: "memory"); }
        ss += __shfl_xor(ss, 32);
        const float rs = rsqrtf(ss * (1.0f / 256.0f) + RMS_EPS) * 0.8f;
        const float* sg = F.in[9];
        bf16_t* yp = (bf16_t*)((char*)(Y + (tok0 + qb * 128 + r0) * (2 * DM) + h * 256) + (unsigned)(ql * (2 * DM) + 4 * hi) * 2u);
#pragma unroll
        for (int d = 0; d < 8; ++d) {
            asm volatile("" ::: "memory");
#pragma unroll
            for (int r4 = 0; r4 < 4; ++r4) { const int dv = 32 * d + 8 * r4; const f32x4 g = *(const f32x4*)(sg + dv + 4 * hi);
                u32x2 wv; wv.x = cvt_pk_bf16(o[d][4 * r4] * rs * g[0], o[d][4 * r4 + 1] * rs * g[1]); wv.y = cvt_pk_bf16(o[d][4 * r4 + 2] * rs * g[2], o[d][4 * r4 + 3] * rs * g[3]);
                *(u32x2*)(yp + dv) = wv; }
        }
    }
    LDS_WAIT(); __builtin_amdgcn_s_barrier(); asm volatile("" ::: "memory");
}

__device__ __forceinline__ void gla_scores_phase(const Frame& F) {
    const bf16_t* qp = (const bf16_t*)(F.ws + WS_GQP); const bf16_t* qm = (const bf16_t*)(F.ws + WS_GQM);
    const bf16_t* kp = (const bf16_t*)(F.ws + WS_GKP); const bf16_t* km = (const bf16_t*)(F.ws + WS_GKM);
    bf16_t* attc = (bf16_t*)(F.ws + WS_ATTC);
    LAS float* tmp = (LAS float*)F.lds;
    const int lane = F.lane, w = F.wave, which = w >> 2, mi = (w >> 1) & 1, si = w & 1, hi = lane >> 5, l31 = lane & 31;
    for (int unit = blockIdx.x; unit < NB * GL_H * NCH; unit += F.G) {
        const int b = unit >> 8, h = (unit >> 6) & 3, ch = unit & 63;
        const size_t t0 = (size_t)b * SEQ + ch * 64;
        const bf16_t* A = (which ? qm : qp) + (t0 + 32 * mi + l31) * GL_KW + h * 256 + 8 * hi;
        const bf16_t* Bm = (which ? kp : km) + (t0 + 32 * si + l31) * GL_KW + h * 256 + 8 * hi;
        f32x16 acc;
#pragma unroll
        for (int r = 0; r < 16; ++r) acc[r] = 0.f;
#pragma unroll
        for (int st = 0; st < 16; ++st) acc = __builtin_amdgcn_mfma_f32_32x32x16_bf16(*(const bf16x8*)(A + 16 * st), *(const bf16x8*)(Bm + 16 * st), acc, 0, 0, 0);
        const int s = 32 * si + l31;
#pragma unroll
        for (int r = 0; r < 16; ++r) { const int t = 32 * mi + (r & 3) + 8 * (r >> 2) + 4 * hi; const bool keep = which ? (s > t) : (s <= t); acc[r] = keep ? acc[r] : 0.f; }
        if (which) {
#pragma unroll
            for (int r = 0; r < 16; ++r) { const int t = 32 * mi + (r & 3) + 8 * (r >> 2) + 4 * hi; tmp[t * 64 + s] = acc[r]; }
        }
        LDS_WAIT(); __syncthreads();
        if (!which) {
#pragma unroll
            for (int r = 0; r < 16; ++r) { const int t = 32 * mi + (r & 3) + 8 * (r >> 2) + 4 * hi; const float v = acc[r] + tmp[t * 64 + s];
                attc[((size_t)unit * 64 + t) * 64 + s] = (bf16_t)(cvt_pk_bf16(v, 0.f) & 0xffffu); }
        }
        LDS_WAIT(); __syncthreads();
    }
}

constexpr int GL_KST = 544, GL_AST = 144, GL_VST = 272;
constexpr int GL_KM = 0, GL_QP = 64 * GL_KST, GL_AT = 2 * 64 * GL_KST, GL_VV = GL_AT + 64 * GL_AST, GL_DEC = GL_VV + 64 * GL_VST;
__device__ __forceinline__ void gla_scan_unit(const Frame& F, int g) {
    const int b = g >> 4, h = (g >> 2) & 3, vg = g & 3;
    const bf16_t* qp = (const bf16_t*)(F.ws + WS_GQP); const bf16_t* km = (const bf16_t*)(F.ws + WS_GKM);
    const bf16_t* gv = (const bf16_t*)(F.ws + WS_GV); const bf16_t* attc = (const bf16_t*)(F.ws + WS_ATTC);
    const float* bcum = (const float*)(F.ws + WS_BCUM); float* og = (float*)(F.ws + WS_OGLA);
    const int tid = F.tid, lane = F.lane, w = F.wave, gq = lane >> 4, li = lane & 15, q4 = li >> 2, p4 = li & 3;
    f32x4 S[16];
#pragma unroll
    for (int i = 0; i < 16; ++i) S[i] = (f32x4){0.f, 0.f, 0.f, 0.f};
    u32x4 rk[4], rq[4], ra, rv[2]; float rdec = 0.f;
    const size_t tb0 = (size_t)b * SEQ;
#define GLA_LOAD(c) do { const size_t t0_ = tb0 + (size_t)(c) * 64; \
        _Pragma("unroll") for (int i = 0; i < 4; ++i) { const int idx = tid + 512 * i, row = idx >> 5, cc = idx & 31; \
            rk[i] = *(const u32x4*)(km + (t0_ + row) * GL_KW + h * 256 + cc * 8); rq[i] = *(const u32x4*)(qp + (t0_ + row) * GL_KW + h * 256 + cc * 8); } \
        ra = *(const u32x4*)(attc + ((size_t)((b * GL_H + h) * NCH + (c)) * 64 + (tid >> 3)) * 64 + (tid & 7) * 8); \
        _Pragma("unroll") for (int i = 0; i < 2; ++i) { const int idx = tid + 512 * i, row = idx >> 4, cc = idx & 15; \
            rv[i] = *(const u32x4*)(gv + (t0_ + row) * GL_VW + h * 512 + vg * 128 + cc * 8); } \
        if (tid < 256) rdec = bcum[(t0_ + 63) * GL_KW + h * 256 + tid]; } while (0)
    GLA_LOAD(0);
    for (int c = 0; c < NCH; ++c) {
        __syncthreads();
#pragma unroll
        for (int i = 0; i < 4; ++i) { const int idx = tid + 512 * i, row = idx >> 5, cc = idx & 31;
            *(LAS u32x4*)(F.lds + GL_KM + row * GL_KST + cc * 16) = rk[i]; *(LAS u32x4*)(F.lds + GL_QP + row * GL_KST + cc * 16) = rq[i]; }
        *(LAS u32x4*)(F.lds + GL_AT + (tid >> 3) * GL_AST + (tid & 7) * 16) = ra;
#pragma unroll
        for (int i = 0; i < 2; ++i) { const int idx = tid + 512 * i, row = idx >> 4, cc = idx & 15; *(LAS u32x4*)(F.lds + GL_VV + row * GL_VST + cc * 16) = rv[i]; }
        if (tid < 256) *(LAS float*)(F.lds + GL_DEC + tid * 4) = __expf(rdec);
        LDS_WAIT(); __syncthreads();
        if (c + 1 < NCH) GLA_LOAD(c + 1);
        const size_t t0 = tb0 + (size_t)c * 64;
        bf16x8 bv[2];
#pragma unroll
        for (int st = 0; st < 2; ++st) { const LAS unsigned char* p = F.lds + GL_VV + (32 * st + 8 * gq + q4) * GL_VST + (16 * w + 4 * p4) * 2;
            bv[st] = cat8(lds_tr16(p), lds_tr16(p + 4 * GL_VST)); }
        bf16x8 af[2][4];
#pragma unroll
        for (int st = 0; st < 2; ++st)
#pragma unroll
            for (int tb = 0; tb < 4; ++tb) af[st][tb] = *(const LAS bf16x8*)(F.lds + GL_AT + (16 * tb + li) * GL_AST + (32 * st + 8 * gq) * 2);
        f32x4 o[4];
#pragma unroll
        for (int tb = 0; tb < 4; ++tb) o[tb] = (f32x4){0.f, 0.f, 0.f, 0.f};
        u32x4 qa[2][4];
#define GLA_LOADQ(buf, ks_) do { _Pragma("unroll") for (int tb = 0; tb < 4; ++tb) { const LAS unsigned char* p = F.lds + GL_QP + (16 * tb + li) * GL_KST + (32 * (ks_) + 4 * gq) * 2; \
            const u32x2 a0 = *(const LAS u32x2*)p, a1 = *(const LAS u32x2*)(p + 32); buf[tb].x = a0.x; buf[tb].y = a0.y; buf[tb].z = a1.x; buf[tb].w = a1.y; } } while (0)
        GLA_LOADQ(qa[0], 0);
#pragma unroll
        for (int ks = 0; ks < 8; ++ks) {
            if (ks < 7) GLA_LOADQ(qa[(ks + 1) & 1], ks + 1);
            __builtin_amdgcn_sched_barrier(0);
            const bf16x8 sb = pk8(S[2 * ks][0], S[2 * ks][1], S[2 * ks][2], S[2 * ks][3], S[2 * ks + 1][0], S[2 * ks + 1][1], S[2 * ks + 1][2], S[2 * ks + 1][3]);
#pragma unroll
            for (int tb = 0; tb < 4; ++tb) o[tb] = __builtin_amdgcn_mfma_f32_16x16x32_bf16(__builtin_bit_cast(bf16x8, qa[ks & 1][tb]), sb, o[tb], 0, 0, 0);
            __builtin_amdgcn_sched_barrier(0);
        }
#undef GLA_LOADQ
#pragma unroll
        for (int st = 0; st < 2; ++st)
#pragma unroll
            for (int tb = 0; tb < 4; ++tb) o[tb] = __builtin_amdgcn_mfma_f32_16x16x32_bf16(af[st][tb], bv[st], o[tb], 0, 0, 0);
#pragma unroll
        for (int tb = 0; tb < 4; ++tb)
#pragma unroll
            for (int r = 0; r < 4; ++r) og[(t0 + 16 * tb + 4 * gq + r) * GL_VW + h * 512 + vg * 128 + 16 * w + li] = o[tb][r];
        bf16x8 ak[2][2];
#define GLA_LOADK(buf, kb_) do { _Pragma("unroll") for (int st = 0; st < 2; ++st) { const LAS unsigned char* p = F.lds + GL_KM + (32 * st + 8 * gq + q4) * GL_KST + (16 * (kb_) + 4 * p4) * 2; \
            buf[st] = cat8(lds_tr16(p), lds_tr16(p + 4 * GL_KST)); } } while (0)
        GLA_LOADK(ak[0], 0);
#pragma unroll
        for (int kb = 0; kb < 16; ++kb) {
            if (kb < 15) GLA_LOADK(ak[(kb + 1) & 1], kb + 1);
            const f32x4 d = *(const LAS f32x4*)(F.lds + GL_DEC + (16 * kb + 4 * gq) * 4);
            __builtin_amdgcn_sched_barrier(0);
            S[kb] = __builtin_amdgcn_mfma_f32_16x16x32_bf16(ak[kb & 1][0], bv[0], S[kb], 0, 0, 0);
            S[kb] = __builtin_amdgcn_mfma_f32_16x16x32_bf16(ak[kb & 1][1], bv[1], S[kb], 0, 0, 0);
            S[kb] = S[kb] * d;
            __builtin_amdgcn_sched_barrier(0);
        }
#undef GLA_LOADK
    }
#undef GLA_LOAD
    __syncthreads();
}

__device__ __forceinline__ void gla_out_phase(const Frame& F) {
    const float* og = (const float*)(F.ws + WS_OGLA); const bf16_t* sg = (const bf16_t*)(F.ws + WS_SG); bf16_t* yg = (bf16_t*)(F.ws + WS_YCAT) + DM;
    const float* gn = F.in[12];
    const int gw = blockIdx.x * 8 + F.wave, NGW = F.G * 8, lane = F.lane;
    const f32x4 g0 = *(const f32x4*)(gn + 8 * lane), g1 = *(const f32x4*)(gn + 8 * lane + 4);
    for (int rw = gw; rw < TOK * GL_H; rw += NGW) {
        const size_t off = (size_t)rw * 512 + 8 * lane;
        const f32x4 a = *(const f32x4*)(og + off), b = *(const f32x4*)(og + off + 4);
        float ss = (a[0] * a[0] + a[1] * a[1]) + (a[2] * a[2] + a[3] * a[3]) + (b[0] * b[0] + b[1] * b[1]) + (b[2] * b[2] + b[3] * b[3]);
        ss = wave_sum(ss);
        const float rs = rsqrtf(ss * (1.0f / 512.0f) + RMS_EPS);
        f32x4 sa, sb; unpack8(*(const u32x4*)(sg + off), sa, sb);
        *(u32x4*)(yg + (size_t)(rw >> 2) * (2 * DM) + (rw & 3) * 512 + 8 * lane) = pack8(a * rs * g0 * sa, b * rs * g1 * sb);
    }
}

__device__ __forceinline__ void route_phase(const Frame& F, int rep) {
    const float* x1 = (const float*)(F.ws + WS_X1); const float* gf = F.in[19]; const float* wr = F.in[20]; const float* rb = F.in[21];
    bf16_t* h2 = (bf16_t*)(F.ws + WS_H2);
    int* topi = (int*)(F.ws + WS_ROUTE + rep * 524288); float* gate = (float*)(F.ws + WS_ROUTE + 131072 + rep * 524288); int* posn = (int*)(F.ws + WS_ROUTE + 262144 + rep * 524288);
    unsigned* cnt = (unsigned*)(F.ws + WS_CTL) + CW_CNT + rep * 2048;
    const int lane = F.lane, gw = blockIdx.x * 8 + F.wave, NGW = F.G * 8, e = lane & 31, hf = lane >> 5;
    LAS float* wsh = (LAS float*)(F.lds);
    for (int base = blockIdx.x * 8; base < TOK / 4; base += NGW) {
        const int gp = base + F.wave;
        float lg[4];
        f32x4 xv[4][8];
#pragma unroll
        for (int i = 0; i < 4; ++i) { const float* xrow = x1 + (size_t)(4 * gp + i) * DM + 4 * lane;
#pragma unroll
            for (int j = 0; j < 8; ++j) xv[i][j] = *(const f32x4*)(xrow + 256 * j); }
#pragma unroll
        for (int i = 0; i < 4; ++i) { float ss = 0.f;
#pragma unroll
            for (int j = 0; j < 8; ++j) ss += (xv[i][j][0] * xv[i][j][0] + xv[i][j][1] * xv[i][j][1]) + (xv[i][j][2] * xv[i][j][2] + xv[i][j][3] * xv[i][j][3]);
            ss = wave_sum(ss);
            const float rs = rsqrtf(ss * (1.0f / DM) + RMS_EPS);
            unsigned char* hrow = (unsigned char*)h2 + (size_t)(4 * gp + i) * DM + 4 * lane; const float* gfl = gf + 4 * lane; asm volatile("" : "+v"(hrow), "+v"(gfl));
#pragma unroll
            for (int j = 0; j < 8; ++j) { const f32x4 g = *(const f32x4*)(gfl + 256 * j); const f32x4 hv = xv[i][j] * rs * g; xv[i][j] = hv;
                *(unsigned*)(hrow + 256 * j) = pack_fp8x4(hv[0], hv[1], hv[2], hv[3]); }
        }
        f32x4 acc[2][2];
#pragma unroll
        for (int tg = 0; tg < 2; ++tg)
#pragma unroll
            for (int eg = 0; eg < 2; ++eg) acc[tg][eg] = (f32x4){0.f, 0.f, 0.f, 0.f};
        LAS float* hsm = (LAS float*)(F.lds + 65536);
        f32x4 wreg[8];
        { const float* wb = wr + 4 * F.tid; asm volatile("" : "+v"(wb));
#pragma unroll
        for (int m = 0; m < 8; ++m) wreg[m] = *(const f32x4*)(wb + 2048 * m); }
#pragma unroll
        for (int wd = 0; wd < 4; ++wd) {
            __syncthreads();
#pragma unroll
            for (int m = 0; m < 8; ++m) *(LAS f32x4*)(wsh + 4 * (F.tid + 512 * m)) = wreg[m];
            if (wd < 3) { const float* wb = wr + (size_t)(512 * (wd + 1)) * NEXP + 4 * F.tid; asm volatile("" : "+v"(wb));
#pragma unroll
                for (int m = 0; m < 8; ++m) wreg[m] = *(const f32x4*)(wb + 2048 * m); }
#pragma unroll
            for (int i = 0; i < 4; ++i)
#pragma unroll
                for (int jj = 0; jj < 2; ++jj) *(LAS f32x4*)(hsm + (4 * F.wave + i) * 516 + 4 * (lane + 64 * jj)) = xv[i][2 * wd + jj];
            LDS_WAIT(); __syncthreads();
            const LAS float* ap = hsm + (lane & 15) * 516 + 64 * F.wave + (lane >> 4);
            const LAS float* bp = wsh + (64 * F.wave + (lane >> 4)) * NEXP + (lane & 15);
#pragma unroll 4
            for (int ks = 0; ks < 16; ++ks) {
                const float a0 = ap[4 * ks], a1 = ap[16 * 516 + 4 * ks], b0 = bp[4 * ks * NEXP], b1 = bp[4 * ks * NEXP + 16];
                acc[0][0] = __builtin_amdgcn_mfma_f32_16x16x4f32(a0, b0, acc[0][0], 0, 0, 0); acc[0][1] = __builtin_amdgcn_mfma_f32_16x16x4f32(a0, b1, acc[0][1], 0, 0, 0);
                acc[1][0] = __builtin_amdgcn_mfma_f32_16x16x4f32(a1, b0, acc[1][0], 0, 0, 0); acc[1][1] = __builtin_amdgcn_mfma_f32_16x16x4f32(a1, b1, acc[1][1], 0, 0, 0);
            }
        }
        __syncthreads();
#pragma unroll
        for (int tg = 0; tg < 2; ++tg)
#pragma unroll
            for (int eg = 0; eg < 2; ++eg)
#pragma unroll
                for (int r = 0; r < 4; ++r) wsh[F.wave * 1024 + (16 * tg + 4 * (lane >> 4) + r) * 32 + 16 * eg + (lane & 15)] = acc[tg][eg][r];
        LDS_WAIT(); __syncthreads();
#pragma unroll
        for (int i = 0; i < 4; ++i) { float sum = 0.f;
#pragma unroll
            for (int w8 = 0; w8 < 8; ++w8) sum += wsh[w8 * 1024 + (4 * F.wave + i) * 32 + e];
            lg[i] = sum; }
        LAS unsigned* lc = (LAS unsigned*)(F.lds + 133120);
        if (F.tid < 32) lc[F.tid] = 0u;
        LDS_WAIT(); __syncthreads();
        int lr[2][4];
#pragma unroll
        for (int rd = 0; rd < 2; ++rd) {
            const size_t t = (size_t)(4 * gp + 2 * hf + rd);
            float v = (hf ? lg[2 + rd] : lg[rd]) + rb[e];
            float selv[4]; int sele[4];
#pragma unroll
            for (int k = 0; k < TOPK; ++k) {
                float mx = v;
#pragma unroll
                for (int o = 1; o < 32; o <<= 1) mx = fmaxf(mx, __shfl_xor(mx, o));
                int idx = (v == mx) ? e : 64;
#pragma unroll
                for (int o = 1; o < 32; o <<= 1) idx = min(idx, __shfl_xor(idx, o));
                selv[k] = mx; sele[k] = idx;
                if (e == idx) v = -__builtin_inff();
            }
            const float e1 = __expf(selv[1] - selv[0]), e2 = __expf(selv[2] - selv[0]), e3 = __expf(selv[3] - selv[0]);
            const float inv = 1.0f / (1.0f + e1 + e2 + e3);
            const float gk[4] = {inv, e1 * inv, e2 * inv, e3 * inv};
#pragma unroll
            for (int k = 0; k < TOPK; ++k)
                if (e == sele[k]) { lr[rd][k] = (int)__hip_atomic_fetch_add(lc + e, 1u, __ATOMIC_RELAXED, __HIP_MEMORY_SCOPE_WORKGROUP); topi[t * 4 + k] = e; gate[t * 4 + k] = gk[k]; }
                else lr[rd][k] = -1;
        }
        LDS_WAIT(); __syncthreads();
        if (F.tid < 32) { const unsigned n = lc[F.tid]; lc[32 + F.tid] = n ? __hip_atomic_fetch_add(cnt + 64 * F.tid, n, RLX_AGENT) : 0u; }
        LDS_WAIT(); __syncthreads();
        const int rbase = (int)lc[32 + e];
#pragma unroll
        for (int rd = 0; rd < 2; ++rd)
#pragma unroll
            for (int k = 0; k < TOPK; ++k) if (lr[rd][k] >= 0) posn[(size_t)(4 * gp + 2 * hf + rd) * 4 + k] = rbase + lr[rd][k];
    }
}

__device__ __forceinline__ void build_mtoff(const Frame& F, LAS int* mt) {
    const unsigned* cnt = (const unsigned*)(F.ws + WS_CTL) + CW_CNT;
    if (F.wave == 0) {
        const int e = F.lane & 31;
        const unsigned c = __hip_atomic_load(cnt + 64 * e, RLX_AGENT);
        const int nt_ = (int)((c + 255u) >> 8); int incl = nt_;
#pragma unroll
        for (int o = 1; o < 32; o <<= 1) { const int v = __shfl_up(incl, o, 32); if (e >= o) incl += v; }
        if (F.lane < 32) { mt[e] = incl - nt_; mt[34 + e] = (int)c; if (e == 31) mt[NEXP] = incl; }
    }
    LDS_WAIT(); __syncthreads();
}

__device__ __forceinline__ void scatter_phase(const Frame& F, const LAS int* mt) {
    const bf16_t* h2 = (const bf16_t*)(F.ws + WS_H2); bf16_t* xs = (bf16_t*)(F.ws + WS_XS);
    const int* topi = (const int*)(F.ws + WS_ROUTE); const int* posn = (const int*)(F.ws + WS_ROUTE + 262144); int* rowof = (int*)(F.ws + WS_ROUTE + 393216);
    const int lane = F.lane, gw = blockIdx.x * 8 + F.wave, NGW = F.G * 8;
    for (int pi = gw; pi < TOK * TOPK; pi += NGW) {
        const int e = topi[pi], dest = 256 * mt[e] + posn[pi], t = pi >> 2;
        if (lane == 0) rowof[pi] = dest;
#pragma unroll
        for (int j = 0; j < 2; ++j) *(u32x4*)((unsigned char*)xs + (size_t)dest * DM + 16 * (lane + 64 * j)) = *(const u32x4*)((const unsigned char*)h2 + (size_t)t * DM + 16 * (lane + 64 * j));
    }
}

__device__ __forceinline__ void combine_phase(const Frame& F) {
    const float* x1 = (const float*)(F.ws + WS_X1); const bf16_t* yb = (const bf16_t*)(F.ws + WS_YB); float* x2 = (float*)(F.ws + WS_X2);
    bf16_t* h3 = (bf16_t*)(F.ws + WS_H3); const bf16_t* ub = (const bf16_t*)(F.ws + WS_UB); bf16_t* pnb = (bf16_t*)(F.ws + WS_PN);
    const float* gate = (const float*)(F.ws + WS_ROUTE + 131072); const int* rowof = (const int*)(F.ws + WS_ROUTE + 393216);
    const float* gp = F.in[26]; const float* gpost = F.in[29];
    const int lane = F.lane, gw = blockIdx.x * 8 + F.wave, NGW = F.G * 8;
    for (int t = gw; t < TOK; t += NGW) {
        f32x4 xa[4], xb[4];
#pragma unroll
        for (int j = 0; j < 4; ++j) { xa[j] = *(const f32x4*)(x1 + (size_t)t * DM + 8 * (lane + 64 * j)); xb[j] = *(const f32x4*)(x1 + (size_t)t * DM + 8 * (lane + 64 * j) + 4); }
#pragma unroll
        for (int k = 0; k < TOPK; ++k) { const float g = gate[t * 4 + k] * Y8_INV; const size_t r = (size_t)rowof[t * 4 + k];
#pragma unroll
            for (int j = 0; j < 4; ++j) { const u32x2 w8 = *(const u32x2*)((const unsigned char*)yb + r * DM + 8 * (lane + 64 * j));
                const f32x2 p0 = __builtin_amdgcn_cvt_pk_f32_fp8((int)w8.x, false), p1 = __builtin_amdgcn_cvt_pk_f32_fp8((int)w8.x, true), p2 = __builtin_amdgcn_cvt_pk_f32_fp8((int)w8.y, false), p3 = __builtin_amdgcn_cvt_pk_f32_fp8((int)w8.y, true);
                const f32x4 ya = {p0[0], p0[1], p1[0], p1[1]}, ybv = {p2[0], p2[1], p3[0], p3[1]}; xa[j] += g * ya; xb[j] += g * ybv; } }
        float ss = 0.f;
#pragma unroll
        for (int j = 0; j < 4; ++j) { *(u32x4*)((bf16_t*)x2 + (size_t)t * DM + 8 * (lane + 64 * j)) = pack8(xa[j], xb[j]);
            ss += (xa[j][0] * xa[j][0] + xa[j][1] * xa[j][1]) + (xa[j][2] * xa[j][2] + xa[j][3] * xa[j][3]) + (xb[j][0] * xb[j][0] + xb[j][1] * xb[j][1]) + (xb[j][2] * xb[j][2] + xb[j][3] * xb[j][3]); }
        ss = wave_sum(ss);
        const float rs = rsqrtf(ss * (1.0f / DM) + RMS_EPS);
#pragma unroll
        for (int j = 0; j < 4; ++j) { const f32x4 g0 = *(const f32x4*)(gp + 8 * (lane + 64 * j)), g1 = *(const f32x4*)(gp + 8 * (lane + 64 * j) + 4);
            const f32x4 ha_ = xa[j] * rs * g0, hb_ = xb[j] * rs * g1; u32x2 w8; w8.x = pack_fp8x4(ha_[0], ha_[1], ha_[2], ha_[3]); w8.y = pack_fp8x4(hb_[0], hb_[1], hb_[2], hb_[3]);
            *(u32x2*)((unsigned char*)h3 + (size_t)t * DM + 8 * (lane + 64 * j)) = w8; }
        f32x4 ua[4], uc[4]; float su = 0.f;
#pragma unroll
        for (int j = 0; j < 4; ++j) { const u32x2 w8 = *(const u32x2*)((const unsigned char*)ub + (size_t)t * DM + 8 * (lane + 64 * j));
            { const f32x2 p0 = __builtin_amdgcn_cvt_pk_f32_fp8((int)w8.x, false), p1 = __builtin_amdgcn_cvt_pk_f32_fp8((int)w8.x, true), p2 = __builtin_amdgcn_cvt_pk_f32_fp8((int)w8.y, false), p3 = __builtin_amdgcn_cvt_pk_f32_fp8((int)w8.y, true);
              ua[j] = (f32x4){p0[0], p0[1], p1[0], p1[1]} * U8_INV; uc[j] = (f32x4){p2[0], p2[1], p3[0], p3[1]} * U8_INV; }
            su += (ua[j][0] * ua[j][0] + ua[j][1] * ua[j][1]) + (ua[j][2] * ua[j][2] + ua[j][3] * ua[j][3]) + (uc[j][0] * uc[j][0] + uc[j][1] * uc[j][1]) + (uc[j][2] * uc[j][2] + uc[j][3] * uc[j][3]); }
        su = wave_sum(su);
        const float ru = rsqrtf(su * (1.0f / DM) + RMS_EPS);
#pragma unroll
        for (int j = 0; j < 4; ++j) { const f32x4 g0 = *(const f32x4*)(gpost + 8 * (lane + 64 * j)), g1 = *(const f32x4*)(gpost + 8 * (lane + 64 * j) + 4);
            { const f32x4 pa = ua[j] * ru * g0, pc = uc[j] * ru * g1; u32x2 w8; w8.x = pack_fp8x4(pa[0], pa[1], pa[2], pa[3]); w8.y = pack_fp8x4(pc[0], pc[1], pc[2], pc[3]);
              *(u32x2*)((unsigned char*)pnb + (size_t)t * DM + 8 * (lane + 64 * j)) = w8; } }
    }
}

struct EpiPlain {
    static constexpr bool PERM = true, AFTER_DRAIN = false, HAS_MID = false;
    bf16_t* O;
    __device__ __forceinline__ void operator()(const f32x4 (&acc)[2][2][4][2], const Unit& u, int wr, int wc, int fr, int fq) const {
        const size_t row0 = (size_t)u.pm * 256 + wr * 64 + fr; const int c0 = u.pn * 256 + wc * 32 + 8 * fq;
#pragma unroll
        for (int ai = 0; ai < 2; ++ai)
#pragma unroll
            for (int m = 0; m < 4; ++m)
#pragma unroll
                for (int bj = 0; bj < 2; ++bj) { const f32x4 a = acc[ai][bj][m][0] * U8_SCALE, b = acc[ai][bj][m][1] * U8_SCALE;
                    u32x2 w8; w8.x = pack_fp8x4(a[0], a[1], a[2], a[3]); w8.y = pack_fp8x4(b[0], b[1], b[2], b[3]);
                    *(u32x2*)((unsigned char*)O + (row0 + ai * 128 + m * 16) * DM + c0 + bj * 128) = w8; }
    }
};

#ifndef NCONV
#define NCONV 112
#endif
#ifndef NC1
#define NC1 0
#endif
constexpr int MOE_NIT = CV_NIT, MOE_SPLIT = NC1 ? (MOE_NIT * 27 / 100) / (NC1 * 8 + (NC1 == 0)) * (NC1 * 8) : 0;
__device__ __forceinline__ void attn_gla_phase(Frame& F, int rep) {
    volatile LAS unsigned* misc = (volatile LAS unsigned*)(F.lds + MISC_OFF);
    unsigned* ctl = (unsigned*)(F.ws + WS_CTL);
    const bool do_gla = (rep == 0 || rep == 1 || rep == 2 || rep == 6), do_att = (rep == 0 || rep == 1 || rep == 3 || rep == 6), do_conv = (rep == 0 || rep == 4 || rep == 5 || rep == 6);
    if ((int)blockIdx.x < NB * GL_H * 4) { if (do_gla) gla_scan_unit(F, (int)blockIdx.x); }
    else if ((int)blockIdx.x < NB * GL_H * 4 + NCONV) { if (do_conv) moe_convert(F, (int)blockIdx.x - NB * GL_H * 4, NCONV, MOE_SPLIT, MOE_NIT, rep == 5); }
    const float lam = __uint_as_float((unsigned)__builtin_amdgcn_readfirstlane((int)__hip_atomic_load(ctl + CW_LAM, RLX_AGENT)));
    if (do_att) for (;;) {
        if (F.tid == 0) misc[4] = __hip_atomic_fetch_add(ctl + CW_QUEUE + 64 * rep, 1u, RLX_AGENT);
        LDS_WAIT(); __syncthreads();
        const unsigned unit = (unsigned)__builtin_amdgcn_readfirstlane((int)misc[4]);
        if (unit >= (unsigned)(NB * DA_H * (SEQ / 128))) break;
        const int qb = 31 - (int)(unit >> 4), bh = (int)(unit & 15);
        attn_unit(F, bh >> 3, bh & 7, qb, lam);
    }
    __syncthreads();
}

constexpr int NPHASE = 14;
struct Args { const float* in[30]; float* out; unsigned char* ws; int ph_lo, ph_hi, rep, pad; };
__global__ void __launch_bounds__(512, 2) mk_fwd(Args args) {
    extern __shared__ __attribute__((aligned(16))) unsigned char lds_raw[];
    Frame F;
    F.lds = (LAS unsigned char*)lds_raw;
    F.wave = __builtin_amdgcn_readfirstlane((int)threadIdx.x >> 6); refresh(F);
    F.G = gridDim.x; { const int bx = blockIdx.x; F.vcu = (F.G % 8 == 0) ? (bx % 8) * (F.G / 8) + bx / 8 : bx; }
    F.ws = args.ws; F.out = args.out;
#pragma unroll
    for (int i = 0; i < 30; ++i) F.in[i] = args.in[i];
    volatile LAS unsigned* misc = (volatile LAS unsigned*)(F.lds + MISC_OFF);
    if (F.tid < 64) misc[F.tid] = 0u;
    __syncthreads();
    unsigned* ctl = (unsigned*)(F.ws + WS_CTL);
    const int lo = args.ph_lo, hi = args.ph_hi;
    const bool multi = (hi - lo) > 1;
    XcdBarrier bar; bar.bar = ctl + CW_BAR; bar.x = 0; bar.st = nullptr; bar.wave = 0;
    if (multi) bar = xcd_barrier_post(ctl + CW_BAR, misc + 8);
    bar.wave = F.wave;
#ifndef PH_MASK
#define PH_MASK 0xFFFF
#endif
#define IN(k) (((PH_MASK >> (k)) & 1) && lo <= (k) && (k) < hi)
#define SEAM(k) do { if (IN(k) && IN((k) + 1)) xcd_barrier(bar); } while (0)
#ifndef REP_MASK
#define REP_MASK 0
#endif
#define NREP(k) ((((REP_MASK) >> (k)) & 1) ? 2 : 1)
#define REPSEAM(k) do { if (rep + 1 < NREP(k)) xcd_barrier(bar); } while (0)
    LAS int* mt = (LAS int*)(F.lds + MISC_OFF + 64);
    LAS unsigned char* ring = F.lds;

    if (IN(0)) { refresh(F); p0_prologue(F, args.rep); } SEAM(0);
    if (IN(1)) { refresh(F);
        const int ncomp = F.G - NC1;
        if ((int)blockIdx.x < ncomp) {
        pg8::Gemm g{(const bf16_t*)(F.ws + WS_H1), (const bf16_t*)(F.ws + WS_WTIN), TOK, IN_MAIN, DM, F.tid}; pg8::StaticOrder S; S.init(TOK, IN_MAIN, ncomp, (int)blockIdx.x);
        EpiInProj E{(bf16_t*)(F.ws + WS_Q), (bf16_t*)(F.ws + WS_K), (bf16_t*)(F.ws + WS_V), (bf16_t*)(F.ws + WS_GQP), (bf16_t*)(F.ws + WS_GQM), (bf16_t*)(F.ws + WS_GKP), (bf16_t*)(F.ws + WS_GKM),
                    (bf16_t*)(F.ws + WS_GV), (bf16_t*)(F.ws + WS_SG), (bf16_t*)(F.ws + WS_GATES), F.in[3], F.in[4], (const float*)(F.ws + WS_BCUM), F.in[16], (LAS float*)(F.lds + EX_OFF)};
        pg8::gemm_phase<EpiInProj, pg8::StaticOrder, true, true>(ring, g, S, E);
        refresh(F);
        { pg8::Gemm g2{(const bf16_t*)(F.ws + WS_H1F8), (const bf16_t*)(F.ws + WS_WTMG8), TOK, 2 * DM, DM / 2, F.tid}; pg8::StaticOrder S2; S2.init(TOK, 2 * DM, ncomp, (int)blockIdx.x);
          EpiGates E2{(bf16_t*)(F.ws + WS_GATES), F.in[16]};
          pg8::gemm_phase<EpiGates, pg8::StaticOrder, true, true, 2>(ring, g2, S2, E2); }
        }
#if NC1 > 0
        else if (args.rep == 0) moe_convert(F, (int)blockIdx.x - ncomp, NC1, 0, MOE_SPLIT);
#endif
    } SEAM(1);
    if (IN(2)) { refresh(F); gla_scores_phase(F); } SEAM(2);
    if (IN(3)) { refresh(F); attn_gla_phase(F, args.rep); } SEAM(3);
    if (IN(4)) { refresh(F); gla_out_phase(F); } SEAM(4);
    if (IN(5)) { refresh(F);
        pg8::Gemm g{(const bf16_t*)(F.ws + WS_YCAT), (const bf16_t*)(F.ws + WS_WTBR), TOK, DM, 2 * DM, F.tid}; pg8::StaticOrder S; S.init(TOK, DM, F.G, (int)blockIdx.x);
        EpiMixed2 E{(const bf16_t*)(F.ws + WS_GATES), (bf16_t*)(F.ws + WS_MIXED)};
        pg8::gemm_phase<EpiMixed2, pg8::StaticOrder, true, true>(ring, g, S, E);
    } SEAM(5);
    if (IN(6)) { refresh(F);
#ifndef NO_X1
        { pg8::Gemm g{(const bf16_t*)(F.ws + WS_MIXED), (const bf16_t*)(F.ws + WS_WTOUT), TOK, DM, DM, F.tid}; pg8::StaticOrder S; S.init(TOK, DM, F.G, (int)blockIdx.x);
          EpiX1 E{F.in[0], (float*)(F.ws + WS_X1)};
          pg8::gemm_phase<EpiX1, pg8::StaticOrder, true, true>(ring, g, S, E); }
#endif
    } SEAM(6);
    if (IN(7)) { refresh(F); route_phase(F, args.rep); } SEAM(7);
    if (IN(8)) { refresh(F); build_mtoff(F, mt); scatter_phase(F, mt); } SEAM(8);
    if (IN(9)) { refresh(F);
        build_mtoff(F, mt);
        pg8::Gemm g{(const bf16_t*)(F.ws + WS_XS), (const bf16_t*)(F.ws + WS_WTGU), MAXROWS, 2 * DEXP, DM / 2, F.tid}; GroupedOrder S; S.init(mt, 16, F.G, (int)blockIdx.x);
        EpiGU8 E{F.in[23], (unsigned char*)(F.ws + WS_ACT)};
        pg8::gemm_phase<EpiGU8, GroupedOrder, true, true, 2>(ring, g, S, E);
    } SEAM(9);
    if (IN(10)) { refresh(F);
        build_mtoff(F, mt);
        pg8::Gemm g{(const bf16_t*)(F.ws + WS_ACT), (const bf16_t*)(F.ws + WS_WTDN), MAXROWS, DM, DEXP / 2, F.tid}; GroupedOrder S; S.init(mt, 8, F.G, (int)blockIdx.x);
        EpiDN8 E{F.in[25], (bf16_t*)(F.ws + WS_YB)};
        pg8::gemm_phase<EpiDN8, GroupedOrder, true, true, 2>(ring, g, S, E);
        refresh(F);
        { const int G = F.G, c = (int)blockIdx.x, U = mt[32] * 8;
          int lrank = c, L = G; bool light = true;
          if ((G & 7) == 0) {
              const int per = (U + 7) >> 3, step = G >> 3, maxr = (per + step - 1) / step, x = c & 7, r = c >> 3;
              int tot = 0, before = 0, myheavy = 0, myr = 0;
              for (int xx = 0; xx < 8; ++xx) { int n = U - xx * per; n = n < 0 ? 0 : (n > per ? per : n); const int rd = (n + step - 1) / step; const int heavy = (rd == maxr && n > 0) ? n - (rd - 1) * step : 0;
                  if (xx < x) before += step - heavy; if (xx == x) { myheavy = heavy; myr = rd; } tot += step - heavy; }
              if (tot * 3 >= (TOK / 256) * (DM / 256)) { L = tot; light = r >= myheavy; lrank = before + r - myheavy; }
          }
          int kple = PLE; asm volatile("" : "+s"(kple));
          pg8::Gemm g2{(const bf16_t*)(F.ws + WS_PB), (const bf16_t*)(F.ws + WS_WTPLEUP), TOK, DM, kple, F.tid}; pg8::StaticOrder S2; S2.init(TOK, DM, L, light ? lrank : 0);
          if (!light) S2.nwg = 0;
          EpiPlain E2{(bf16_t*)(F.ws + WS_UB)};
          pg8::gemm_phase<EpiPlain, pg8::StaticOrder, true, true>(ring, g2, S2, E2); }
    } SEAM(10);
    if (IN(11)) { refresh(F); combine_phase(F); } SEAM(11);
    if (IN(12)) { refresh(F);
        pg8::Gemm g{(const bf16_t*)(F.ws + WS_H3), (const bf16_t*)(F.ws + WS_WTPLEG), TOK, DM, DM / 2, F.tid}; pg8::StaticOrder S; S.init(TOK, DM, F.G, (int)blockIdx.x);
        EpiOut E{(const bf16_t*)(F.ws + WS_X2), (const bf16_t*)(F.ws + WS_PN), F.out, W8_INV};
        pg8::gemm_phase<EpiOut, pg8::StaticOrder, true, true, 2>(ring, g, S, E);
    }
#undef IN
#undef SEAM
}

#ifndef MK_LAUNCHES
#define MK_LAUNCHES 1
#endif
extern "C" void kernel_launch(void* const* d_in, const int* in_sizes, int n_in, void* d_out, int out_size, void* d_ws, size_t ws_size, hipStream_t stream) {
    static int grid = 0;
    if (grid == 0) {
        if (n_in != 30 || out_size != TOK * DM || ws_size < WS_END) { fprintf(stderr, "kernel_launch: unexpected shapes (n_in %d out %d ws %zu)\n", n_in, out_size, ws_size); grid = -1; return; }
        int dev = 0, cus = 0, per_cu = 0;
        if (hipGetDevice(&dev) != hipSuccess || hipDeviceGetAttribute(&cus, hipDeviceAttributeMultiprocessorCount, dev) != hipSuccess) { grid = -1; return; }
        if (hipFuncSetAttribute((const void*)mk_fwd, hipFuncAttributeMaxDynamicSharedMemorySize, LDS_BYTES) != hipSuccess) { fprintf(stderr, "kernel_launch: hipFuncSetAttribute failed\n"); grid = -1; return; }
        if (hipOccupancyMaxActiveBlocksPerMultiprocessor(&per_cu, (const void*)mk_fwd, 512, LDS_BYTES) != hipSuccess || per_cu < 1) { fprintf(stderr, "kernel_launch: occupancy query says %d\n", per_cu); (void)hipGetLastError(); per_cu = 1; }
        grid = cus;
    }
    if (grid < 0) return;
    (void)hipMemsetAsync((char*)d_ws + WS_CTL, 0, CTL_ZERO_BYTES, stream);
    Args a{};
    for (int i = 0; i < 30; ++i) a.in[i] = (const float*)d_in[i];
    a.out = (float*)d_out; a.ws = (unsigned char*)d_ws;
#if MK_LAUNCHES == 1
    a.ph_lo = 0; a.ph_hi = NPHASE;
    hipLaunchKernelGGL(mk_fwd, dim3(grid), dim3(512), LDS_BYTES, stream, a);
#else
    for (int p = 0; p < 13; ++p) for (int rep = 0; rep < NREP(p); ++rep) { a.ph_lo = p; a.ph_hi = p + 1; a.rep = rep;
#ifdef PROBE3_MODE
        if (p == 3 && rep == 1) a.rep = PROBE3_MODE;
#endif
#ifdef PROBE0_MODE
        if (p == 0 && rep == 1) a.rep = PROBE0_MODE;
#endif
        hipLaunchKernelGGL(mk_fwd, dim3(grid), dim3(512), LDS_BYTES, stream, a); }
#endif
}
```
